# Optimizing an MI355X kernel written in HIP

```python
import jax
import jax.numpy as jnp
from jax import lax
import numpy as np

D_MODEL = 1024
BATCH = 8
SEQ = 4096
DEPTH = 4

GRID_W = 64
CTX_LEN = 256
N_MIXERS = 3
N_LAYERS_NA = (DEPTH + 2) // 3
N_LAYERS_GLA = (DEPTH + 1) // 3
N_LAYERS_RWKV = DEPTH // 3
D_FF = 4 * D_MODEL
NORM_EPS = 1e-6

NA_HEAD_DIM = 64
NA_HEADS = D_MODEL // NA_HEAD_DIM
NA_WIN_R = 8
NA_WIN_C = 16

GLA_HEADS = 4
GLA_DK = D_MODEL // 2
GLA_DV = D_MODEL
GLA_HK = GLA_DK // GLA_HEADS
GLA_HV = GLA_DV // GLA_HEADS
GLA_LOW_RANK = 16
GLA_GATE_NORM = 16.0
GLA_CHUNK = 64
GLA_IN = 2 * GLA_DK + 2 * GLA_DV + 2 * GLA_LOW_RANK

RW_HEAD = 64
RW_HEADS = D_MODEL // RW_HEAD
RW_DECAY_LORA = 64
RW_AAA_LORA = 64
RW_GATE_LORA = 160
RW_GN_EPS = 64e-5

kernel_name = 'hybrid_natten_gla_rwkv7_dit_trunk'


def rms_norm(x, g):
    xf = x.astype(jnp.float32)
    y = xf * lax.rsqrt(jnp.mean(xf * xf, axis=-1, keepdims=True) + NORM_EPS)
    return (y * g.astype(jnp.float32)).astype(x.dtype)


def modulate(h, shift, scale):
    return h * (1.0 + scale) + shift


def sq_relu_mlp(h, w1, w2):
    return jnp.square(jax.nn.relu(h @ w1)) @ w2


def maybe_flip(t, axis, flip):
    return jnp.flip(t, axis=axis) if flip else t


def natten_latent(q, k, v, k_ctx, v_ctx, rpb):
    B, H, R, W, dh = q.shape
    kr = min(NA_WIN_R, R)
    kc = min(NA_WIN_C, W)
    n_lat = kr * W
    cols = jnp.arange(W)
    c_start = jnp.clip(cols - kc // 2, 0, W - kc)
    col_ok = (cols[None, :] >= c_start[:, None]) & (cols[None, :] < c_start[:, None] + kc)
    col_idx = jnp.clip(cols[None, :] - cols[:, None], -(NA_WIN_C - 1), NA_WIN_C - 1) + NA_WIN_C - 1
    scale = dh ** -0.5
    neg = jnp.finfo(jnp.float32).min
    rpb = rpb.astype(jnp.float32)

    def one_row(args):
        r, q_r = args
        r0 = jnp.clip(r - kr // 2, 0, R - kr)
        k_s = lax.dynamic_slice_in_dim(k, r0, kr, axis=2).reshape(B, H, n_lat, dh)
        v_s = lax.dynamic_slice_in_dim(v, r0, kr, axis=2).reshape(B, H, n_lat, dh)
        row_idx = r0 + jnp.arange(kr) - r + NA_WIN_R - 1
        bias = rpb[:, row_idx[None, :, None], col_idx[:, None, :]]
        bias = jnp.where(col_ok[None, :, None, :], bias, neg).reshape(H, W, n_lat)
        s_lat = jnp.einsum('bhqd,bhkd->bhqk', q_r, k_s).astype(jnp.float32) * scale + bias
        s_ctx = jnp.einsum('bhqd,bhcd->bhqc', q_r, k_ctx).astype(jnp.float32) * scale
        p = jax.nn.softmax(jnp.concatenate([s_lat, s_ctx], axis=-1), axis=-1).astype(v.dtype)
        return (jnp.einsum('bhqk,bhkd->bhqd', p[..., :n_lat], v_s)
                + jnp.einsum('bhqc,bhcd->bhqd', p[..., n_lat:], v_ctx))

    out = lax.map(one_row, (jnp.arange(R), jnp.moveaxis(q, 2, 0)))
    return jnp.moveaxis(out, 0, 2)


def dense_attention(q, k, v):
    s = jnp.einsum('bhqd,bhkd->bhqk', q, k).astype(jnp.float32) * q.shape[-1] ** -0.5
    p = jax.nn.softmax(s, axis=-1).astype(v.dtype)
    return jnp.einsum('bhqk,bhkd->bhqd', p, v)


def natten_mixer(h_x, h_z, w_qkv, w_o, rpb, need_ctx):
    B, S, D = h_x.shape
    R = S // GRID_W

    def heads(h):
        T = h.shape[1]
        return (h @ w_qkv).reshape(B, T, 3, NA_HEADS, NA_HEAD_DIM).transpose(2, 0, 3, 1, 4)

    q, k, v = heads(h_x)
    q_c, k_c, v_c = heads(h_z)
    grid = lambda t: t.reshape(B, NA_HEADS, R, GRID_W, NA_HEAD_DIM)
    o = natten_latent(grid(q), grid(k), grid(v), k_c, v_c, rpb)
    o_x = o.reshape(B, NA_HEADS, S, NA_HEAD_DIM).transpose(0, 2, 1, 3).reshape(B, S, D) @ w_o
    o_z = None
    if need_ctx:
        oc = dense_attention(q_c, k_c, v_c)
        o_z = oc.transpose(0, 2, 1, 3).reshape(B, h_z.shape[1], D) @ w_o
    return o_x, o_z


def gla_scan(q, k, v, g, s0):
    B, H, T, hk = q.shape
    hv = v.shape[-1]
    n = T // GLA_CHUNK
    ch = lambda t: t.reshape(B, H, n, GLA_CHUNK, t.shape[-1])
    q, k, v, g = ch(q), ch(k), ch(v), ch(g)
    b = jnp.cumsum(g, axis=3)
    b_last = b[:, :, :, -1:, :]
    q_e = q * jnp.exp(b)
    k_e = k * jnp.exp(-b)
    order_mask = jnp.tril(jnp.ones((GLA_CHUNK, GLA_CHUNK), dtype=bool))
    a = jnp.where(order_mask, jnp.einsum('bhnld,bhnmd->bhnlm', q_e, k_e), 0.0)
    o_intra = jnp.einsum('bhnlm,bhnmv->bhnlv', a, v)
    u = jnp.einsum('bhnld,bhnlv->bhndv', k * jnp.exp(b_last - b), v)
    dec = jnp.exp(b_last[:, :, :, 0])

    def step(s, inp):
        d, du = inp
        return d[..., None] * s + du, s

    s_fin, s_prev = lax.scan(step, s0, (jnp.moveaxis(dec, 2, 0), jnp.moveaxis(u, 2, 0)))
    o_inter = jnp.einsum('bhnld,nbhdv->bhnlv', q_e, s_prev)
    return (o_intra + o_inter).reshape(B, H, T, hv), s_fin


def gla_mixer(h_x, h_z, w_in, w_dec2, b_dec, norm_g, w_o, need_ctx):
    B = h_x.shape[0]

    def project(h):
        T = h.shape[1]
        p = h.astype(jnp.float32) @ w_in
        q, k, v, gt, lr = jnp.split(p, [GLA_DK, 2 * GLA_DK, 2 * GLA_DK + GLA_DV, 2 * GLA_DK + 2 * GLA_DV], axis=-1)
        hd = lambda t, d: t.reshape(B, T, GLA_HEADS, d).transpose(0, 2, 1, 3)
        q = hd(q, GLA_HK) * GLA_HK ** -0.5
        k = hd(k, GLA_HK)
        v = hd(v, GLA_HV)
        lr = lr.reshape(B, T, 2, GLA_LOW_RANK)
        z = jnp.einsum('btdr,drk->btdk', lr, w_dec2) + b_dec
        g = jax.nn.log_sigmoid(z) / GLA_GATE_NORM
        return q, k, v, gt, [hd(g[:, :, d], GLA_HK) for d in range(2)]

    sides = [project(h_x), project(h_z)]
    s0 = jnp.zeros((B, GLA_HEADS, GLA_HK, GLA_HV), jnp.float32)
    o = [0.0, 0.0]
    for d in range(2):
        flip = d == 1
        s_start = s0
        for side in (1, 0):
            q, k, v, _, gs = sides[side]
            os_, s_start = gla_scan(*(maybe_flip(t, 2, flip) for t in (q, k, v, gs[d])), s_start)
            o[side] = o[side] + maybe_flip(os_, 2, flip)

    def finish(side):
        ov = o[side]
        gt = sides[side][3]
        T = ov.shape[2]
        ov = ov * lax.rsqrt(jnp.mean(ov * ov, axis=-1, keepdims=True) + NORM_EPS) * norm_g
        ov = ov.transpose(0, 2, 1, 3).reshape(B, T, GLA_DV) * jax.nn.silu(gt)
        return (ov @ w_o).astype(h_x.dtype)

    return finish(0), (finish(1) if need_ctx else None)


def centred_shift(h):
    p = jnp.pad(h, ((0, 0), (1, 1), (0, 0)))
    return 0.5 * (p[:, :-2] + p[:, 2:])


def rwkv_project(h, mix, w_rkv, w0, w1, w2, a0, a1, a2, g1, g2, k_k, k_a):
    B, T, D = h.shape
    hd = lambda t: t.reshape(B, T, RW_HEADS, RW_HEAD)
    xx = centred_shift(h) - h
    xr, xw, xk, xv, xa, xg = (h + xx * mix[m] for m in range(6))
    r = hd(xr @ w_rkv[0])
    k = hd(xk @ w_rkv[1])
    v = hd(xv @ w_rkv[2])
    g = jax.nn.sigmoid(xg @ g1) @ g2
    kk = k * k_k.reshape(RW_HEADS, RW_HEAD)
    kk = kk * lax.rsqrt(jnp.maximum(jnp.sum(kk * kk, axis=-1, keepdims=True), 1e-24))
    k_a = k_a.reshape(RW_HEADS, RW_HEAD)
    dirs = []
    for d in range(2):
        w_log = -jax.nn.softplus(-(w0[d] + jnp.tanh(xw @ w1[d]) @ w2[d])) - 0.5
        decay = hd(jnp.exp(-jnp.exp(w_log)))
        a = hd(jax.nn.sigmoid(a0[d] + (xa @ a1[d]) @ a2[d]))
        dirs.append((decay, k * (1.0 + (a - 1.0) * k_a), a))
    return r, v, g, kk, dirs


def rwkv_scan(s0, r, decay, k, v, kk, a):
    tm = lambda t: jnp.moveaxis(t, 1, 0)

    def step(s, inp):
        r_t, w_t, k_t, v_t, kk_t, b_t = inp
        sa = jnp.einsum('bhij,bhj->bhi', s, -kk_t)
        s = s * w_t[:, :, None, :] + sa[..., None] * b_t[:, :, None, :] + v_t[..., None] * k_t[:, :, None, :]
        return s, jnp.einsum('bhij,bhj->bhi', s, r_t)

    s_fin, y = lax.scan(step, s0, (tm(r), tm(decay), tm(k), tm(v), tm(kk), tm(kk * a)))
    return jnp.moveaxis(y, 0, 1), s_fin


def rwkv_mixer(h_x, h_z, mix, w_rkv, w0, w1, w2, a0, a1, a2, g1, g2, k_k, k_a, r_k,
               ln_g, ln_b, w_o, need_ctx):
    prm = (mix, w_rkv, w0, w1, w2, a0, a1, a2, g1, g2, k_k, k_a)
    sides = [rwkv_project(h.astype(jnp.float32), *prm) for h in (h_x, h_z)]
    B, _, D = h_x.shape
    r_k = r_k.astype(jnp.float32)
    s0 = jnp.zeros((B, RW_HEADS, RW_HEAD, RW_HEAD), jnp.float32)
    y = [0.0, 0.0]
    bonus = [0.0, 0.0]
    for d in range(2):
        flip = d == 1
        s_start = s0
        for side in (1, 0):
            r, v, _, kk, dirs = sides[side]
            decay, k_d, a = dirs[d]
            ys, s_start = rwkv_scan(s_start, *(maybe_flip(t, 1, flip) for t in (r, decay, k_d, v, kk, a)))
            y[side] = y[side] + maybe_flip(ys, 1, flip)
            bonus[side] = bonus[side] + jnp.sum(r * k_d * r_k, axis=-1, keepdims=True) * v

    def finish(side):
        yv = y[side]
        g = sides[side][2]
        T = yv.shape[1]
        mu = jnp.mean(yv, axis=-1, keepdims=True)
        var = jnp.mean(jnp.square(yv - mu), axis=-1, keepdims=True)
        yn = ((yv - mu) * lax.rsqrt(var + RW_GN_EPS)).reshape(B, T, D) * ln_g + ln_b
        out = (yn + bonus[side].reshape(B, T, D)) * g
        return (out @ w_o).astype(h_x.dtype)

    return finish(0), (finish(1) if need_ctx else None)


def setup_inputs(seed: int = 0) -> dict:
    key = jax.random.key(seed)
    keys = list(jax.random.split(key, 40))
    nrm = lambda shape, s: jax.random.normal(keys.pop(), shape, jnp.float32) * s
    uni = lambda shape, lo, hi: jax.random.uniform(keys.pop(), shape, jnp.float32, lo, hi)
    D = D_MODEL
    nA, nB, nC = N_LAYERS_NA, N_LAYERS_GLA, N_LAYERS_RWKV
    return {
        'x': nrm((BATCH, SEQ, D), 1.0),
        'c': nrm((BATCH, D), 1.0),
        'ctx': nrm((BATCH, CTX_LEN, D), 1.0),
        'c_ctx': nrm((D,), 1.0),
        'ada_w': nrm((DEPTH, D, 6 * D), 0.5 * D ** -0.5),
        'ada_b': nrm((DEPTH, 6 * D), 0.01),
        'norm1_g': 1.0 + nrm((DEPTH, D), 0.02),
        'norm2_g': 1.0 + nrm((DEPTH, D), 0.02),
        'mlp_w1': nrm((DEPTH, D, D_FF), D ** -0.5),
        'mlp_w2': nrm((DEPTH, D_FF, D), D_FF ** -0.5),
        'final_g': 1.0 + nrm((D,), 0.02),
        'na_w_qkv': nrm((nA, D, 3 * D), D ** -0.5),
        'na_w_o': nrm((nA, D, D), D ** -0.5),
        'na_rpb': nrm((nA, NA_HEADS, 2 * NA_WIN_R - 1, 2 * NA_WIN_C - 1), 0.1),
        'gla_w_in': nrm((nB, D, GLA_IN), D ** -0.5),
        'gla_w_dec2': nrm((nB, 2, GLA_LOW_RANK, GLA_DK), GLA_LOW_RANK ** -0.5),
        'gla_b_dec': 1.0 + nrm((nB, 2, GLA_DK), 0.5),
        'gla_norm_g': 1.0 + nrm((nB, GLA_HV), 0.02),
        'gla_w_o': nrm((nB, GLA_DV, D), GLA_DV ** -0.5),
        'rw_mix': uni((nC, 6, D), 0.0, 1.0),
        'rw_w_rkv': nrm((nC, 3, D, D), D ** -0.5),
        'rw_w0': uni((nC, 2, D), -5.0, 1.0),
        'rw_w1': nrm((nC, 2, D, RW_DECAY_LORA), D ** -0.5),
        'rw_w2': nrm((nC, 2, RW_DECAY_LORA, D), 0.1),
        'rw_a0': nrm((nC, 2, D), 0.1),
        'rw_a1': nrm((nC, 2, D, RW_AAA_LORA), D ** -0.5),
        'rw_a2': nrm((nC, 2, RW_AAA_LORA, D), 0.1),
        'rw_g1': nrm((nC, D, RW_GATE_LORA), D ** -0.5),
        'rw_g2': nrm((nC, RW_GATE_LORA, D), RW_GATE_LORA ** -0.5),
        'rw_k_k': 0.85 + nrm((nC, D), 0.02),
        'rw_k_a': 1.0 + nrm((nC, D), 0.02),
        'rw_r_k': nrm((nC, RW_HEADS, RW_HEAD), 0.1),
        'rw_ln_g': 1.0 + nrm((nC, D), 0.02),
        'rw_ln_b': nrm((nC, D), 0.01),
        'rw_w_o': nrm((nC, D, D), D ** -0.5),
    }


def reference(x, c, ctx, c_ctx, ada_w, ada_b, norm1_g, norm2_g, mlp_w1, mlp_w2, final_g,
              na_w_qkv, na_w_o, na_rpb, gla_w_in, gla_w_dec2, gla_b_dec, gla_norm_g, gla_w_o,
              rw_mix, rw_w_rkv, rw_w0, rw_w1, rw_w2, rw_a0, rw_a1, rw_a2, rw_g1, rw_g2,
              rw_k_k, rw_k_a, rw_r_k, rw_ln_g, rw_ln_b, rw_w_o):
    z = ctx.astype(x.dtype)
    sc = jax.nn.silu(c)
    scc = jax.nn.silu(c_ctx)
    for i in range(DEPTH):
        kind, j = i % N_MIXERS, i // N_MIXERS
        need_ctx = i < DEPTH - 1
        mx = jnp.split((sc @ ada_w[i] + ada_b[i])[:, None, :], 6, axis=-1)
        mz = jnp.split((scc @ ada_w[i] + ada_b[i])[None, None, :], 6, axis=-1)
        h_x = modulate(rms_norm(x, norm1_g[i]), mx[0], mx[1])
        h_z = modulate(rms_norm(z, norm1_g[i]), mz[0], mz[1])
        if kind == 0:
            o_x, o_z = natten_mixer(h_x, h_z, na_w_qkv[j], na_w_o[j], na_rpb[j], need_ctx)
        elif kind == 1:
            o_x, o_z = gla_mixer(h_x, h_z, gla_w_in[j], gla_w_dec2[j], gla_b_dec[j], gla_norm_g[j],
                                 gla_w_o[j], need_ctx)
        else:
            o_x, o_z = rwkv_mixer(h_x, h_z, rw_mix[j], rw_w_rkv[j], rw_w0[j], rw_w1[j], rw_w2[j],
                                  rw_a0[j], rw_a1[j], rw_a2[j], rw_g1[j], rw_g2[j], rw_k_k[j],
                                  rw_k_a[j], rw_r_k[j], rw_ln_g[j], rw_ln_b[j], rw_w_o[j], need_ctx)
        x = x + mx[2] * o_x
        x = x + mx[5] * sq_relu_mlp(modulate(rms_norm(x, norm2_g[i]), mx[3], mx[4]), mlp_w1[i], mlp_w2[i])
        if need_ctx:
            z = z + mz[2] * o_z
            z = z + mz[5] * sq_relu_mlp(modulate(rms_norm(z, norm2_g[i]), mz[3], mz[4]), mlp_w1[i], mlp_w2[i])
    return rms_norm(x, final_g)
```

```cpp
#include <hip/hip_runtime.h>
#include <hip/hip_cooperative_groups.h>
#include <cstdio>
#include <cstdint>
namespace cg = cooperative_groups;

namespace pg8 {
#define PG8_LAS __attribute__((address_space(3)))
typedef unsigned short bf16_t;
typedef short bf16x8 __attribute__((ext_vector_type(8)));
typedef float f32x4 __attribute__((ext_vector_type(4)));
typedef unsigned u32x4 __attribute__((ext_vector_type(4)));
constexpr int BM = 256, BK = 64, HALF = 128, HTB = HALF * BK * 2  , STAGE_BYTES = 8 * HTB, NXCD = 8, WGM = 8;

__host__ __device__ __forceinline__ int lds_byte(int r, int c) { const int st = (r >> 4) * 2 + (c >> 5), rr = r & 15, cc = c & 31, ob = rr * 64 + cc * 2; return st * 1024 + (ob ^ (((ob >> 9) & 1) << 5)); }
__host__ __device__ __forceinline__ void stage_rc(int b, int& R, int& C) { const int st = b / 1024, sb = b % 1024, swz = sb ^ (((sb >> 9) & 1) << 5); R = (st >> 1) * 16 + swz / 64; C = (st & 1) * 32 + (swz % 64) / 2; }
__host__ __device__ __forceinline__ int perm32(int rho) { const int n = rho >> 4, i = rho & 15; return 8 * (i >> 2) + 4 * n + (i & 3); }

struct Unit { int pm, pn; };
struct Gemm { const bf16_t* A; const bf16_t* Bt; int M, N, K; };

struct StaticOrder {
    int nM, nN, nwg, G, c;
    __host__ __device__ void init(int M, int N, int G_, int c_) { nM = M / BM; nN = N / BM; nwg = nM * nN; G = G_; c = c_; }
    __host__ __device__ bool next(int i, Unit& u) const {
        const long L = (long)i * G + c; if (L >= nwg) return false;
        int wgid = (int)L; { const int q = nwg / NXCD, r = nwg % NXCD, xcd = wgid % NXCD, off = wgid / NXCD; wgid = (xcd < r ? xcd * (q + 1) : r * (q + 1) + (xcd - r) * q) + off; }
        const int nig = WGM * nN, gid = wgid / nig, fm = gid * WGM, gsz = (nM - fm) < WGM ? (nM - fm) : WGM;
        u.pm = fm + ((wgid % nig) % gsz); u.pn = (wgid % nig) / gsz; return true;
    }
    __device__ __forceinline__ void a_ready(const Unit&) const {}
    __device__ __forceinline__ void done(const Unit&) const {}
};

__device__ __forceinline__ unsigned cvt_pk_bf16(float lo, float hi) { unsigned r; asm volatile("v_cvt_pk_bf16_f32 %0, %1, %2" : "=v"(r) : "v"(lo), "v"(hi)); return r; }
template <class Epi, class Sched, bool ALIGN_EPI = false, bool SP2 = false>
__device__ __forceinline__ void gemm_phase(PG8_LAS unsigned char* lds, const Gemm g, const Sched& S, const Epi& E) {
    const int tid = threadIdx.x, wid = __builtin_amdgcn_readfirstlane(tid >> 6), lane = tid & 63, wr = wid >> 2, wc = wid & 3, fr = lane & 15, fq = lane >> 4;
    const int K = g.K, nt = K / BK;
    unsigned voffA[2], voffB[2];
#pragma unroll
    for (int i = 0; i < 2; ++i) { int R, C; stage_rc(tid * 16 + i * 8192, R, C); const int Rb = Epi::PERM ? ((R & ~31) + perm32(R & 31)) : R;
        voffA[i] = (unsigned)(R * K + C) * 2u; voffB[i] = (unsigned)(Rb * K + C) * 2u; }
    const size_t kstep = (size_t)(BK * 2);
    const size_t hstep = (size_t)HALF * K * 2;
    const size_t tstep = 2 * hstep;
    const unsigned ldsw = (unsigned)wid * 1024u;
    const int aoff = lds_byte(wr * 64 + fr, fq * 8), boff = lds_byte(wc * 32 + fr, fq * 8);
#define PG8_SA(b, h) (((b) * 2 + (h)) * HTB)
#define PG8_SB(b, h) ((4 + (b) * 2 + (h)) * HTB)
#define PG8_STAGE(bufoff, gbase, voff) do { _Pragma("unroll") for (int _i = 0; _i < 2; ++_i) \
        __builtin_amdgcn_global_load_lds((const unsigned*)((const char*)(gbase) + (voff)[_i]), (PG8_LAS unsigned*)(lds + (bufoff) + ldsw + _i * 8192), 16, 0, 0); } while (0)
#define PG8_LDA(dst, b, h) do { _Pragma("unroll") for (int m = 0; m < 4; ++m) _Pragma("unroll") for (int k = 0; k < 2; ++k) dst[m][k] = *(const PG8_LAS bf16x8*)(lds + PG8_SA(b, h) + aoff + m * 2048 + k * 1024); } while (0)
#define PG8_LDB(dst, b, h) do { _Pragma("unroll") for (int n = 0; n < 2; ++n) _Pragma("unroll") for (int k = 0; k < 2; ++k) dst[n][k] = *(const PG8_LAS bf16x8*)(lds + PG8_SB(b, h) + boff + n * 2048 + k * 1024); } while (0)
#define PG8_MMA(ai, bj, At, Bt) do { __builtin_amdgcn_s_setprio(1); _Pragma("unroll") for (int m = 0; m < 4; ++m) _Pragma("unroll") for (int n = 0; n < 2; ++n) _Pragma("unroll") for (int k = 0; k < 2; ++k) \
        acc[ai][bj][m][n] = __builtin_amdgcn_mfma_f32_16x16x32_bf16(Bt[n][k], At[m][k], acc[ai][bj][m][n], 0, 0, 0); __builtin_amdgcn_s_setprio(0); } while (0)
#define PG8_WAIT_V(n) asm volatile("s_waitcnt vmcnt(" #n ")" ::: "memory")
#define PG8_WAIT_L(n) asm volatile("s_waitcnt lgkmcnt(" #n ")" ::: "memory")
#define PG8_BAR __builtin_amdgcn_s_barrier()
#define PG8_SCHED __builtin_amdgcn_sched_barrier(0)
    Unit cur, nxt; int ui = 0;
    if (!S.next(0, cur)) return;
    f32x4 acc[2][2][4][2];
#pragma unroll
    for (int a = 0; a < 2; ++a)
#pragma unroll
        for (int b = 0; b < 2; ++b)
#pragma unroll
            for (int m = 0; m < 4; ++m)
#pragma unroll
                for (int n = 0; n < 2; ++n) acc[a][b][m][n] = (f32x4){0.f, 0.f, 0.f, 0.f};
    bf16x8 At[4][2], B0[2][2], B1[2][2];
    const char* cA = (const char*)g.A + (size_t)cur.pm * tstep; const char* cB = (const char*)g.Bt + (size_t)cur.pn * tstep;
    S.a_ready(cur);
    if constexpr (SP2) {
        PG8_STAGE(PG8_SB(0, 0), cB, voffB); PG8_STAGE(PG8_SB(0, 1), cB + hstep, voffB); PG8_STAGE(PG8_SA(0, 0), cA, voffA); PG8_STAGE(PG8_SA(0, 1), cA + hstep, voffA);
        if (wr == 1) PG8_BAR;
        PG8_WAIT_V(2); PG8_BAR;
        PG8_STAGE(PG8_SB(1, 0), cB + kstep, voffB); PG8_STAGE(PG8_SA(1, 0), cA + kstep, voffA); PG8_STAGE(PG8_SB(1, 1), cB + hstep + kstep, voffB);
        PG8_WAIT_V(6); PG8_BAR;
    } else {
        PG8_STAGE(PG8_SB(0, 0), cB, voffB); PG8_STAGE(PG8_SA(0, 0), cA, voffA); PG8_STAGE(PG8_SB(0, 1), cB + hstep, voffB); PG8_STAGE(PG8_SA(0, 1), cA + hstep, voffA);
        if (wr == 1) PG8_BAR;
        PG8_WAIT_V(4); PG8_BAR;
        PG8_STAGE(PG8_SB(1, 0), cB + kstep, voffB); PG8_STAGE(PG8_SA(1, 0), cA + kstep, voffA); PG8_STAGE(PG8_SB(1, 1), cB + hstep + kstep, voffB);
        PG8_WAIT_V(6); PG8_BAR;
    }
    for (;;) {
        const bool has_next = S.next(ui + 1, nxt);
        const char* nA = has_next ? (const char*)g.A + (size_t)nxt.pm * tstep : cA; const char* nB = has_next ? (const char*)g.Bt + (size_t)nxt.pn * tstep : cB;
        for (int t = 0; t < nt; t += 2) {
            const bool last = (t == nt - 2);
            const char* a1 = cA + (size_t)(t + 1) * kstep;
            const char* a2 = last ? nA : cA + (size_t)(t + 2) * kstep; const char* b2 = last ? nB : cB + (size_t)(t + 2) * kstep;
            const char* a3 = a2 + kstep; const char* b3 = b2 + kstep;
            if (last && has_next) S.a_ready(nxt);
            if constexpr (SP2) {
            PG8_LDB(B0, 0, 0); PG8_LDB(B1, 0, 1); PG8_SCHED; PG8_LDA(At, 0, 0); PG8_STAGE(PG8_SA(1, 1), a1 + hstep, voffA);
            PG8_WAIT_V(8); PG8_WAIT_L(0); PG8_BAR; PG8_MMA(0, 0, At, B0); PG8_MMA(0, 1, At, B1); PG8_BAR; PG8_SCHED;
            PG8_LDA(At, 0, 1); PG8_STAGE(PG8_SB(0, 0), b2, voffB); PG8_STAGE(PG8_SB(0, 1), b2 + hstep, voffB); PG8_STAGE(PG8_SA(0, 0), a2, voffA);
            PG8_WAIT_V(8); PG8_WAIT_L(0); PG8_BAR; PG8_MMA(1, 0, At, B0); PG8_MMA(1, 1, At, B1); PG8_BAR; PG8_SCHED;
            PG8_LDB(B0, 1, 0); PG8_LDB(B1, 1, 1); PG8_SCHED; PG8_LDA(At, 1, 0); PG8_STAGE(PG8_SA(0, 1), a2 + hstep, voffA);
            PG8_WAIT_V(8); PG8_WAIT_L(0); PG8_BAR; PG8_MMA(0, 0, At, B0); PG8_MMA(0, 1, At, B1); PG8_BAR; PG8_SCHED;
            PG8_LDA(At, 1, 1); PG8_STAGE(PG8_SB(1, 0), b3, voffB); PG8_STAGE(PG8_SB(1, 1), b3 + hstep, voffB); PG8_STAGE(PG8_SA(1, 0), a3, voffA);
            PG8_WAIT_V(8); PG8_WAIT_L(0); PG8_BAR; PG8_MMA(1, 0, At, B0); PG8_MMA(1, 1, At, B1); PG8_BAR; PG8_SCHED;
            } else {
            PG8_LDB(B0, 0, 0); PG8_SCHED; PG8_LDA(At, 0, 0); PG8_STAGE(PG8_SA(1, 1), a1 + hstep, voffA);
            PG8_WAIT_L(8); PG8_BAR; PG8_WAIT_L(0); PG8_MMA(0, 0, At, B0); PG8_BAR; PG8_SCHED;
            PG8_LDB(B1, 0, 1); PG8_STAGE(PG8_SB(0, 0), b2, voffB);
            PG8_BAR; PG8_WAIT_L(0); PG8_MMA(0, 1, At, B1); PG8_BAR;
            PG8_LDA(At, 0, 1); PG8_STAGE(PG8_SA(0, 0), a2, voffA);
            PG8_BAR; PG8_WAIT_L(0); PG8_MMA(1, 0, At, B0); PG8_BAR; PG8_SCHED;
            PG8_STAGE(PG8_SB(0, 1), b2 + hstep, voffB);
            PG8_WAIT_V(6); PG8_BAR; PG8_MMA(1, 1, At, B1); PG8_BAR;
            PG8_LDB(B0, 1, 0); PG8_SCHED; PG8_LDA(At, 1, 0); PG8_STAGE(PG8_SA(0, 1), a2 + hstep, voffA);
            PG8_WAIT_L(8); PG8_BAR; PG8_WAIT_L(0); PG8_MMA(0, 0, At, B0); PG8_BAR; PG8_SCHED;
            PG8_LDB(B1, 1, 1); PG8_STAGE(PG8_SB(1, 0), b3, voffB);
            PG8_BAR; PG8_WAIT_L(0); PG8_MMA(0, 1, At, B1); PG8_BAR;
            PG8_LDA(At, 1, 1); PG8_STAGE(PG8_SA(1, 0), a3, voffA);
            PG8_BAR; PG8_WAIT_L(0); PG8_MMA(1, 0, At, B0); PG8_BAR; PG8_SCHED;
            PG8_STAGE(PG8_SB(1, 1), b3 + hstep, voffB);
            PG8_WAIT_V(6); PG8_BAR; PG8_MMA(1, 1, At, B1); PG8_BAR;
            }
        }
        if constexpr (ALIGN_EPI) { if (wr == 0) PG8_BAR; }
        if constexpr (!Epi::AFTER_DRAIN) { E(acc, cur, wr, wc, fr, fq); S.done(cur); }
        if (!has_next) break;
#pragma unroll
        for (int a = 0; a < 2; ++a)
#pragma unroll
            for (int b = 0; b < 2; ++b)
#pragma unroll
                for (int m = 0; m < 4; ++m)
#pragma unroll
                    for (int n = 0; n < 2; ++n) acc[a][b][m][n] = (f32x4){0.f, 0.f, 0.f, 0.f};
        cur = nxt; cA = nA; cB = nB; ++ui;
        if constexpr (ALIGN_EPI) { if (wr == 1) PG8_BAR; }
    }
    PG8_WAIT_V(0);
    if constexpr (!ALIGN_EPI) { if (wr == 0) PG8_BAR; }
    PG8_BAR;
    if constexpr (Epi::AFTER_DRAIN) { E.fused(acc, cur, wr, wc, fr, fq, lds, wid, lane); S.done(cur); }
#undef PG8_SA
#undef PG8_SB
#undef PG8_STAGE
#undef PG8_LDA
#undef PG8_LDB
#undef PG8_MMA
#undef PG8_WAIT_V
#undef PG8_WAIT_L
#undef PG8_BAR
#undef PG8_SCHED
}
}

#ifndef GM
#define GM 0xffff
#endif
#define DI __device__ __forceinline__
#define LAS __attribute__((address_space(3)))
typedef unsigned short bf16_t;
typedef short bf16x8 __attribute__((ext_vector_type(8)));
typedef float f32x4 __attribute__((ext_vector_type(4)));
typedef float f32x16 __attribute__((ext_vector_type(16)));
typedef unsigned u32x4 __attribute__((ext_vector_type(4)));
typedef unsigned u32x2 __attribute__((ext_vector_type(2)));
typedef float f32x2_t __attribute__((ext_vector_type(2)));
typedef __bf16 bf16x2_t __attribute__((ext_vector_type(2)));

constexpr int D = 1024, NB = 8, SEQ = 4096, CTX = 256, FF = 4096;
constexpr int ML = NB * SEQ, MC = NB * CTX, MT = ML + MC;
constexpr size_t MiB = 1u << 20;
constexpr size_t WS_MOD = 0, WS_ZF = 1 * MiB, WS_RK = 9 * MiB, WS_LR = 14 * MiB, WS_W = 20 * MiB, WS_H2 = 56 * MiB, WS_BIG = 192 * MiB, WS_G = 430 * MiB;
constexpr size_t W_MIX = WS_W, W_O = WS_W + 14 * MiB, W_G2 = WS_W + 16 * MiB, W_1 = WS_W + 17 * MiB, W_2 = WS_W + 25 * MiB;
constexpr int LDS_BYTES = 147456;
constexpr int NTHREADS = 512;

struct Args { const float* in[35]; float* out; unsigned char* ws; int lo, hi; };

DI float bf2f(bf16_t v) { return __uint_as_float(((unsigned)v) << 16); }
DI unsigned cvtpk(float lo, float hi) { f32x2_t v = {lo, hi}; bf16x2_t b = __builtin_convertvector(v, bf16x2_t); return __builtin_bit_cast(unsigned, b); }
DI bf16_t f2bf(float x) { return (bf16_t)(cvtpk(x, 0.f) & 0xffffu); }
DI float wave_sum(float v) {
#pragma unroll
    for (int o = 1; o < 64; o <<= 1) v += __shfl_xor(v, o);
    return v;
}
DI float sigmoidf_(float x) { return 1.f / (1.f + __expf(-x)); }
DI float softplusf_(float x) { return fmaxf(x, 0.f) + log1pf(__expf(-fabsf(x))); }
DI int crow(int i, int h) { return (i & 3) + 8 * (i >> 2) + 4 * h; }
#define MFMA32(a, b, c) __builtin_amdgcn_mfma_f32_32x32x16_bf16((a), (b), (c), 0, 0, 0)

DI void mma_tile(f32x16& acc, const bf16_t* A, int lda, const bf16_t* Bt, int ldb, int ksteps, int lane) {
    const int rho = lane & 31, h = lane >> 5;
    const bf16_t* ap = A + rho * lda + 8 * h; const bf16_t* bp = Bt + rho * ldb + 8 * h;
    for (int s = 0; s < ksteps; ++s) {
        bf16x8 av = *(const bf16x8*)(ap + 16 * s); bf16x8 bv = *(const bf16x8*)(bp + 16 * s);
        acc = MFMA32(av, bv, acc);
    }
}

template <class Inner> struct Epi {
    static constexpr bool PERM = true, AFTER_DRAIN = false;
    Inner in;
    DI void operator()(const pg8::f32x4 (&acc)[2][2][4][2], const pg8::Unit& u, int wr, int wc, int fr, int fq) const {
        const int row0 = u.pm * 256 + wr * 64 + fr, col0 = u.pn * 256 + wc * 32 + 8 * fq;
#pragma unroll
        for (int ai = 0; ai < 2; ++ai)
#pragma unroll
            for (int m = 0; m < 4; ++m) {
                const int row = row0 + ai * 128 + m * 16;
#pragma unroll
                for (int bj = 0; bj < 2; ++bj) in.store8(row, col0 + bj * 128, acc[ai][bj][m][0], acc[ai][bj][m][1]);
            }
    }
};
DI u32x4 pack8(f32x4 a, f32x4 b) { u32x4 w; w.x = cvtpk(a[0], a[1]); w.y = cvtpk(a[2], a[3]); w.z = cvtpk(b[0], b[1]); w.w = cvtpk(b[2], b[3]); return w; }

template <int ACT> struct InStore {
    bf16_t* O; int ldc;
    DI void store8(int row, int col, f32x4 a, f32x4 b) const {
        if (ACT == 1) {
#pragma unroll
            for (int j = 0; j < 4; ++j) { float x = fmaxf(a[j], 0.f); a[j] = x * x; float y = fmaxf(b[j], 0.f); b[j] = y * y; }
        }
        *(u32x4*)(O + (size_t)row * ldc + col) = pack8(a, b);
    }
};
struct InNaQkv {
    bf16_t* QK; bf16_t* VTL; bf16_t* VTC;
    DI void store8(int row, int col, f32x4 a, f32x4 b) const {
        if (col < 2048) {
            const float sc = col < 1024 ? 0.125f : 1.f;
            *(u32x4*)(QK + (size_t)row * 2048 + col) = pack8(a * sc, b * sc);
        } else {
            const int c = col - 2048, hd = c >> 6, d0 = c & 63;
            bf16_t* p; size_t ld;
            if (row < ML) { const int b_ = row >> 12, t = row & 4095; p = VTL + ((size_t)((b_ * 16 + hd) * 64 + d0)) * 4096 + t; ld = 4096; }
            else { const int r2 = row - ML, b_ = r2 >> 8, t = r2 & 255; p = VTC + ((size_t)((b_ * 16 + hd) * 64 + d0)) * 256 + t; ld = 256; }
#pragma unroll
            for (int j = 0; j < 4; ++j) { p[(size_t)j * ld] = f2bf(a[j]); p[(size_t)(j + 4) * ld] = f2bf(b[j]); }
        }
    }
};
struct InResid {
    const float* sl; const float* sc; float* dl; float* dc; const float* gate;
    DI void store8(int row, int col, f32x4 a, f32x4 b) const {
        const float* s; float* d; int mi;
        if (row < ML) { s = sl + (size_t)row * 1024 + col; d = dl + (size_t)row * 1024 + col; mi = row >> 12; }
        else { s = sc + (size_t)(row - ML) * 1024 + col; d = dc + (size_t)(row - ML) * 1024 + col; mi = 8; }
        const float* g = gate + (size_t)mi * 6144 + col;
        const f32x4 g0 = *(const f32x4*)g, g1 = *(const f32x4*)(g + 4);
        const f32x4 x0 = *(const f32x4*)s, x1 = *(const f32x4*)(s + 4);
        *(f32x4*)d = x0 + g0 * a; *(f32x4*)(d + 4) = x1 + g1 * b;
    }
};
struct InGlaIn {
    bf16_t* P; float* LR;
    DI void store8(int row, int col, f32x4 a, f32x4 b) const {
        if (col < 3072) {
            const float sc = col < 512 ? 0.08838834764831845f : 1.f;
            *(u32x4*)(P + (size_t)row * 3072 + col) = pack8(a * sc, b * sc);
        } else if (col < 3104) {
            float* p = LR + (size_t)row * 32 + (col - 3072);
            *(f32x4*)p = a; *(f32x4*)(p + 4) = b;
        }
    }
};
struct InRwL1 {
    bf16_t* RKV; bf16_t* SG; bf16_t* TWAA;
    DI void store8(int row, int col, f32x4 a, f32x4 b) const {
        if (col < 3072) { *(u32x4*)(RKV + (size_t)row * 3072 + col) = pack8(a, b); }
        else if (col < 3328) {
#pragma unroll
            for (int j = 0; j < 4; ++j) { a[j] = sigmoidf_(a[j]); b[j] = sigmoidf_(b[j]); }
            *(u32x4*)(SG + (size_t)row * 256 + (col - 3072)) = pack8(a, b);
        } else {
            const int c = col - 3328;
            if (c < 128) {
#pragma unroll
                for (int j = 0; j < 4; ++j) { a[j] = tanhf(a[j]); b[j] = tanhf(b[j]); }
            }
            *(u32x4*)(TWAA + (size_t)row * 256 + c) = pack8(a, b);
        }
    }
};

template <class Inner> DI void run_gemm(LAS unsigned char* lds, const bf16_t* A, const bf16_t* Bt, int M, int N, int K, const Inner& in) {
    int Kr = K; asm volatile("" : "+s"(Kr));
    pg8::Gemm g{A, Bt, M, N, Kr}; pg8::StaticOrder S; S.init(M, N, (int)gridDim.x, (int)blockIdx.x);
    Epi<Inner> E{in};
#ifndef NO_GEMM
    pg8::gemm_phase<Epi<Inner>, pg8::StaticOrder, true, true>(lds, g, S, E);
#endif
    __syncthreads();
}

DI void conv_item(const float* W, int ldw, int Kv, int Nv, const float* mix, int mode, bf16_t* WT, int ldt, int row_off, int col_off, float* scr, int kb, int nb, int lane) {
    const int k0 = 64 * kb, n0 = 32 * nb;
#pragma unroll 8
    for (int i = 0; i < 32; ++i) {
        const int kk = 2 * i + (lane >> 5), k = k0 + kk, n = n0 + (lane & 31);
        float v = (k < Kv && n < Nv) ? W[(size_t)k * ldw + n] : 0.f;
        if (mode) { const float m = (k < Kv) ? mix[k] : 0.f; v *= (mode == 1) ? (1.f - m) : m; }
        scr[kk * 33 + (lane & 31)] = v;
    }
    __builtin_amdgcn_s_waitcnt(0xc07f); __builtin_amdgcn_wave_barrier();
    const int c = lane & 7;
#pragma unroll
    for (int j = 0; j < 4; ++j) {
        const int n = (lane >> 3) + 8 * j; const float* s = scr + (8 * c) * 33 + n;
        u32x4 o; o.x = cvtpk(s[0 * 33], s[1 * 33]); o.y = cvtpk(s[2 * 33], s[3 * 33]); o.z = cvtpk(s[4 * 33], s[5 * 33]); o.w = cvtpk(s[6 * 33], s[7 * 33]);
        *(u32x4*)(WT + (size_t)(row_off + n0 + n) * ldt + col_off + k0 + 8 * c) = o;
    }
    __builtin_amdgcn_s_waitcnt(0xc07f); __builtin_amdgcn_wave_barrier();
}
DI void conv_job(const float* W, int ldw, int Kv, int Nv, int Kp, int Np, const float* mix, int mode, bf16_t* WT, int ldt, int row_off, int col_off, float* scr, int gw, int ngw, int lane) {
    const int nkb = Kp / 64, nnb = Np / 32, nit = nkb * nnb;
    for (int it = gw; it < nit; it += ngw) conv_item(W, ldw, Kv, Nv, mix, mode, WT, ldt, row_off, col_off, scr, it / nnb, it % nnb, lane);
}

DI void norm_row(const float* xr, const f32x4 (&gs)[4], const f32x4 (&sh)[4], int lane, f32x4 (&out)[4]) {
    f32x4 v[4]; float s = 0.f;
#pragma unroll
    for (int j = 0; j < 4; ++j) { v[j] = *(const f32x4*)(xr + 4 * lane + 256 * j); s += (v[j].x * v[j].x + v[j].y * v[j].y) + (v[j].z * v[j].z + v[j].w * v[j].w); }
    s = wave_sum(s);
    const float rinv = rsqrtf(s * (1.f / 1024.f) + 1e-6f);
#pragma unroll
    for (int j = 0; j < 4; ++j) out[j] = v[j] * rinv * gs[j] + sh[j];
}
DI void store_row_bf16(bf16_t* o, const f32x4 (&v)[4], int lane) {
#pragma unroll
    for (int j = 0; j < 4; ++j) { u32x2 w; w.x = cvtpk(v[j].x, v[j].y); w.y = cvtpk(v[j].z, v[j].w); *(u32x2*)(o + 4 * lane + 256 * j) = w; }
}
DI void phase_prenorm(const float* xl, const float* xc, const float* g, const float* modl  , int shift_chunk, bf16_t* H, int ldh, bool with_hs, int Mrows, int gw, int ngw, int lane) {
    const int nstrips = Mrows / 8;
    for (int st = gw; st < nstrips; st += ngw) {
        const int row0 = 8 * st;
        int mi, seg0, seg1;
        if (row0 < ML) { mi = row0 >> 12; seg0 = row0 & ~4095; seg1 = seg0 + 4096; } else { mi = 8; seg0 = ML + ((row0 - ML) & ~255); seg1 = seg0 + 256; }
        const float* mp = modl + (size_t)mi * 6144 + shift_chunk * 1024;
        f32x4 gs[4], sh[4];
#pragma unroll
        for (int j = 0; j < 4; ++j) { const int c = 4 * lane + 256 * j; sh[j] = *(const f32x4*)(mp + c); const f32x4 sc = *(const f32x4*)(mp + 1024 + c); gs[j] = *(const f32x4*)(g + c) * (sc + 1.f); }
#define XROW(r) ((r) < ML ? xl + (size_t)(r) * 1024 : xc + (size_t)((r) - ML) * 1024)
        if (!with_hs) {
            for (int r = row0; r < row0 + 8; ++r) { f32x4 o[4]; norm_row(XROW(r), gs, sh, lane, o); store_row_bf16(H + (size_t)r * ldh, o, lane); }
        } else {
            f32x4 prev[4], cur[4], nxt[4];
            if (row0 > seg0) norm_row(XROW(row0 - 1), gs, sh, lane, prev); else { for (int j = 0; j < 4; ++j) prev[j] = (f32x4){0.f, 0.f, 0.f, 0.f}; }
            norm_row(XROW(row0), gs, sh, lane, cur);
            for (int r = row0; r < row0 + 8; ++r) {
                if (r + 1 < seg1) norm_row(XROW(r + 1), gs, sh, lane, nxt); else { for (int j = 0; j < 4; ++j) nxt[j] = (f32x4){0.f, 0.f, 0.f, 0.f}; }
                store_row_bf16(H + (size_t)r * ldh, cur, lane);
                f32x4 hs[4];
#pragma unroll
                for (int j = 0; j < 4; ++j) hs[j] = (prev[j] + nxt[j]) * 0.5f;
                store_row_bf16(H + (size_t)r * ldh + 1024, hs, lane);
#pragma unroll
                for (int j = 0; j < 4; ++j) { prev[j] = cur[j]; cur[j] = nxt[j]; }
            }
        }
#undef XROW
    }
}

DI void phase_mod(const Args& a, float* lds, int tid) {
    float* sc = lds;
    float* red = lds + 1024 * 12;
    const float* c = a.in[1]; const float* cctx = a.in[3]; const float* ada_w = a.in[4]; const float* ada_b = a.in[5];
    float* mod = (float*)(a.ws + WS_MOD);
    for (int idx = tid; idx < 9 * 1024; idx += NTHREADS) { const int j = idx >> 10, k = idx & 1023; const float v = j < 8 ? c[j * 1024 + k] : cctx[k]; sc[k * 12 + j] = v * sigmoidf_(v); }
    __syncthreads();
    for (int unit = blockIdx.x; unit < 384; unit += gridDim.x) {
        const int l = unit / 96, n0 = (unit % 96) * 64, col = tid & 63, ks = tid >> 6;
        const float* w = ada_w + ((size_t)l * 1024 + ks * 128) * 6144 + n0 + col;
        float acc[9];
#pragma unroll
        for (int j = 0; j < 9; ++j) acc[j] = 0.f;
#pragma unroll 8
        for (int kk = 0; kk < 128; ++kk) {
            const float wv = w[(size_t)kk * 6144]; const float* s = sc + (ks * 128 + kk) * 12;
            const f32x4 s0 = *(const f32x4*)s, s1 = *(const f32x4*)(s + 4); const float s8 = s[8];
            acc[0] += s0.x * wv; acc[1] += s0.y * wv; acc[2] += s0.z * wv; acc[3] += s0.w * wv;
            acc[4] += s1.x * wv; acc[5] += s1.y * wv; acc[6] += s1.z * wv; acc[7] += s1.w * wv; acc[8] += s8 * wv;
        }
#pragma unroll
        for (int j = 0; j < 9; ++j) red[(ks * 9 + j) * 64 + col] = acc[j];
        __syncthreads();
        for (int idx = tid; idx < 576; idx += NTHREADS) {
            const int j = idx >> 6, cc = idx & 63; float s = ada_b[l * 6144 + n0 + cc];
#pragma unroll
            for (int k2 = 0; k2 < 8; ++k2) s += red[(k2 * 9 + j) * 64 + cc];
            mod[((size_t)(l * 9 + j)) * 6144 + n0 + cc] = s;
        }
        __syncthreads();
    }
}

DI void attn_unit(const bf16_t* QK, const bf16_t* VTL, const bf16_t* VTC, bf16_t* O, const float* rpb, int b, int hd, int r, int cq, int lane) {
    const int n = lane & 31, h = lane >> 5;
    const bool lat = r >= 0;
    const int qrow0 = lat ? b * 4096 + r * 64 : ML + b * 256 + cq * 64;
    const int pin = (n & 0x13) | ((n & 4) << 1) | ((n & 8) >> 1);
    bf16x8 bq[2][4];
#pragma unroll
    for (int qb = 0; qb < 2; ++qb)
#pragma unroll
        for (int s = 0; s < 4; ++s) bq[qb][s] = *(const bf16x8*)(QK + (size_t)(qrow0 + 32 * qb + n) * 2048 + hd * 64 + 32 * h + 8 * s);
    f32x16 o[2][2];
#pragma unroll
    for (int x = 0; x < 2; ++x)
#pragma unroll
        for (int y = 0; y < 2; ++y)
#pragma unroll
            for (int i = 0; i < 16; ++i) o[x][y][i] = 0.f;
    float mrun[2] = {-1e30f, -1e30f}, lrun[2] = {0.f, 0.f};
    const int r0 = lat ? min(max(r - 4, 0), 56) : 0;
    const int nblk = lat ? 24 : 8;
    const bf16_t* vtc = VTC + (size_t)((b * 16 + hd) * 64) * 256;
    const bf16_t* vtl = VTL + (size_t)((b * 16 + hd) * 64) * 4096;
    for (int blk = 0; blk < nblk; ++blk) {
        int krow0, ldv, kc0 = 0, ridx = 0; const bf16_t* vt;
        const bool lb_ = blk >= 8;
        if (!lb_) { krow0 = ML + b * 256 + blk * 32; vt = vtc + blk * 32; ldv = 256; }
        else { const int lb = blk - 8, kr = r0 + (lb >> 1); kc0 = (lb & 1) * 32; krow0 = b * 4096 + kr * 64 + kc0; vt = vtl + kr * 64 + kc0; ldv = 4096; ridx = kr - r + 7; }
        bf16x8 ka[4];
#pragma unroll
        for (int s = 0; s < 4; ++s) ka[s] = *(const bf16x8*)(QK + (size_t)(krow0 + pin) * 2048 + 1024 + hd * 64 + 32 * h + 8 * s);
        bf16x8 va[2][2];
#pragma unroll
        for (int db = 0; db < 2; ++db)
#pragma unroll
            for (int s2 = 0; s2 < 2; ++s2) va[db][s2] = *(const bf16x8*)(vt + (size_t)(32 * db + n) * ldv + 16 * s2 + 8 * h);
        f32x16 sa[2];
#pragma unroll
        for (int qb = 0; qb < 2; ++qb) {
#pragma unroll
            for (int i = 0; i < 16; ++i) sa[qb][i] = 0.f;
#pragma unroll
            for (int s = 0; s < 4; ++s) sa[qb] = MFMA32(ka[s], bq[qb][s], sa[qb]);
        }
        bf16x8 pb[2][2];
#pragma unroll
        for (int qb = 0; qb < 2; ++qb) {
            if (lb_) {
                const int qc = 32 * qb + n, cs = min(max(qc - 8, 0), 48);
                const float* bp = rpb + (hd * 15 + ridx) * 31;
#pragma unroll
                for (int i = 0; i < 16; ++i) {
                    const int kc = kc0 + (i & 7) + 8 * h + 16 * (i >> 3);
                    const bool ok = (unsigned)(kc - cs) < 16u;
                    const int ci = min(max(kc - qc + 15, 0), 30);
                    const float bv = bp[ci];
                    sa[qb][i] = ok ? sa[qb][i] + bv : -1e30f;
                }
            }
            float bm = sa[qb][0];
#pragma unroll
            for (int i = 1; i < 16; ++i) bm = fmaxf(bm, sa[qb][i]);
            bm = fmaxf(bm, __shfl_xor(bm, 32));
            const float mnew = fmaxf(mrun[qb], bm);
            const float alpha = __expf(mrun[qb] - mnew);
            mrun[qb] = mnew;
            float ps = 0.f;
#pragma unroll
            for (int i = 0; i < 16; ++i) { const float p = __expf(sa[qb][i] - mnew); sa[qb][i] = p; ps += p; }
            lrun[qb] = lrun[qb] * alpha + ps;
#pragma unroll
            for (int db = 0; db < 2; ++db)
#pragma unroll
                for (int i = 0; i < 16; ++i) o[db][qb][i] *= alpha;
#pragma unroll
            for (int s2 = 0; s2 < 2; ++s2) {
                u32x4 w; w.x = cvtpk(sa[qb][8 * s2 + 0], sa[qb][8 * s2 + 1]); w.y = cvtpk(sa[qb][8 * s2 + 2], sa[qb][8 * s2 + 3]);
                w.z = cvtpk(sa[qb][8 * s2 + 4], sa[qb][8 * s2 + 5]); w.w = cvtpk(sa[qb][8 * s2 + 6], sa[qb][8 * s2 + 7]);
                pb[qb][s2] = __builtin_bit_cast(bf16x8, w);
            }
        }
#pragma unroll
        for (int db = 0; db < 2; ++db)
#pragma unroll
            for (int qb = 0; qb < 2; ++qb)
#pragma unroll
                for (int s2 = 0; s2 < 2; ++s2) o[db][qb] = MFMA32(va[db][s2], pb[qb][s2], o[db][qb]);
    }
#pragma unroll
    for (int qb = 0; qb < 2; ++qb) {
        const float lt = lrun[qb] + __shfl_xor(lrun[qb], 32);
        const float inv = 1.f / lt;
        bf16_t* op = O + (size_t)(qrow0 + 32 * qb + n) * 1024 + hd * 64;
#pragma unroll
        for (int db = 0; db < 2; ++db)
#pragma unroll
            for (int g = 0; g < 4; ++g) {
                u32x2 w; w.x = cvtpk(o[db][qb][4 * g] * inv, o[db][qb][4 * g + 1] * inv); w.y = cvtpk(o[db][qb][4 * g + 2] * inv, o[db][qb][4 * g + 3] * inv);
                *(u32x2*)(op + 32 * db + 8 * g + 4 * h) = w;
            }
    }
}

DI void gla_unit(const bf16_t* P, const float* LR, const float* wdec, const float* bdec, bf16_t* OUT  , unsigned char* lds, int unit, int tid) {
    const int lane = tid & 63, wid = __builtin_amdgcn_readfirstlane(tid >> 6);
    const int vs = unit & 3, dir = (unit >> 2) & 1, hd = (unit >> 3) & 3, b = unit >> 5;
    bf16_t* QE = (bf16_t*)lds;
    bf16_t* KE = QE + 64 * 136;
    bf16_t* ST = KE + 64 * 136;
    bf16_t* KDT = ST + 64 * 136;
    bf16_t* VT = KDT + 128 * 72;
    bf16_t* AM = VT + 64 * 72;
    float* Bc = (float*)(AM + 64 * 72);
    float* LRs = Bc + 64 * 128;
    float* GRP = LRs + 64 * 16;
    float* DEC = GRP + 4 * 128;
    const int dcol = tid & 127, lg = tid >> 7;
    float wd[16];
#pragma unroll
    for (int r = 0; r < 16; ++r) wd[r] = wdec[(dir * 16 + r) * 512 + hd * 128 + dcol];
    const float bd = bdec[dir * 512 + hd * 128 + dcol];
    const int col_q = hd * 128, col_k = 512 + hd * 128, col_v = 1024 + hd * 256 + vs * 64;
    f32x16 st;
#pragma unroll
    for (int i = 0; i < 16; ++i) st[i] = 0.f;
    const int svt = wid >> 2, sdt = wid & 3, rho = lane & 31, hh = lane >> 5;
    bf16_t* outp = OUT + (size_t)dir * MT * 1024;
    for (int side = 0; side < 2; ++side) {
        const int T = side == 0 ? 256 : 4096, base = side == 0 ? ML + b * 256 : b * 4096, nch = T / 64;
        for (int n = 0; n < nch; ++n) {
#define GROW(l) (base + (dir ? (T - 1 - (n * 64 + (l))) : (n * 64 + (l))))
            { const int idx = tid * 2, l = idx >> 4, r = idx & 15; const float* p = LR + (size_t)GROW(l) * 32 + dir * 16 + r; LRs[l * 16 + r] = p[0]; LRs[l * 16 + r + 1] = p[1]; }
            __syncthreads();
            { float run = 0.f;
              for (int li = 0; li < 16; ++li) { const int l = 16 * lg + li; float z = bd;
#pragma unroll
                  for (int r = 0; r < 16; ++r) z += LRs[l * 16 + r] * wd[r];
                  const float g = -softplusf_(-z) * (1.f / 16.f); run += g; Bc[l * 128 + dcol] = run; }
              GRP[lg * 128 + dcol] = run; }
            __syncthreads();
            { float off = 0.f, blast = 0.f;
#pragma unroll
              for (int g2 = 0; g2 < 4; ++g2) { const float t = GRP[g2 * 128 + dcol]; blast += t; if (g2 < lg) off += t; }
              if (lg == 0) DEC[dcol] = __expf(blast);
              for (int li = 0; li < 16; ++li) { const int l = 16 * lg + li; const float bv = Bc[l * 128 + dcol] + off; const size_t ro = (size_t)GROW(l) * 3072;
                  const float qv = bf2f(P[ro + col_q + dcol]), kv = bf2f(P[ro + col_k + dcol]);
                  QE[l * 136 + dcol] = f2bf(qv * __expf(bv)); KE[l * 136 + dcol] = f2bf(kv * __expf(-bv)); KDT[dcol * 72 + l] = f2bf(kv * __expf(blast - bv)); }
              { const int l = tid >> 3, v0 = (tid & 7) * 8; const bf16x8 vv = *(const bf16x8*)(P + (size_t)GROW(l) * 3072 + col_v + v0);
#pragma unroll
                for (int e = 0; e < 8; ++e) VT[(v0 + e) * 72 + l] = (bf16_t)vv[e]; }
#pragma unroll
              for (int i = 0; i < 16; ++i) ST[(32 * svt + crow(i, hh)) * 136 + 32 * sdt + rho] = f2bf(st[i]);
            }
            __syncthreads();
            if (wid < 4) { const int lt = wid >> 1, mt = wid & 1; f32x16 acc;
#pragma unroll
                for (int i = 0; i < 16; ++i) acc[i] = 0.f;
                mma_tile(acc, QE + 32 * lt * 136, 136, KE + 32 * mt * 136, 136, 8, lane);
#pragma unroll
                for (int i = 0; i < 16; ++i) { const int l = 32 * lt + crow(i, hh), m = 32 * mt + rho; AM[l * 72 + m] = f2bf(m <= l ? acc[i] : 0.f); } }
            __syncthreads();
            if (wid < 4) { const int lt = wid >> 1, vt2 = wid & 1; f32x16 acc;
#pragma unroll
                for (int i = 0; i < 16; ++i) acc[i] = 0.f;
                mma_tile(acc, AM + 32 * lt * 72, 72, VT + 32 * vt2 * 72, 72, 4, lane);
                mma_tile(acc, QE + 32 * lt * 136, 136, ST + 32 * vt2 * 136, 136, 8, lane);
#pragma unroll
                for (int i = 0; i < 16; ++i) { const int l = 32 * lt + crow(i, hh); outp[(size_t)GROW(l) * 1024 + hd * 256 + vs * 64 + 32 * vt2 + rho] = f2bf(acc[i]); } }
            { const float dc = DEC[32 * sdt + rho];
#pragma unroll
              for (int i = 0; i < 16; ++i) st[i] *= dc;
              mma_tile(st, VT + 32 * svt * 72, 72, KDT + 32 * sdt * 72, 72, 4, lane); }
            __syncthreads();
#undef GROW
        }
    }
}
DI void gla_finish(bf16_t* OF, const bf16_t* OB, const bf16_t* P, const float* ng, int Mrows, int gw, int ngw, int lane) {
    for (int row = gw; row < Mrows; row += ngw) {
        const int c0 = 16 * lane;
        const bf16x8 a0 = *(const bf16x8*)(OF + (size_t)row * 1024 + c0), a1 = *(const bf16x8*)(OF + (size_t)row * 1024 + c0 + 8);
        const bf16x8 b0 = *(const bf16x8*)(OB + (size_t)row * 1024 + c0), b1 = *(const bf16x8*)(OB + (size_t)row * 1024 + c0 + 8);
        const bf16x8 g0 = *(const bf16x8*)(P + (size_t)row * 3072 + 2048 + c0), g1 = *(const bf16x8*)(P + (size_t)row * 3072 + 2048 + c0 + 8);
        float o[16]; float ss = 0.f;
#pragma unroll
        for (int e = 0; e < 8; ++e) { o[e] = bf2f((bf16_t)a0[e]) + bf2f((bf16_t)b0[e]); o[8 + e] = bf2f((bf16_t)a1[e]) + bf2f((bf16_t)b1[e]); }
#pragma unroll
        for (int e = 0; e < 16; ++e) ss += o[e] * o[e];
        ss += __shfl_xor(ss, 1); ss += __shfl_xor(ss, 2); ss += __shfl_xor(ss, 4); ss += __shfl_xor(ss, 8);
        const float rinv = rsqrtf(ss * (1.f / 256.f) + 1e-6f);
        float y[16];
#pragma unroll
        for (int e = 0; e < 16; ++e) { const float gt = bf2f((bf16_t)(e < 8 ? g0[e] : g1[e - 8])); y[e] = o[e] * rinv * ng[(c0 + e) & 255] * (gt * sigmoidf_(gt)); }
        u32x4 w0, w1; w0.x = cvtpk(y[0], y[1]); w0.y = cvtpk(y[2], y[3]); w0.z = cvtpk(y[4], y[5]); w0.w = cvtpk(y[6], y[7]);
        w1.x = cvtpk(y[8], y[9]); w1.y = cvtpk(y[10], y[11]); w1.z = cvtpk(y[12], y[13]); w1.w = cvtpk(y[14], y[15]);
        *(u32x4*)(OF + (size_t)row * 1024 + c0) = w0; *(u32x4*)(OF + (size_t)row * 1024 + c0 + 8) = w1;
    }
}

DI void rwkv_unit(const Args& a, const bf16_t* RKV, const bf16_t* TWAA, bf16_t* Y  , float* RK  , unsigned char* lds, int unit, int tid) {
    const int lane = tid & 63, wid = __builtin_amdgcn_readfirstlane(tid >> 6);
    const int dir = unit & 1, hd = (unit >> 1) & 15, b = unit >> 5;
    bf16_t* W2T = (bf16_t*)lds;
    bf16_t* A2T = W2T + 64 * 72;
    bf16_t* TWs = A2T + 64 * 72;
    bf16_t* AAs = TWs + 32 * 72;
    float* ZW = (float*)(AAs + 32 * 72);
    float* ZA = ZW + 2048;
    float* SW = ZA + 2048; float* SKD = SW + 2048; float* SBB = SKD + 2048; float* SNK = SBB + 2048; float* SR = SNK + 2048; float* SV = SR + 2048;
    float* XCH = SV + 2048;
    float* YC = XCH + 2048;
    const float* w2 = a.in[23] + (size_t)dir * 64 * 1024; const float* a2 = a.in[26] + (size_t)dir * 64 * 1024;
    for (int e = 0; e < 8; ++e) { const int idx = tid + 512 * e, j = idx >> 6, c = idx & 63; W2T[c * 72 + j] = f2bf(w2[(size_t)j * 1024 + hd * 64 + c]); A2T[c * 72 + j] = f2bf(a2[(size_t)j * 1024 + hd * 64 + c]); }
    const int etok = tid >> 4, ec0 = (tid & 15) * 4;
    float cw0[4], ca0[4], ckk[4], cka[4], crk[4];
#pragma unroll
    for (int e = 0; e < 4; ++e) { const int c = hd * 64 + ec0 + e; cw0[e] = a.in[21][dir * 1024 + c]; ca0[e] = a.in[24][dir * 1024 + c]; ckk[e] = a.in[29][c]; cka[e] = a.in[30][c]; crk[e] = a.in[31][c]; }
    float s[8];
#pragma unroll
    for (int j = 0; j < 8; ++j) s[j] = 0.f;
    bf16_t* yout = Y + (size_t)dir * MT * 1024; float* rkout = RK + (size_t)dir * MT * 16;
    __syncthreads();
    for (int side = 0; side < 2; ++side) {
        const int T = side == 0 ? 256 : 4096, base = side == 0 ? ML + b * 256 : b * 4096, nch = T / 32;
        for (int n = 0; n < nch; ++n) {
#define RROW(l) (base + (dir ? (T - 1 - (n * 32 + (l))) : (n * 32 + (l))))
            const int erow = RROW(etok);
            { const bf16_t* p = TWAA + (size_t)erow * 256 + dir * 64 + ec0; *(u32x2*)(TWs + etok * 72 + ec0) = *(const u32x2*)p; *(u32x2*)(AAs + etok * 72 + ec0) = *(const u32x2*)(p + 128); }
            __syncthreads();
            if (wid < 4) { const int ct = wid & 1; f32x16 acc;
#pragma unroll
                for (int i = 0; i < 16; ++i) acc[i] = 0.f;
                mma_tile(acc, wid < 2 ? TWs : AAs, 72, (wid < 2 ? W2T : A2T) + 32 * ct * 72, 72, 4, lane);
                float* Z = wid < 2 ? ZW : ZA;
#pragma unroll
                for (int i = 0; i < 16; ++i) Z[crow(i, lane >> 5) * 64 + 32 * ct + (lane & 31)] = acc[i]; }
            __syncthreads();
            { const bf16_t* p = RKV + (size_t)erow * 3072 + hd * 64 + ec0;
              const u32x2 r2 = *(const u32x2*)p, k2 = *(const u32x2*)(p + 1024), v2 = *(const u32x2*)(p + 2048);
              float rv[4], kv[4], vv[4];
              rv[0] = __uint_as_float(r2.x << 16); rv[1] = __uint_as_float(r2.x & 0xffff0000u); rv[2] = __uint_as_float(r2.y << 16); rv[3] = __uint_as_float(r2.y & 0xffff0000u);
              kv[0] = __uint_as_float(k2.x << 16); kv[1] = __uint_as_float(k2.x & 0xffff0000u); kv[2] = __uint_as_float(k2.y << 16); kv[3] = __uint_as_float(k2.y & 0xffff0000u);
              vv[0] = __uint_as_float(v2.x << 16); vv[1] = __uint_as_float(v2.x & 0xffff0000u); vv[2] = __uint_as_float(v2.y << 16); vv[3] = __uint_as_float(v2.y & 0xffff0000u);
              float kkv[4], av[4], kd[4]; float ss = 0.f, rk = 0.f;
#pragma unroll
              for (int e = 0; e < 4; ++e) { kkv[e] = kv[e] * ckk[e]; ss += kkv[e] * kkv[e]; av[e] = sigmoidf_(ca0[e] + ZA[etok * 64 + ec0 + e]); kd[e] = kv[e] * (1.f + (av[e] - 1.f) * cka[e]); rk += rv[e] * kd[e] * crk[e]; }
              ss += __shfl_xor(ss, 1); ss += __shfl_xor(ss, 2); ss += __shfl_xor(ss, 4); ss += __shfl_xor(ss, 8);
              rk += __shfl_xor(rk, 1); rk += __shfl_xor(rk, 2); rk += __shfl_xor(rk, 4); rk += __shfl_xor(rk, 8);
              const float kinv = rsqrtf(fmaxf(ss, 1e-24f));
              if ((tid & 15) == 0) rkout[(size_t)erow * 16 + hd] = rk;
#pragma unroll
              for (int e = 0; e < 4; ++e) { const int o = etok * 64 + ec0 + e; const float kn = kkv[e] * kinv;
                  const float wl = -softplusf_(-(cw0[e] + ZW[o])) - 0.5f;
                  SW[o] = __expf(-__expf(wl)); SKD[o] = kd[e]; SBB[o] = kn * av[e]; SNK[o] = -kn; SR[o] = rv[e]; SV[o] = vv[e]; }
            }
            __syncthreads();
            { float yp = 0.f;
              for (int t = 0; t < 32; ++t) {
                  const int o = t * 64 + 8 * wid;
                  const f32x4 nk0 = *(const f32x4*)(SNK + o), nk1 = *(const f32x4*)(SNK + o + 4);
                  const f32x4 w0 = *(const f32x4*)(SW + o), w1 = *(const f32x4*)(SW + o + 4);
                  const f32x4 b0 = *(const f32x4*)(SBB + o), b1 = *(const f32x4*)(SBB + o + 4);
                  const f32x4 k0 = *(const f32x4*)(SKD + o), k1 = *(const f32x4*)(SKD + o + 4);
                  const f32x4 r0 = *(const f32x4*)(SR + o), r1 = *(const f32x4*)(SR + o + 4);
                  const float vi = SV[t * 64 + lane];
                  const float sap = (s[0] * nk0.x + s[1] * nk0.y) + (s[2] * nk0.z + s[3] * nk0.w) + (s[4] * nk1.x + s[5] * nk1.y) + (s[6] * nk1.z + s[7] * nk1.w);
                  float* x = XCH + (t & 1) * 1024;
                  x[wid * 64 + lane] = sap; x[(8 + wid) * 64 + lane] = yp;
                  __syncthreads();
                  float sa = 0.f;
#pragma unroll
                  for (int w = 0; w < 8; ++w) sa += x[w * 64 + lane];
                  if (t > 0 && wid == ((t - 1) & 7)) { float ys = 0.f;
#pragma unroll
                      for (int w = 0; w < 8; ++w) ys += x[(8 + w) * 64 + lane];
                      YC[(t - 1) * 64 + lane] = ys; }
                  s[0] = s[0] * w0.x + sa * b0.x + vi * k0.x; s[1] = s[1] * w0.y + sa * b0.y + vi * k0.y; s[2] = s[2] * w0.z + sa * b0.z + vi * k0.z; s[3] = s[3] * w0.w + sa * b0.w + vi * k0.w;
                  s[4] = s[4] * w1.x + sa * b1.x + vi * k1.x; s[5] = s[5] * w1.y + sa * b1.y + vi * k1.y; s[6] = s[6] * w1.z + sa * b1.z + vi * k1.z; s[7] = s[7] * w1.w + sa * b1.w + vi * k1.w;
                  yp = (s[0] * r0.x + s[1] * r0.y) + (s[2] * r0.z + s[3] * r0.w) + (s[4] * r1.x + s[5] * r1.y) + (s[6] * r1.z + s[7] * r1.w);
              }
              XCH[(8 + wid) * 64 + lane] = yp;
              __syncthreads();
              if (wid == 7) { float ys = 0.f;
#pragma unroll
                  for (int w = 0; w < 8; ++w) ys += XCH[(8 + w) * 64 + lane];
                  YC[31 * 64 + lane] = ys; }
            }
            __syncthreads();
            { u32x2 w; w.x = cvtpk(YC[etok * 64 + ec0], YC[etok * 64 + ec0 + 1]); w.y = cvtpk(YC[etok * 64 + ec0 + 2], YC[etok * 64 + ec0 + 3]);
              *(u32x2*)(yout + (size_t)erow * 1024 + hd * 64 + ec0) = w; }
#undef RROW
        }
    }
    __syncthreads();
}
DI void rwkv_finish(bf16_t* YF, const bf16_t* YB, const bf16_t* RKV, const bf16_t* G, const float* RK, const float* lng, const float* lnb, int Mrows, int gw, int ngw, int lane) {
    for (int row = gw; row < Mrows; row += ngw) {
        const int c0 = 16 * lane, hd = lane >> 2;
        const bf16x8 a0 = *(const bf16x8*)(YF + (size_t)row * 1024 + c0), a1 = *(const bf16x8*)(YF + (size_t)row * 1024 + c0 + 8);
        const bf16x8 b0 = *(const bf16x8*)(YB + (size_t)row * 1024 + c0), b1 = *(const bf16x8*)(YB + (size_t)row * 1024 + c0 + 8);
        const bf16x8 v0 = *(const bf16x8*)(RKV + (size_t)row * 3072 + 2048 + c0), v1 = *(const bf16x8*)(RKV + (size_t)row * 3072 + 2048 + c0 + 8);
        const bf16x8 g0 = *(const bf16x8*)(G + (size_t)row * 1024 + c0), g1 = *(const bf16x8*)(G + (size_t)row * 1024 + c0 + 8);
        const float rk = RK[(size_t)row * 16 + hd] + RK[(size_t)MT * 16 + (size_t)row * 16 + hd];
        float y[16]; float sm = 0.f;
#pragma unroll
        for (int e = 0; e < 8; ++e) { y[e] = bf2f((bf16_t)a0[e]) + bf2f((bf16_t)b0[e]); y[8 + e] = bf2f((bf16_t)a1[e]) + bf2f((bf16_t)b1[e]); }
#pragma unroll
        for (int e = 0; e < 16; ++e) sm += y[e];
        sm += __shfl_xor(sm, 1); sm += __shfl_xor(sm, 2);
        const float mu = sm * (1.f / 64.f);
        float sv = 0.f;
#pragma unroll
        for (int e = 0; e < 16; ++e) { y[e] -= mu; sv += y[e] * y[e]; }
        sv += __shfl_xor(sv, 1); sv += __shfl_xor(sv, 2);
        const float rinv = rsqrtf(sv * (1.f / 64.f) + 64e-5f);
        float o[16];
#pragma unroll
        for (int e = 0; e < 16; ++e) { const float vv = bf2f((bf16_t)(e < 8 ? v0[e] : v1[e - 8])), gg = bf2f((bf16_t)(e < 8 ? g0[e] : g1[e - 8]));
            o[e] = (y[e] * rinv * lng[c0 + e] + lnb[c0 + e] + rk * vv) * gg; }
        u32x4 w0, w1; w0.x = cvtpk(o[0], o[1]); w0.y = cvtpk(o[2], o[3]); w0.z = cvtpk(o[4], o[5]); w0.w = cvtpk(o[6], o[7]);
        w1.x = cvtpk(o[8], o[9]); w1.y = cvtpk(o[10], o[11]); w1.z = cvtpk(o[12], o[13]); w1.w = cvtpk(o[14], o[15]);
        *(u32x4*)(YF + (size_t)row * 1024 + c0) = w0; *(u32x4*)(YF + (size_t)row * 1024 + c0 + 8) = w1;
    }
}

#define WSP(T, off) ((T*)(a.ws + (off)))
#define PHASE(k) if (lo <= (k) && (k) < hi)
#define SEAM(k) do { if ((k) + 1 < hi) grid.sync(); } while (0)
template <int L> DI void run_layer(const Args& a, unsigned char* lds, cg::grid_group& grid, int lo, int hi) {
    constexpr int kind = L % 3, jj = L / 3, P0 = 1 + 8 * L;
    constexpr bool need_ctx = L < 3;
    constexpr int Mact = need_ctx ? MT : ML;
    const int tid = threadIdx.x, lane = tid & 63, wid = __builtin_amdgcn_readfirstlane(tid >> 6);
    const int gw = blockIdx.x * 8 + wid, ngw = gridDim.x * 8;
    LAS unsigned char* ldsl = (LAS unsigned char*)lds;
    PHASE(P0 + 0) {
        float* scr = (float*)(lds + wid * 8704);
        const float* modl = WSP(float, WS_MOD) + (size_t)L * 9 * 6144;
        phase_prenorm(L == 0 ? a.in[0] : a.out, L == 0 ? a.in[2] : WSP(float, WS_ZF), a.in[6] + L * 1024, modl, 0, WSP(bf16_t, WS_H2), kind == 2 ? 2048 : 1024, kind == 2, MT, gw, ngw, lane);
        bf16_t* Wmix = WSP(bf16_t, W_MIX); bf16_t* Wo = WSP(bf16_t, W_O);
        conv_job(a.in[8] + (size_t)L * 1024 * 4096, 4096, 1024, 4096, 1024, 4096, nullptr, 0, WSP(bf16_t, W_1), 1024, 0, 0, scr, gw, ngw, lane);
        conv_job(a.in[9] + (size_t)L * 4096 * 1024, 1024, 4096, 1024, 4096, 1024, nullptr, 0, WSP(bf16_t, W_2), 4096, 0, 0, scr, gw, ngw, lane);
        if (kind == 0) {
            conv_job(a.in[11] + (size_t)jj * 1024 * 3072, 3072, 1024, 3072, 1024, 3072, nullptr, 0, Wmix, 1024, 0, 0, scr, gw, ngw, lane);
            conv_job(a.in[12] + (size_t)jj * 1024 * 1024, 1024, 1024, 1024, 1024, 1024, nullptr, 0, Wo, 1024, 0, 0, scr, gw, ngw, lane);
        } else if (kind == 1) {
            conv_job(a.in[14], 3104, 1024, 3104, 1024, 3328, nullptr, 0, Wmix, 1024, 0, 0, scr, gw, ngw, lane);
            conv_job(a.in[18], 1024, 1024, 1024, 1024, 1024, nullptr, 0, Wo, 1024, 0, 0, scr, gw, ngw, lane);
        } else {
            const float* mix = a.in[19];
            for (int md = 1; md <= 2; ++md) {
                const int co = (md - 1) * 1024;
                for (int q = 0; q < 3; ++q) conv_job(a.in[20] + (size_t)q * 1024 * 1024, 1024, 1024, 1024, 1024, 1024, mix + (q == 0 ? 0 : q + 1) * 1024, md, Wmix, 2048, q * 1024, co, scr, gw, ngw, lane);
                conv_job(a.in[27], 160, 1024, 160, 1024, 256, mix + 5 * 1024, md, Wmix, 2048, 3072, co, scr, gw, ngw, lane);
                for (int q = 0; q < 2; ++q) conv_job(a.in[22] + (size_t)q * 1024 * 64, 64, 1024, 64, 1024, 64, mix + 1 * 1024, md, Wmix, 2048, 3328 + 64 * q, co, scr, gw, ngw, lane);
                for (int q = 0; q < 2; ++q) conv_job(a.in[25] + (size_t)q * 1024 * 64, 64, 1024, 64, 1024, 64, mix + 4 * 1024, md, Wmix, 2048, 3456 + 64 * q, co, scr, gw, ngw, lane);
            }
            conv_job(a.in[28], 1024, 160, 1024, 256, 1024, nullptr, 0, WSP(bf16_t, W_G2), 256, 0, 0, scr, gw, ngw, lane);
            conv_job(a.in[34], 1024, 1024, 1024, 1024, 1024, nullptr, 0, Wo, 1024, 0, 0, scr, gw, ngw, lane);
        }
        SEAM(P0 + 0);
    }
    PHASE(P0 + 1) {
        bf16_t* BIG = WSP(bf16_t, WS_BIG);
        if (kind == 0) run_gemm(ldsl, WSP(bf16_t, WS_H2), WSP(bf16_t, W_MIX), MT, 3072, 1024, InNaQkv{BIG, BIG + (size_t)MT * 2048, BIG + (size_t)MT * 2048 + (size_t)ML * 1024});
        else if (kind == 1) run_gemm(ldsl, WSP(bf16_t, WS_H2), WSP(bf16_t, W_MIX), MT, 3328, 1024, InGlaIn{BIG, WSP(float, WS_LR)});
        else run_gemm(ldsl, WSP(bf16_t, WS_H2), WSP(bf16_t, W_MIX), MT, 3584, 2048, InRwL1{BIG, BIG + (size_t)MT * 3072, BIG + (size_t)MT * 3328});
        SEAM(P0 + 1);
    }
    PHASE(P0 + 2) {
        bf16_t* BIG = WSP(bf16_t, WS_BIG); bf16_t* H2 = WSP(bf16_t, WS_H2);
        if (kind == 0) {
            const bf16_t* VTL = BIG + (size_t)MT * 2048; const bf16_t* VTC = VTL + (size_t)ML * 1024;
            const float* rpb = a.in[13] + (size_t)jj * 16 * 15 * 31;
            const int nu = 8192 + (need_ctx ? 512 : 0);
#ifndef NO_ATTN
            for (int u = gw; u < nu; u += ngw) {
                if (u < 8192) attn_unit(BIG, VTL, VTC, H2, rpb, u >> 10, (u >> 6) & 15, u & 63, 0, lane);
                else { const int v = u - 8192; attn_unit(BIG, VTL, VTC, H2, rpb, v >> 6, (v >> 2) & 15, -1, v & 3, lane); }
            }
#endif
        } else if (kind == 1) {
#ifndef NO_GLA
            for (int u = blockIdx.x; u < 256; u += gridDim.x) gla_unit(BIG, WSP(float, WS_LR), a.in[15], a.in[16], H2, lds, u, tid);
#endif
        } else {
#ifndef NO_RWKV
            for (int u = blockIdx.x; u < 256; u += gridDim.x) rwkv_unit(a, BIG, BIG + (size_t)MT * 3328, H2, WSP(float, WS_RK), lds, u, tid);
#endif
            run_gemm(ldsl, BIG + (size_t)MT * 3072, WSP(bf16_t, W_G2), MT, 1024, 256, InStore<0>{WSP(bf16_t, WS_G), 1024});
        }
        SEAM(P0 + 2);
    }
    if (kind != 0) {
        PHASE(P0 + 3) {
            bf16_t* H2 = WSP(bf16_t, WS_H2);
            if (kind == 1) gla_finish(H2, H2 + (size_t)MT * 1024, WSP(bf16_t, WS_BIG), a.in[17], Mact, gw, ngw, lane);
            else rwkv_finish(H2, H2 + (size_t)MT * 1024, WSP(bf16_t, WS_BIG), WSP(bf16_t, WS_G), WSP(float, WS_RK), a.in[32], a.in[33], Mact, gw, ngw, lane);
            SEAM(P0 + 3);
        }
    }
    PHASE(P0 + 4) {
        run_gemm(ldsl, WSP(bf16_t, WS_H2), WSP(bf16_t, W_O), Mact, 1024, 1024, InResid{L == 0 ? a.in[0] : a.out, L == 0 ? a.in[2] : WSP(float, WS_ZF), a.out, WSP(float, WS_ZF), WSP(float, WS_MOD) + (size_t)L * 9 * 6144 + 2 * 1024});
        SEAM(P0 + 4);
    }
    PHASE(P0 + 5) {
        phase_prenorm(a.out, WSP(float, WS_ZF), a.in[7] + L * 1024, WSP(float, WS_MOD) + (size_t)L * 9 * 6144, 3, WSP(bf16_t, WS_H2), 1024, false, Mact, gw, ngw, lane);
        SEAM(P0 + 5);
    }
    PHASE(P0 + 6) {
        run_gemm(ldsl, WSP(bf16_t, WS_H2), WSP(bf16_t, W_1), Mact, 4096, 1024, InStore<1>{WSP(bf16_t, WS_BIG), 4096});
        SEAM(P0 + 6);
    }
    PHASE(P0 + 7) {
        run_gemm(ldsl, WSP(bf16_t, WS_BIG), WSP(bf16_t, W_2), Mact, 1024, 4096, InResid{a.out, WSP(float, WS_ZF), a.out, WSP(float, WS_ZF), WSP(float, WS_MOD) + (size_t)L * 9 * 6144 + 5 * 1024});
        SEAM(P0 + 7);
    }
}
__global__ void __launch_bounds__(NTHREADS, 2) mega(Args a) {
    extern __shared__ __attribute__((aligned(16))) unsigned char lds[];
    cg::grid_group grid = cg::this_grid();
    const int lo = a.lo, hi = a.hi;
    PHASE(0) { phase_mod(a, (float*)lds, threadIdx.x); SEAM(0); }
    run_layer<0>(a, lds, grid, lo, hi);
    run_layer<1>(a, lds, grid, lo, hi);
    run_layer<2>(a, lds, grid, lo, hi);
    run_layer<3>(a, lds, grid, lo, hi);
    PHASE(33) {
        const int tid = threadIdx.x, lane = tid & 63, wid = tid >> 6;
        const int gw = blockIdx.x * 8 + wid, ngw = gridDim.x * 8;
        const float* fg = a.in[10];
        for (int row = gw; row < ML; row += ngw) {
            float* xr = a.out + (size_t)row * 1024; f32x4 v[4]; float s = 0.f;
#pragma unroll
            for (int j = 0; j < 4; ++j) { v[j] = *(const f32x4*)(xr + 4 * lane + 256 * j); s += (v[j].x * v[j].x + v[j].y * v[j].y) + (v[j].z * v[j].z + v[j].w * v[j].w); }
            s = wave_sum(s); const float rinv = rsqrtf(s * (1.f / 1024.f) + 1e-6f);
#pragma unroll
            for (int j = 0; j < 4; ++j) *(f32x4*)(xr + 4 * lane + 256 * j) = v[j] * rinv * *(const f32x4*)(fg + 4 * lane + 256 * j);
        }
    }
}

#ifndef GM
#define GM 0xffff
#endif
#ifndef MULTI_LAUNCH
#define MULTI_LAUNCH 0
#endif
extern "C" void kernel_launch(void* const* d_in, const int* in_sizes, int n_in, void* d_out, int out_size, void* d_ws, size_t ws_size, hipStream_t stream) {
    static int grid_blocks = 0;
    if (!grid_blocks) {
        int dev = 0, cus = 0, per_cu = 0;
        hipGetDevice(&dev);
        hipDeviceGetAttribute(&cus, hipDeviceAttributeMultiprocessorCount, dev);
        hipFuncSetAttribute((const void*)mega, hipFuncAttributeMaxDynamicSharedMemorySize, LDS_BYTES);
        hipOccupancyMaxActiveBlocksPerMultiprocessor(&per_cu, (const void*)mega, NTHREADS, LDS_BYTES);
        if (per_cu < 1) per_cu = 1;
        grid_blocks = cus * per_cu;
    }
    Args a{};
    for (int i = 0; i < 35; ++i) a.in[i] = (const float*)d_in[i];
    a.out = (float*)d_out; a.ws = (unsigned char*)d_ws;
#if MULTI_LAUNCH
    for (int p = 0; p < 34; ++p) { a.lo = p; a.hi = p + 1; hipLaunchKernelGGL(mega, dim3(grid_blocks), dim3(NTHREADS), LDS_BYTES, stream, a); }
#else
    a.lo = 0; a.hi = 34;
    void* args[] = {&a};
    hipError_t e = hipLaunchCooperativeKernel((const void*)mega, dim3(grid_blocks), dim3(NTHREADS), args, LDS_BYTES, stream);
    if (e != hipSuccess) fprintf(stderr, "cooperative launch failed: %s (grid %d)\n", hipGetErrorString(e), grid_blocks);
#endif
}
```

```cpp
#include <hip/hip_runtime.h>
#include <hip/hip_cooperative_groups.h>
#include <cstdio>
#include <cstdint>
namespace cg = cooperative_groups;

namespace pg8 {
#define PG8_LAS __attribute__((address_space(3)))
typedef unsigned short bf16_t;
typedef short bf16x8 __attribute__((ext_vector_type(8)));
typedef float f32x4 __attribute__((ext_vector_type(4)));
typedef unsigned u32x4 __attribute__((ext_vector_type(4)));
constexpr int BM = 256, BK = 64, HALF = 128, HTB = HALF * BK * 2  , STAGE_BYTES = 8 * HTB, NXCD = 8, WGM = 8;

__host__ __device__ __forceinline__ int lds_byte(int r, int c) { const int st = (r >> 4) * 2 + (c >> 5), rr = r & 15, cc = c & 31, ob = rr * 64 + cc * 2; return st * 1024 + (ob ^ (((ob >> 9) & 1) << 5)); }
__host__ __device__ __forceinline__ void stage_rc(int b, int& R, int& C) { const int st = b / 1024, sb = b % 1024, swz = sb ^ (((sb >> 9) & 1) << 5); R = (st >> 1) * 16 + swz / 64; C = (st & 1) * 32 + (swz % 64) / 2; }
__host__ __device__ __forceinline__ int perm32(int rho) { const int n = rho >> 4, i = rho & 15; return 8 * (i >> 2) + 4 * n + (i & 3); }

struct Unit { int pm, pn; };
struct Gemm { const bf16_t* A; const bf16_t* Bt; int M, N, K; };

struct StaticOrder {
    int nM, nN, nwg, G, c;
    __host__ __device__ void init(int M, int N, int G_, int c_) { nM = M / BM; nN = N / BM; nwg = nM * nN; G = G_; c = c_; }
    __host__ __device__ bool next(int i, Unit& u) const {
        const long L = (long)i * G + c; if (L >= nwg) return false;
        int wgid = (int)L; { const int q = nwg / NXCD, r = nwg % NXCD, xcd = wgid % NXCD, off = wgid / NXCD; wgid = (xcd < r ? xcd * (q + 1) : r * (q + 1) + (xcd - r) * q) + off; }
        const int nig = WGM * nN, gid = wgid / nig, fm = gid * WGM, gsz = (nM - fm) < WGM ? (nM - fm) : WGM;
        u.pm = fm + ((wgid % nig) % gsz); u.pn = (wgid % nig) / gsz; return true;
    }
    __device__ __forceinline__ void a_ready(const Unit&) const {}
    __device__ __forceinline__ void done(const Unit&) const {}
};

__device__ __forceinline__ unsigned cvt_pk_bf16(float lo, float hi) { unsigned r; asm volatile("v_cvt_pk_bf16_f32 %0, %1, %2" : "=v"(r) : "v"(lo), "v"(hi)); return r; }
template <class Epi, class Sched, bool ALIGN_EPI = false, bool SP2 = false>
__device__ __forceinline__ void gemm_phase(PG8_LAS unsigned char* lds, const Gemm g, const Sched& S, const Epi& E) {
    const int tid = threadIdx.x, wid = __builtin_amdgcn_readfirstlane(tid >> 6), lane = tid & 63, wr = wid >> 2, wc = wid & 3, fr = lane & 15, fq = lane >> 4;
    const int K = g.K, nt = K / BK;
    unsigned voffA[2], voffB[2];
#pragma unroll
    for (int i = 0; i < 2; ++i) { int R, C; stage_rc(tid * 16 + i * 8192, R, C); const int Rb = Epi::PERM ? ((R & ~31) + perm32(R & 31)) : R;
        voffA[i] = (unsigned)(R * K + C) * 2u; voffB[i] = (unsigned)(Rb * K + C) * 2u; }
    const size_t kstep = (size_t)(BK * 2);
    const size_t hstep = (size_t)HALF * K * 2;
    const size_t tstep = 2 * hstep;
    const unsigned ldsw = (unsigned)wid * 1024u;
    const int aoff = lds_byte(wr * 64 + fr, fq * 8), boff = lds_byte(wc * 32 + fr, fq * 8);
#define PG8_SA(b, h) (((b) * 2 + (h)) * HTB)
#define PG8_SB(b, h) ((4 + (b) * 2 + (h)) * HTB)
#define PG8_STAGE(bufoff, gbase, voff) do { _Pragma("unroll") for (int _i = 0; _i < 2; ++_i) \
        __builtin_amdgcn_global_load_lds((const unsigned*)((const char*)(gbase) + (voff)[_i]), (PG8_LAS unsigned*)(lds + (bufoff) + ldsw + _i * 8192), 16, 0, 0); } while (0)
#define PG8_LDA(dst, b, h) do { _Pragma("unroll") for (int m = 0; m < 4; ++m) _Pragma("unroll") for (int k = 0; k < 2; ++k) dst[m][k] = *(const PG8_LAS bf16x8*)(lds + PG8_SA(b, h) + aoff + m * 2048 + k * 1024); } while (0)
#define PG8_LDB(dst, b, h) do { _Pragma("unroll") for (int n = 0; n < 2; ++n) _Pragma("unroll") for (int k = 0; k < 2; ++k) dst[n][k] = *(const PG8_LAS bf16x8*)(lds + PG8_SB(b, h) + boff + n * 2048 + k * 1024); } while (0)
#define PG8_MMA(ai, bj, At, Bt) do { __builtin_amdgcn_s_setprio(1); _Pragma("unroll") for (int m = 0; m < 4; ++m) _Pragma("unroll") for (int n = 0; n < 2; ++n) _Pragma("unroll") for (int k = 0; k < 2; ++k) \
        acc[ai][bj][m][n] = __builtin_amdgcn_mfma_f32_16x16x32_bf16(Bt[n][k], At[m][k], acc[ai][bj][m][n], 0, 0, 0); __builtin_amdgcn_s_setprio(0); } while (0)
#define PG8_WAIT_V(n) asm volatile("s_waitcnt vmcnt(" #n ")" ::: "memory")
#define PG8_WAIT_L(n) asm volatile("s_waitcnt lgkmcnt(" #n ")" ::: "memory")
#define PG8_BAR __builtin_amdgcn_s_barrier()
#define PG8_SCHED __builtin_amdgcn_sched_barrier(0)
    Unit cur, nxt; int ui = 0;
    if (!S.next(0, cur)) return;
    f32x4 acc[2][2][4][2];
#pragma unroll
    for (int a = 0; a < 2; ++a)
#pragma unroll
        for (int b = 0; b < 2; ++b)
#pragma unroll
            for (int m = 0; m < 4; ++m)
#pragma unroll
                for (int n = 0; n < 2; ++n) acc[a][b][m][n] = (f32x4){0.f, 0.f, 0.f, 0.f};
    bf16x8 At[4][2], B0[2][2], B1[2][2];
    const char* cA = (const char*)g.A + (size_t)cur.pm * tstep; const char* cB = (const char*)g.Bt + (size_t)cur.pn * tstep;
    S.a_ready(cur);
    if constexpr (SP2) {
        PG8_STAGE(PG8_SB(0, 0), cB, voffB); PG8_STAGE(PG8_SB(0, 1), cB + hstep, voffB); PG8_STAGE(PG8_SA(0, 0), cA, voffA); PG8_STAGE(PG8_SA(0, 1), cA + hstep, voffA);
        if (wr == 1) PG8_BAR;
        PG8_WAIT_V(2); PG8_BAR;
        PG8_STAGE(PG8_SB(1, 0), cB + kstep, voffB); PG8_STAGE(PG8_SA(1, 0), cA + kstep, voffA); PG8_STAGE(PG8_SB(1, 1), cB + hstep + kstep, voffB);
        PG8_WAIT_V(6); PG8_BAR;
    } else {
        PG8_STAGE(PG8_SB(0, 0), cB, voffB); PG8_STAGE(PG8_SA(0, 0), cA, voffA); PG8_STAGE(PG8_SB(0, 1), cB + hstep, voffB); PG8_STAGE(PG8_SA(0, 1), cA + hstep, voffA);
        if (wr == 1) PG8_BAR;
        PG8_WAIT_V(4); PG8_BAR;
        PG8_STAGE(PG8_SB(1, 0), cB + kstep, voffB); PG8_STAGE(PG8_SA(1, 0), cA + kstep, voffA); PG8_STAGE(PG8_SB(1, 1), cB + hstep + kstep, voffB);
        PG8_WAIT_V(6); PG8_BAR;
    }
    for (;;) {
        const bool has_next = S.next(ui + 1, nxt);
        const char* nA = has_next ? (const char*)g.A + (size_t)nxt.pm * tstep : cA; const char* nB = has_next ? (const char*)g.Bt + (size_t)nxt.pn * tstep : cB;
        for (int t = 0; t < nt; t += 2) {
            const bool last = (t == nt - 2);
            const char* a1 = cA + (size_t)(t + 1) * kstep;
            const char* a2 = last ? nA : cA + (size_t)(t + 2) * kstep; const char* b2 = last ? nB : cB + (size_t)(t + 2) * kstep;
            const char* a3 = a2 + kstep; const char* b3 = b2 + kstep;
            if (last && has_next) S.a_ready(nxt);
            if constexpr (SP2) {
            PG8_LDB(B0, 0, 0); PG8_LDB(B1, 0, 1); PG8_SCHED; PG8_LDA(At, 0, 0); PG8_STAGE(PG8_SA(1, 1), a1 + hstep, voffA);
            PG8_WAIT_V(8); PG8_WAIT_L(0); PG8_BAR; PG8_MMA(0, 0, At, B0); PG8_MMA(0, 1, At, B1); PG8_BAR; PG8_SCHED;
            PG8_LDA(At, 0, 1); PG8_STAGE(PG8_SB(0, 0), b2, voffB); PG8_STAGE(PG8_SB(0, 1), b2 + hstep, voffB); PG8_STAGE(PG8_SA(0, 0), a2, voffA);
            PG8_WAIT_V(8); PG8_WAIT_L(0); PG8_BAR; PG8_MMA(1, 0, At, B0); PG8_MMA(1, 1, At, B1); PG8_BAR; PG8_SCHED;
            PG8_LDB(B0, 1, 0); PG8_LDB(B1, 1, 1); PG8_SCHED; PG8_LDA(At, 1, 0); PG8_STAGE(PG8_SA(0, 1), a2 + hstep, voffA);
            PG8_WAIT_V(8); PG8_WAIT_L(0); PG8_BAR; PG8_MMA(0, 0, At, B0); PG8_MMA(0, 1, At, B1); PG8_BAR; PG8_SCHED;
            PG8_LDA(At, 1, 1); PG8_STAGE(PG8_SB(1, 0), b3, voffB); PG8_STAGE(PG8_SB(1, 1), b3 + hstep, voffB); PG8_STAGE(PG8_SA(1, 0), a3, voffA);
            PG8_WAIT_V(8); PG8_WAIT_L(0); PG8_BAR; PG8_MMA(1, 0, At, B0); PG8_MMA(1, 1, At, B1); PG8_BAR; PG8_SCHED;
            } else {
            PG8_LDB(B0, 0, 0); PG8_SCHED; PG8_LDA(At, 0, 0); PG8_STAGE(PG8_SA(1, 1), a1 + hstep, voffA);
            PG8_WAIT_L(8); PG8_BAR; PG8_WAIT_L(0); PG8_MMA(0, 0, At, B0); PG8_BAR; PG8_SCHED;
            PG8_LDB(B1, 0, 1); PG8_STAGE(PG8_SB(0, 0), b2, voffB);
            PG8_BAR; PG8_WAIT_L(0); PG8_MMA(0, 1, At, B1); PG8_BAR;
            PG8_LDA(At, 0, 1); PG8_STAGE(PG8_SA(0, 0), a2, voffA);
            PG8_BAR; PG8_WAIT_L(0); PG8_MMA(1, 0, At, B0); PG8_BAR; PG8_SCHED;
            PG8_STAGE(PG8_SB(0, 1), b2 + hstep, voffB);
            PG8_WAIT_V(6); PG8_BAR; PG8_MMA(1, 1, At, B1); PG8_BAR;
            PG8_LDB(B0, 1, 0); PG8_SCHED; PG8_LDA(At, 1, 0); PG8_STAGE(PG8_SA(0, 1), a2 + hstep, voffA);
            PG8_WAIT_L(8); PG8_BAR; PG8_WAIT_L(0); PG8_MMA(0, 0, At, B0); PG8_BAR; PG8_SCHED;
            PG8_LDB(B1, 1, 1); PG8_STAGE(PG8_SB(1, 0), b3, voffB);
            PG8_BAR; PG8_WAIT_L(0); PG8_MMA(0, 1, At, B1); PG8_BAR;
            PG8_LDA(At, 1, 1); PG8_STAGE(PG8_SA(1, 0), a3, voffA);
            PG8_BAR; PG8_WAIT_L(0); PG8_MMA(1, 0, At, B0); PG8_BAR; PG8_SCHED;
            PG8_STAGE(PG8_SB(1, 1), b3 + hstep, voffB);
            PG8_WAIT_V(6); PG8_BAR; PG8_MMA(1, 1, At, B1); PG8_BAR;
            }
        }
        if constexpr (ALIGN_EPI) { if (wr == 0) PG8_BAR; }
        if constexpr (!Epi::AFTER_DRAIN) { E(acc, cur, wr, wc, fr, fq); S.done(cur); }
        if (!has_next) break;
#pragma unroll
        for (int a = 0; a < 2; ++a)
#pragma unroll
            for (int b = 0; b < 2; ++b)
#pragma unroll
                for (int m = 0; m < 4; ++m)
#pragma unroll
                    for (int n = 0; n < 2; ++n) acc[a][b][m][n] = (f32x4){0.f, 0.f, 0.f, 0.f};
        cur = nxt; cA = nA; cB = nB; ++ui;
        if constexpr (ALIGN_EPI) { if (wr == 1) PG8_BAR; }
    }
    PG8_WAIT_V(0);
    if constexpr (!ALIGN_EPI) { if (wr == 0) PG8_BAR; }
    PG8_BAR;
    if constexpr (Epi::AFTER_DRAIN) { E.fused(acc, cur, wr, wc, fr, fq, lds, wid, lane); S.done(cur); }
#undef PG8_SA
#undef PG8_SB
#undef PG8_STAGE
#undef PG8_LDA
#undef PG8_LDB
#undef PG8_MMA
#undef PG8_WAIT_V
#undef PG8_WAIT_L
#undef PG8_BAR
#undef PG8_SCHED
}
}

#ifndef DUP
#define DUP 0
#endif
#define DI __device__ __forceinline__
#define LAS __attribute__((address_space(3)))
typedef unsigned short bf16_t;
typedef short bf16x8 __attribute__((ext_vector_type(8)));
typedef float f32x4 __attribute__((ext_vector_type(4)));
typedef float f32x16 __attribute__((ext_vector_type(16)));
typedef unsigned u32x4 __attribute__((ext_vector_type(4)));
typedef unsigned u32x2 __attribute__((ext_vector_type(2)));
typedef float f32x2_t __attribute__((ext_vector_type(2)));
typedef __bf16 bf16x2_t __attribute__((ext_vector_type(2)));

constexpr int D = 1024, NB = 8, SEQ = 4096, CTX = 256, FF = 4096;
constexpr int ML = NB * SEQ, MC = NB * CTX, MT = ML + MC;
constexpr size_t MiB = 1u << 20;
constexpr size_t WS_MOD = 0, WS_ZF = 1 * MiB, WS_RK = 9 * MiB, WS_LR = 14 * MiB, WS_W = 20 * MiB, WS_H2 = 56 * MiB, WS_BIG = 192 * MiB, WS_G = 430 * MiB;
constexpr size_t W_MIX = WS_W, W_O = WS_W + 14 * MiB, W_G2 = WS_W + 16 * MiB, W_1 = WS_W + 17 * MiB, W_2 = WS_W + 25 * MiB;
constexpr int LDS_BYTES = 147456;
constexpr int NTHREADS = 512;

struct Args { const float* in[35]; float* out; unsigned char* ws; int lo, hi; };

DI float bf2f(bf16_t v) { return __uint_as_float(((unsigned)v) << 16); }
DI unsigned cvtpk(float lo, float hi) { f32x2_t v = {lo, hi}; bf16x2_t b = __builtin_convertvector(v, bf16x2_t); return __builtin_bit_cast(unsigned, b); }
DI bf16_t f2bf(float x) { return (bf16_t)(cvtpk(x, 0.f) & 0xffffu); }
DI float wave_sum(float v) {
#pragma unroll
    for (int o = 1; o < 64; o <<= 1) v += __shfl_xor(v, o);
    return v;
}
DI float sigmoidf_(float x) { return 1.f / (1.f + __expf(-x)); }
DI float softplusf_(float x) { return fmaxf(x, 0.f) + log1pf(__expf(-fabsf(x))); }
DI int crow(int i, int h) { return (i & 3) + 8 * (i >> 2) + 4 * h; }
#define MFMA32(a, b, c) __builtin_amdgcn_mfma_f32_32x32x16_bf16((a), (b), (c), 0, 0, 0)

DI void mma_tile(f32x16& acc, const bf16_t* A, int lda, const bf16_t* Bt, int ldb, int ksteps, int lane) {
    const int rho = lane & 31, h = lane >> 5;
    const bf16_t* ap = A + rho * lda + 8 * h; const bf16_t* bp = Bt + rho * ldb + 8 * h;
    for (int s = 0; s < ksteps; ++s) {
        bf16x8 av = *(const bf16x8*)(ap + 16 * s); bf16x8 bv = *(const bf16x8*)(bp + 16 * s);
        acc = MFMA32(av, bv, acc);
    }
}

template <class Inner> struct Epi {
    static constexpr bool PERM = true, AFTER_DRAIN = false;
    Inner in;
    DI void operator()(const pg8::f32x4 (&acc)[2][2][4][2], const pg8::Unit& u, int wr, int wc, int fr, int fq) const {
        const int row0 = u.pm * 256 + wr * 64 + fr, col0 = u.pn * 256 + wc * 32 + 8 * fq;
#pragma unroll
        for (int ai = 0; ai < 2; ++ai)
#pragma unroll
            for (int m = 0; m < 4; ++m) {
                const int row = row0 + ai * 128 + m * 16;
#pragma unroll
                for (int bj = 0; bj < 2; ++bj) in.store8(row, col0 + bj * 128, acc[ai][bj][m][0], acc[ai][bj][m][1]);
            }
    }
};
DI u32x4 pack8(f32x4 a, f32x4 b) { u32x4 w; w.x = cvtpk(a[0], a[1]); w.y = cvtpk(a[2], a[3]); w.z = cvtpk(b[0], b[1]); w.w = cvtpk(b[2], b[3]); return w; }

template <int ACT> struct InStore {
    bf16_t* O; int ldc;
    DI void store8(int row, int col, f32x4 a, f32x4 b) const {
        if (ACT == 1) {
#pragma unroll
            for (int j = 0; j < 4; ++j) { float x = fmaxf(a[j], 0.f); a[j] = x * x; float y = fmaxf(b[j], 0.f); b[j] = y * y; }
        }
        *(u32x4*)(O + (size_t)row * ldc + col) = pack8(a, b);
    }
};
struct InNaQkv {
    bf16_t* QK; bf16_t* VTL; bf16_t* VTC;
    DI void store8(int row, int col, f32x4 a, f32x4 b) const {
        if (col < 2048) {
            const float sc = col < 1024 ? 0.125f : 1.f;
            *(u32x4*)(QK + (size_t)row * 2048 + col) = pack8(a * sc, b * sc);
        } else {
            const int c = col - 2048, hd = c >> 6, d0 = c & 63;
            bf16_t* p; size_t ld;
            if (row < ML) { const int b_ = row >> 12, t = row & 4095; p = VTL + ((size_t)((b_ * 16 + hd) * 64 + d0)) * 4096 + t; ld = 4096; }
            else { const int r2 = row - ML, b_ = r2 >> 8, t = r2 & 255; p = VTC + ((size_t)((b_ * 16 + hd) * 64 + d0)) * 256 + t; ld = 256; }
#pragma unroll
            for (int j = 0; j < 4; ++j) { p[(size_t)j * ld] = f2bf(a[j]); p[(size_t)(j + 4) * ld] = f2bf(b[j]); }
        }
    }
};
struct InResid {
    const float* sl; const float* sc; float* dl; float* dc; const float* gate;
    DI void store8(int row, int col, f32x4 a, f32x4 b) const {
        const float* s; float* d; int mi;
        if (row < ML) { s = sl + (size_t)row * 1024 + col; d = dl + (size_t)row * 1024 + col; mi = row >> 12; }
        else { s = sc + (size_t)(row - ML) * 1024 + col; d = dc + (size_t)(row - ML) * 1024 + col; mi = 8; }
        const float* g = gate + (size_t)mi * 6144 + col;
        const f32x4 g0 = *(const f32x4*)g, g1 = *(const f32x4*)(g + 4);
        const f32x4 x0 = *(const f32x4*)s, x1 = *(const f32x4*)(s + 4);
        *(f32x4*)d = x0 + g0 * a; *(f32x4*)(d + 4) = x1 + g1 * b;
    }
};
struct InGlaIn {
    bf16_t* P; float* LR;
    DI void store8(int row, int col, f32x4 a, f32x4 b) const {
        if (col < 3072) {
            const float sc = col < 512 ? 0.08838834764831845f : 1.f;
            *(u32x4*)(P + (size_t)row * 3072 + col) = pack8(a * sc, b * sc);
        } else if (col < 3104) {
            float* p = LR + (size_t)row * 32 + (col - 3072);
            *(f32x4*)p = a; *(f32x4*)(p + 4) = b;
        }
    }
};
struct InRwL1 {
    bf16_t* RKV; bf16_t* SG; bf16_t* TWAA;
    DI void store8(int row, int col, f32x4 a, f32x4 b) const {
        if (col < 3072) { *(u32x4*)(RKV + (size_t)row * 3072 + col) = pack8(a, b); }
        else if (col < 3328) {
#pragma unroll
            for (int j = 0; j < 4; ++j) { a[j] = sigmoidf_(a[j]); b[j] = sigmoidf_(b[j]); }
            *(u32x4*)(SG + (size_t)row * 256 + (col - 3072)) = pack8(a, b);
        } else {
            const int c = col - 3328;
            if (c < 128) {
#pragma unroll
                for (int j = 0; j < 4; ++j) { a[j] = tanhf(a[j]); b[j] = tanhf(b[j]); }
            }
            *(u32x4*)(TWAA + (size_t)row * 256 + c) = pack8(a, b);
        }
    }
};

template <class Inner> DI void run_gemm(LAS unsigned char* lds, const bf16_t* A, const bf16_t* Bt, int M, int N, int K, const Inner& in) {
    int Kr = K; asm volatile("" : "+s"(Kr));
    pg8::Gemm g{A, Bt, M, N, Kr}; pg8::StaticOrder S; S.init(M, N, (int)gridDim.x, (int)blockIdx.x);
    Epi<Inner> E{in};
#ifndef NO_GEMM
    pg8::gemm_phase<Epi<Inner>, pg8::StaticOrder, true, true>(lds, g, S, E);
#endif
    __syncthreads();
}

DI void conv_item(const float* W, int ldw, int Kv, int Nv, const float* mix, int mode, bf16_t* WT, int ldt, int row_off, int col_off, float* scr, int kb, int nb, int lane) {
    const int k0 = 64 * kb, n0 = 32 * nb;
#pragma unroll 8
    for (int i = 0; i < 32; ++i) {
        const int kk = 2 * i + (lane >> 5), k = k0 + kk, n = n0 + (lane & 31);
        float v = (k < Kv && n < Nv) ? W[(size_t)k * ldw + n] : 0.f;
        if (mode) { const float m = (k < Kv) ? mix[k] : 0.f; v *= (mode == 1) ? (1.f - m) : m; }
        scr[kk * 33 + (lane & 31)] = v;
    }
    __builtin_amdgcn_s_waitcnt(0xc07f); __builtin_amdgcn_wave_barrier();
    const int c = lane & 7;
#pragma unroll
    for (int j = 0; j < 4; ++j) {
        const int n = (lane >> 3) + 8 * j; const float* s = scr + (8 * c) * 33 + n;
        u32x4 o; o.x = cvtpk(s[0 * 33], s[1 * 33]); o.y = cvtpk(s[2 * 33], s[3 * 33]); o.z = cvtpk(s[4 * 33], s[5 * 33]); o.w = cvtpk(s[6 * 33], s[7 * 33]);
        *(u32x4*)(WT + (size_t)(row_off + n0 + n) * ldt + col_off + k0 + 8 * c) = o;
    }
    __builtin_amdgcn_s_waitcnt(0xc07f); __builtin_amdgcn_wave_barrier();
}
DI void conv_job(const float* W, int ldw, int Kv, int Nv, int Kp, int Np, const float* mix, int mode, bf16_t* WT, int ldt, int row_off, int col_off, float* scr, int gw, int ngw, int lane) {
    const int nkb = Kp / 64, nnb = Np / 32, nit = nkb * nnb;
    for (int it = gw; it < nit; it += ngw) conv_item(W, ldw, Kv, Nv, mix, mode, WT, ldt, row_off, col_off, scr, it / nnb, it % nnb, lane);
}

DI void norm_row(const float* xr, const f32x4 (&gs)[4], const f32x4 (&sh)[4], int lane, f32x4 (&out)[4]) {
    f32x4 v[4]; float s = 0.f;
#pragma unroll
    for (int j = 0; j < 4; ++j) { v[j] = *(const f32x4*)(xr + 4 * lane + 256 * j); s += (v[j].x * v[j].x + v[j].y * v[j].y) + (v[j].z * v[j].z + v[j].w * v[j].w); }
    s = wave_sum(s);
    const float rinv = rsqrtf(s * (1.f / 1024.f) + 1e-6f);
#pragma unroll
    for (int j = 0; j < 4; ++j) out[j] = v[j] * rinv * gs[j] + sh[j];
}
DI void store_row_bf16(bf16_t* o, const f32x4 (&v)[4], int lane) {
#pragma unroll
    for (int j = 0; j < 4; ++j) { u32x2 w; w.x = cvtpk(v[j].x, v[j].y); w.y = cvtpk(v[j].z, v[j].w); *(u32x2*)(o + 4 * lane + 256 * j) = w; }
}
DI void phase_prenorm(const float* xl, const float* xc, const float* g, const float* modl  , int shift_chunk, bf16_t* H, int ldh, bool with_hs, int Mrows, int gw, int ngw, int lane) {
    const int nstrips = Mrows / 8;
    for (int st = gw; st < nstrips; st += ngw) {
        const int row0 = 8 * st;
        int mi, seg0, seg1;
        if (row0 < ML) { mi = row0 >> 12; seg0 = row0 & ~4095; seg1 = seg0 + 4096; } else { mi = 8; seg0 = ML + ((row0 - ML) & ~255); seg1 = seg0 + 256; }
        const float* mp = modl + (size_t)mi * 6144 + shift_chunk * 1024;
        f32x4 gs[4], sh[4];
#pragma unroll
        for (int j = 0; j < 4; ++j) { const int c = 4 * lane + 256 * j; sh[j] = *(const f32x4*)(mp + c); const f32x4 sc = *(const f32x4*)(mp + 1024 + c); gs[j] = *(const f32x4*)(g + c) * (sc + 1.f); }
#define XROW(r) ((r) < ML ? xl + (size_t)(r) * 1024 : xc + (size_t)((r) - ML) * 1024)
        if (!with_hs) {
            for (int r = row0; r < row0 + 8; ++r) { f32x4 o[4]; norm_row(XROW(r), gs, sh, lane, o); store_row_bf16(H + (size_t)r * ldh, o, lane); }
        } else {
            f32x4 prev[4], cur[4], nxt[4];
            if (row0 > seg0) norm_row(XROW(row0 - 1), gs, sh, lane, prev); else { for (int j = 0; j < 4; ++j) prev[j] = (f32x4){0.f, 0.f, 0.f, 0.f}; }
            norm_row(XROW(row0), gs, sh, lane, cur);
            for (int r = row0; r < row0 + 8; ++r) {
                if (r + 1 < seg1) norm_row(XROW(r + 1), gs, sh, lane, nxt); else { for (int j = 0; j < 4; ++j) nxt[j] = (f32x4){0.f, 0.f, 0.f, 0.f}; }
                store_row_bf16(H + (size_t)r * ldh, cur, lane);
                f32x4 hs[4];
#pragma unroll
                for (int j = 0; j < 4; ++j) hs[j] = (prev[j] + nxt[j]) * 0.5f;
                store_row_bf16(H + (size_t)r * ldh + 1024, hs, lane);
#pragma unroll
                for (int j = 0; j < 4; ++j) { prev[j] = cur[j]; cur[j] = nxt[j]; }
            }
        }
#undef XROW
    }
}

DI void phase_mod(const Args& a, float* lds, int tid) {
    float* sc = lds;
    float* red = lds + 1024 * 12;
    const float* c = a.in[1]; const float* cctx = a.in[3]; const float* ada_w = a.in[4]; const float* ada_b = a.in[5];
    float* mod = (float*)(a.ws + WS_MOD);
    for (int idx = tid; idx < 9 * 1024; idx += NTHREADS) { const int j = idx >> 10, k = idx & 1023; const float v = j < 8 ? c[j * 1024 + k] : cctx[k]; sc[k * 12 + j] = v * sigmoidf_(v); }
    __syncthreads();
    for (int unit = blockIdx.x; unit < 384; unit += gridDim.x) {
        const int l = unit / 96, n0 = (unit % 96) * 64, col = tid & 63, ks = tid >> 6;
        const float* w = ada_w + ((size_t)l * 1024 + ks * 128) * 6144 + n0 + col;
        float acc[9];
#pragma unroll
        for (int j = 0; j < 9; ++j) acc[j] = 0.f;
#pragma unroll 8
        for (int kk = 0; kk < 128; ++kk) {
            const float wv = w[(size_t)kk * 6144]; const float* s = sc + (ks * 128 + kk) * 12;
            const f32x4 s0 = *(const f32x4*)s, s1 = *(const f32x4*)(s + 4); const float s8 = s[8];
            acc[0] += s0.x * wv; acc[1] += s0.y * wv; acc[2] += s0.z * wv; acc[3] += s0.w * wv;
            acc[4] += s1.x * wv; acc[5] += s1.y * wv; acc[6] += s1.z * wv; acc[7] += s1.w * wv; acc[8] += s8 * wv;
        }
#pragma unroll
        for (int j = 0; j < 9; ++j) red[(ks * 9 + j) * 64 + col] = acc[j];
        __syncthreads();
        for (int idx = tid; idx < 576; idx += NTHREADS) {
            const int j = idx >> 6, cc = idx & 63; float s = ada_b[l * 6144 + n0 + cc];
#pragma unroll
            for (int k2 = 0; k2 < 8; ++k2) s += red[(k2 * 9 + j) * 64 + cc];
            mod[((size_t)(l * 9 + j)) * 6144 + n0 + cc] = s;
        }
        __syncthreads();
    }
}

DI void attn_unit(const bf16_t* QK, const bf16_t* VTL, const bf16_t* VTC, bf16_t* O, const float* rpb, int b, int hd, int r, int cq, int lane) {
    const int n = lane & 31, h = lane >> 5;
    const bool lat = r >= 0;
    const int qrow0 = lat ? b * 4096 + r * 64 : ML + b * 256 + cq * 64;
    const int pin = (n & 0x13) | ((n & 4) << 1) | ((n & 8) >> 1);
    bf16x8 bq[2][4];
#pragma unroll
    for (int qb = 0; qb < 2; ++qb)
#pragma unroll
        for (int s = 0; s < 4; ++s) bq[qb][s] = *(const bf16x8*)(QK + (size_t)(qrow0 + 32 * qb + n) * 2048 + hd * 64 + 32 * h + 8 * s);
    f32x16 o[2][2];
#pragma unroll
    for (int x = 0; x < 2; ++x)
#pragma unroll
        for (int y = 0; y < 2; ++y)
#pragma unroll
            for (int i = 0; i < 16; ++i) o[x][y][i] = 0.f;
    float mrun[2] = {-1e30f, -1e30f}, lrun[2] = {0.f, 0.f};
    const int r0 = lat ? min(max(r - 4, 0), 56) : 0;
    const int nblk = lat ? 24 : 8;
    const bf16_t* vtc = VTC + (size_t)((b * 16 + hd) * 64) * 256;
    const bf16_t* vtl = VTL + (size_t)((b * 16 + hd) * 64) * 4096;
    for (int blk = 0; blk < nblk; ++blk) {
        int krow0, ldv, kc0 = 0, ridx = 0; const bf16_t* vt;
        const bool lb_ = blk >= 8;
        if (!lb_) { krow0 = ML + b * 256 + blk * 32; vt = vtc + blk * 32; ldv = 256; }
        else { const int lb = blk - 8, kr = r0 + (lb >> 1); kc0 = (lb & 1) * 32; krow0 = b * 4096 + kr * 64 + kc0; vt = vtl + kr * 64 + kc0; ldv = 4096; ridx = kr - r + 7; }
        bf16x8 ka[4];
#pragma unroll
        for (int s = 0; s < 4; ++s) ka[s] = *(const bf16x8*)(QK + (size_t)(krow0 + pin) * 2048 + 1024 + hd * 64 + 32 * h + 8 * s);
        bf16x8 va[2][2];
#pragma unroll
        for (int db = 0; db < 2; ++db)
#pragma unroll
            for (int s2 = 0; s2 < 2; ++s2) va[db][s2] = *(const bf16x8*)(vt + (size_t)(32 * db + n) * ldv + 16 * s2 + 8 * h);
        f32x16 sa[2];
#pragma unroll
        for (int qb = 0; qb < 2; ++qb) {
#pragma unroll
            for (int i = 0; i < 16; ++i) sa[qb][i] = 0.f;
#pragma unroll
            for (int s = 0; s < 4; ++s) sa[qb] = MFMA32(ka[s], bq[qb][s], sa[qb]);
        }
        bf16x8 pb[2][2];
#pragma unroll
        for (int qb = 0; qb < 2; ++qb) {
            if (lb_) {
                const int qc = 32 * qb + n, cs = min(max(qc - 8, 0), 48);
                const float* bp = rpb + (hd * 15 + ridx) * 31;
#pragma unroll
                for (int i = 0; i < 16; ++i) {
                    const int kc = kc0 + (i & 7) + 8 * h + 16 * (i >> 3);
                    const bool ok = (unsigned)(kc - cs) < 16u;
                    const int ci = min(max(kc - qc + 15, 0), 30);
                    const float bv = bp[ci];
                    sa[qb][i] = ok ? sa[qb][i] + bv : -1e30f;
                }
            }
            float bm = sa[qb][0];
#pragma unroll
            for (int i = 1; i < 16; ++i) bm = fmaxf(bm, sa[qb][i]);
            bm = fmaxf(bm, __shfl_xor(bm, 32));
            const float mnew = fmaxf(mrun[qb], bm);
            const float alpha = __expf(mrun[qb] - mnew);
            mrun[qb] = mnew;
            float ps = 0.f;
#pragma unroll
            for (int i = 0; i < 16; ++i) { const float p = __expf(sa[qb][i] - mnew); sa[qb][i] = p; ps += p; }
            lrun[qb] = lrun[qb] * alpha + ps;
#pragma unroll
            for (int db = 0; db < 2; ++db)
#pragma unroll
                for (int i = 0; i < 16; ++i) o[db][qb][i] *= alpha;
#pragma unroll
            for (int s2 = 0; s2 < 2; ++s2) {
                u32x4 w; w.x = cvtpk(sa[qb][8 * s2 + 0], sa[qb][8 * s2 + 1]); w.y = cvtpk(sa[qb][8 * s2 + 2], sa[qb][8 * s2 + 3]);
                w.z = cvtpk(sa[qb][8 * s2 + 4], sa[qb][8 * s2 + 5]); w.w = cvtpk(sa[qb][8 * s2 + 6], sa[qb][8 * s2 + 7]);
                pb[qb][s2] = __builtin_bit_cast(bf16x8, w);
            }
        }
#pragma unroll
        for (int db = 0; db < 2; ++db)
#pragma unroll
            for (int qb = 0; qb < 2; ++qb)
#pragma unroll
                for (int s2 = 0; s2 < 2; ++s2) o[db][qb] = MFMA32(va[db][s2], pb[qb][s2], o[db][qb]);
    }
#pragma unroll
    for (int qb = 0; qb < 2; ++qb) {
        const float lt = lrun[qb] + __shfl_xor(lrun[qb], 32);
        const float inv = 1.f / lt;
        bf16_t* op = O + (size_t)(qrow0 + 32 * qb + n) * 1024 + hd * 64;
#pragma unroll
        for (int db = 0; db < 2; ++db)
#pragma unroll
            for (int g = 0; g < 4; ++g) {
                u32x2 w; w.x = cvtpk(o[db][qb][4 * g] * inv, o[db][qb][4 * g + 1] * inv); w.y = cvtpk(o[db][qb][4 * g + 2] * inv, o[db][qb][4 * g + 3] * inv);
                *(u32x2*)(op + 32 * db + 8 * g + 4 * h) = w;
            }
    }
}

DI void gla_unit(const bf16_t* P, const float* LR, const float* wdec, const float* bdec, bf16_t* OUT  , unsigned char* lds, int unit, int tid) {
    const int lane = tid & 63, wid = __builtin_amdgcn_readfirstlane(tid >> 6);
    const int vs = unit & 3, dir = (unit >> 2) & 1, hd = (unit >> 3) & 3, b = unit >> 5;
    bf16_t* QE = (bf16_t*)lds;
    bf16_t* KE = QE + 64 * 136;
    bf16_t* ST = KE + 64 * 136;
    bf16_t* KDT = ST + 64 * 136;
    bf16_t* VT = KDT + 128 * 72;
    bf16_t* AM = VT + 64 * 72;
    float* Bc = (float*)(AM + 64 * 72);
    float* LRs = Bc + 64 * 128;
    float* GRP = LRs + 64 * 16;
    float* DEC = GRP + 4 * 128;
    const int dcol = tid & 127, lg = tid >> 7;
    float wd[16];
#pragma unroll
    for (int r = 0; r < 16; ++r) wd[r] = wdec[(dir * 16 + r) * 512 + hd * 128 + dcol];
    const float bd = bdec[dir * 512 + hd * 128 + dcol];
    const int col_q = hd * 128, col_k = 512 + hd * 128, col_v = 1024 + hd * 256 + vs * 64;
    f32x16 st;
#pragma unroll
    for (int i = 0; i < 16; ++i) st[i] = 0.f;
    const int svt = wid >> 2, sdt = wid & 3, rho = lane & 31, hh = lane >> 5;
    bf16_t* outp = OUT + (size_t)dir * MT * 1024;
    for (int side = 0; side < 2; ++side) {
        const int T = side == 0 ? 256 : 4096, base = side == 0 ? ML + b * 256 : b * 4096, nch = T / 64;
        for (int n = 0; n < nch; ++n) {
#define GROW(l) (base + (dir ? (T - 1 - (n * 64 + (l))) : (n * 64 + (l))))
            { const int idx = tid * 2, l = idx >> 4, r = idx & 15; const float* p = LR + (size_t)GROW(l) * 32 + dir * 16 + r; LRs[l * 16 + r] = p[0]; LRs[l * 16 + r + 1] = p[1]; }
            __syncthreads();
            { float run = 0.f;
              for (int li = 0; li < 16; ++li) { const int l = 16 * lg + li; float z = bd;
#pragma unroll
                  for (int r = 0; r < 16; ++r) z += LRs[l * 16 + r] * wd[r];
                  const float g = -softplusf_(-z) * (1.f / 16.f); run += g; Bc[l * 128 + dcol] = run; }
              GRP[lg * 128 + dcol] = run; }
            __syncthreads();
            { float off = 0.f, blast = 0.f;
#pragma unroll
              for (int g2 = 0; g2 < 4; ++g2) { const float t = GRP[g2 * 128 + dcol]; blast += t; if (g2 < lg) off += t; }
              if (lg == 0) DEC[dcol] = __expf(blast);
              for (int li = 0; li < 16; ++li) { const int l = 16 * lg + li; const float bv = Bc[l * 128 + dcol] + off; const size_t ro = (size_t)GROW(l) * 3072;
                  const float qv = bf2f(P[ro + col_q + dcol]), kv = bf2f(P[ro + col_k + dcol]);
                  QE[l * 136 + dcol] = f2bf(qv * __expf(bv)); KE[l * 136 + dcol] = f2bf(kv * __expf(-bv)); KDT[dcol * 72 + l] = f2bf(kv * __expf(blast - bv)); }
              { const int l = tid >> 3, v0 = (tid & 7) * 8; const bf16x8 vv = *(const bf16x8*)(P + (size_t)GROW(l) * 3072 + col_v + v0);
#pragma unroll
                for (int e = 0; e < 8; ++e) VT[(v0 + e) * 72 + l] = (bf16_t)vv[e]; }
#pragma unroll
              for (int i = 0; i < 16; ++i) ST[(32 * svt + crow(i, hh)) * 136 + 32 * sdt + rho] = f2bf(st[i]);
            }
            __syncthreads();
            if (wid < 4) { const int lt = wid >> 1, mt = wid & 1; f32x16 acc;
#pragma unroll
                for (int i = 0; i < 16; ++i) acc[i] = 0.f;
                mma_tile(acc, QE + 32 * lt * 136, 136, KE + 32 * mt * 136, 136, 8, lane);
#pragma unroll
                for (int i = 0; i < 16; ++i) { const int l = 32 * lt + crow(i, hh), m = 32 * mt + rho; AM[l * 72 + m] = f2bf(m <= l ? acc[i] : 0.f); } }
            __syncthreads();
            if (wid < 4) { const int lt = wid >> 1, vt2 = wid & 1; f32x16 acc;
#pragma unroll
                for (int i = 0; i < 16; ++i) acc[i] = 0.f;
                mma_tile(acc, AM + 32 * lt * 72, 72, VT + 32 * vt2 * 72, 72, 4, lane);
                mma_tile(acc, QE + 32 * lt * 136, 136, ST + 32 * vt2 * 136, 136, 8, lane);
#pragma unroll
                for (int i = 0; i < 16; ++i) { const int l = 32 * lt + crow(i, hh); outp[(size_t)GROW(l) * 1024 + hd * 256 + vs * 64 + 32 * vt2 + rho] = f2bf(acc[i]); } }
            { const float dc = DEC[32 * sdt + rho];
#pragma unroll
              for (int i = 0; i < 16; ++i) st[i] *= dc;
              mma_tile(st, VT + 32 * svt * 72, 72, KDT + 32 * sdt * 72, 72, 4, lane); }
            __syncthreads();
#undef GROW
        }
    }
}
DI void gla_finish(bf16_t* OF, const bf16_t* OB, const bf16_t* P, const float* ng, int Mrows, int gw, int ngw, int lane) {
    for (int row = gw; row < Mrows; row += ngw) {
        const int c0 = 16 * lane;
        const bf16x8 a0 = *(const bf16x8*)(OF + (size_t)row * 1024 + c0), a1 = *(const bf16x8*)(OF + (size_t)row * 1024 + c0 + 8);
        const bf16x8 b0 = *(const bf16x8*)(OB + (size_t)row * 1024 + c0), b1 = *(const bf16x8*)(OB + (size_t)row * 1024 + c0 + 8);
        const bf16x8 g0 = *(const bf16x8*)(P + (size_t)row * 3072 + 2048 + c0), g1 = *(const bf16x8*)(P + (size_t)row * 3072 + 2048 + c0 + 8);
        float o[16]; float ss = 0.f;
#pragma unroll
        for (int e = 0; e < 8; ++e) { o[e] = bf2f((bf16_t)a0[e]) + bf2f((bf16_t)b0[e]); o[8 + e] = bf2f((bf16_t)a1[e]) + bf2f((bf16_t)b1[e]); }
#pragma unroll
        for (int e = 0; e < 16; ++e) ss += o[e] * o[e];
        ss += __shfl_xor(ss, 1); ss += __shfl_xor(ss, 2); ss += __shfl_xor(ss, 4); ss += __shfl_xor(ss, 8);
        const float rinv = rsqrtf(ss * (1.f / 256.f) + 1e-6f);
        float y[16];
#pragma unroll
        for (int e = 0; e < 16; ++e) { const float gt = bf2f((bf16_t)(e < 8 ? g0[e] : g1[e - 8])); y[e] = o[e] * rinv * ng[(c0 + e) & 255] * (gt * sigmoidf_(gt)); }
        u32x4 w0, w1; w0.x = cvtpk(y[0], y[1]); w0.y = cvtpk(y[2], y[3]); w0.z = cvtpk(y[4], y[5]); w0.w = cvtpk(y[6], y[7]);
        w1.x = cvtpk(y[8], y[9]); w1.y = cvtpk(y[10], y[11]); w1.z = cvtpk(y[12], y[13]); w1.w = cvtpk(y[14], y[15]);
        *(u32x4*)(OF + (size_t)row * 1024 + c0) = w0; *(u32x4*)(OF + (size_t)row * 1024 + c0 + 8) = w1;
    }
}

typedef unsigned u32x2_t __attribute__((ext_vector_type(2)));
DI float red_rows(float x) {
    unsigned u = __float_as_uint(x);
    u32x2_t r = __builtin_amdgcn_permlane16_swap(u, u, false, false);
    const float y = __uint_as_float(r.x) + __uint_as_float(r.y);
    unsigned v = __float_as_uint(y);
    u32x2_t q = __builtin_amdgcn_permlane32_swap(v, v, false, false);
    return __uint_as_float(q.x) + __uint_as_float(q.y);
}
DI int rw_row(int q, int l, int dir, int b) {
    int T, base, n;
    if (q < 8) { T = 256; base = ML + b * 256; n = q; } else { T = 4096; base = b * 4096; n = q - 8; }
    const int t = n * 32 + l;
    return base + (dir ? T - 1 - t : t);
}
#define DPPB(n) " row_newbcast:" #n " row_mask:0xf bank_mask:0xf\n\t"
#define RW_UPD(n, sreg) "v_mul_f32_dpp " sreg ", %17, " sreg DPPB(n) "v_fmac_f32_dpp " sreg ", %18, %21" DPPB(n) "v_fmac_f32_dpp " sreg ", %19, %22" DPPB(n)
DI void rwkv_unit(const Args& a, const bf16_t* RKV, const bf16_t* TWAA, bf16_t* Y  , float* RK  , unsigned char* lds, int unit, int tid) {
    const int lane = tid & 63, wid = __builtin_amdgcn_readfirstlane(tid >> 6);
    const int dir = unit & 1, hd = (unit >> 1) & 15, b = unit >> 5;
    float* SA = (float*)lds;
    float* YC = SA + 6 * 4096;
    bf16_t* W2T = (bf16_t*)(YC + 4096);
    bf16_t* A2T = W2T + 64 * 72;
    constexpr int NCH = 136;
    {
        const float* w2 = a.in[23] + (size_t)dir * 64 * 1024; const float* a2 = a.in[26] + (size_t)dir * 64 * 1024;
        for (int e = 0; e < 8; ++e) { const int idx = tid + 512 * e, j = idx >> 6, c = idx & 63; W2T[c * 72 + j] = f2bf(w2[(size_t)j * 1024 + hd * 64 + c]); A2T[c * 72 + j] = f2bf(a2[(size_t)j * 1024 + hd * 64 + c]); }
    }
    __syncthreads();
    bf16_t* yout = Y + (size_t)dir * MT * 1024; float* rkout = RK + (size_t)dir * MT * 16;
    if (wid >= 4) {
        const int pw = wid - 4, rho = lane & 31, h = lane >> 5, ptid = tid - 256;
        float cw0[2], ca0[2], ckk[2], cka[2], crk[2];
#pragma unroll
        for (int ct = 0; ct < 2; ++ct) { const int c = hd * 64 + 32 * ct + rho; cw0[ct] = a.in[21][dir * 1024 + c]; ca0[ct] = a.in[24][dir * 1024 + c]; ckk[ct] = a.in[29][c]; cka[ct] = a.in[30][c]; crk[ct] = a.in[31][c]; }
        for (int p = 0; p <= NCH + 1; ++p) {
            if (p < NCH) {
                const int buf = p & 1;
                const int rowA = rw_row(p, 8 * pw + (rho & 7), dir, b);
                const bf16_t* ta = TWAA + (size_t)rowA * 256 + dir * 64 + 8 * h;
                f32x16 zw0, zw1, za0, za1;
#pragma unroll
                for (int i = 0; i < 16; ++i) { zw0[i] = 0.f; zw1[i] = 0.f; za0[i] = 0.f; za1[i] = 0.f; }
#pragma unroll
                for (int s = 0; s < 4; ++s) {
                    const bf16x8 atw = *(const bf16x8*)(ta + 16 * s), aaa = *(const bf16x8*)(ta + 128 + 16 * s);
                    const bf16x8 bw0 = *(const bf16x8*)(W2T + rho * 72 + 16 * s + 8 * h), bw1 = *(const bf16x8*)(W2T + (32 + rho) * 72 + 16 * s + 8 * h);
                    const bf16x8 ba0 = *(const bf16x8*)(A2T + rho * 72 + 16 * s + 8 * h), ba1 = *(const bf16x8*)(A2T + (32 + rho) * 72 + 16 * s + 8 * h);
                    zw0 = MFMA32(atw, bw0, zw0); zw1 = MFMA32(atw, bw1, zw1); za0 = MFMA32(aaa, ba0, za0); za1 = MFMA32(aaa, ba1, za1);
                }
#pragma unroll
                for (int i = 0; i < 4; ++i) {
                    const int tok = 8 * pw + i + 4 * h; const int row = rw_row(p, tok, dir, b);
                    const bf16_t* pr = RKV + (size_t)row * 3072 + hd * 64 + rho;
                    float rv[2], kv[2], vv[2], av[2], kkv[2], kd[2]; float ss = 0.f, rk = 0.f;
#pragma unroll
                    for (int ct = 0; ct < 2; ++ct) {
                        rv[ct] = bf2f(pr[32 * ct]); kv[ct] = bf2f(pr[1024 + 32 * ct]); vv[ct] = bf2f(pr[2048 + 32 * ct]);
                        const float zav = ct ? za1[i] : za0[i];
                        av[ct] = 1.f / (1.f + __expf(-(ca0[ct] + zav)));
                        kkv[ct] = kv[ct] * ckk[ct]; ss += kkv[ct] * kkv[ct];
                        kd[ct] = kv[ct] * (1.f + (av[ct] - 1.f) * cka[ct]); rk += rv[ct] * kd[ct] * crk[ct];
                    }
#pragma unroll
                    for (int o = 1; o < 32; o <<= 1) { ss += __shfl_xor(ss, o); rk += __shfl_xor(rk, o); }
                    const float kinv = rsqrtf(fmaxf(ss, 1e-24f));
                    if (rho == 0) rkout[(size_t)row * 16 + hd] = rk;
#pragma unroll
                    for (int ct = 0; ct < 2; ++ct) {
                        const float zwv = ct ? zw1[i] : zw0[i];
                        const float x = -(cw0[ct] + zwv);
                        const float sp = fmaxf(x, 0.f) + __logf(1.f + __expf(-fabsf(x)));
                        const float dec = __expf(-__expf(-sp - 0.5f));
                        const float kn = kkv[ct] * kinv;
                        float* o = SA + buf * 2048 + tok * 64 + 32 * ct + rho;
                        o[0 * 4096] = dec; o[1 * 4096] = kd[ct]; o[2 * 4096] = kn * av[ct]; o[3 * 4096] = -kn; o[4 * 4096] = rv[ct]; o[5 * 4096] = vv[ct];
                    }
                }
            }
            if (p >= 2) {
                const int tok = ptid >> 3, i0 = (ptid & 7) * 8; const int row = rw_row(p - 2, tok, dir, b);
                const float* y = YC + (p & 1) * 2048 + tok * 64 + i0;
                const f32x4 y0 = *(const f32x4*)y, y1 = *(const f32x4*)(y + 4);
                *(u32x4*)(yout + (size_t)row * 1024 + hd * 64 + i0) = pack8(y0, y1);
            }
            __syncthreads();
        }
    } else {
        const int rl = lane & 15, cg = lane >> 4, myrow = 16 * wid + rl;
        float s0 = 0.f, s1 = 0.f, s2 = 0.f, s3 = 0.f, s4 = 0.f, s5 = 0.f, s6 = 0.f, s7 = 0.f, s8 = 0.f, s9 = 0.f, s10 = 0.f, s11 = 0.f, s12 = 0.f, s13 = 0.f, s14 = 0.f, s15 = 0.f;
        for (int p = 0; p <= NCH + 1; ++p) {
            if (p >= 1 && p <= NCH) {
                const int buf = (p - 1) & 1;
                const float* base = SA + buf * 2048;
                float* yc = YC + buf * 2048 + myrow;
                float w_c = base[lane], kd_c = base[4096 + lane], bb_c = base[2 * 4096 + lane], nk_c = base[3 * 4096 + lane], r_c = base[4 * 4096 + lane], v_c = base[5 * 4096 + myrow];
                for (int t = 0; t < 32; ++t) {
                    const int tn = (t + 1) & 31;
                    const float w_n = base[tn * 64 + lane], kd_n = base[4096 + tn * 64 + lane], bb_n = base[2 * 4096 + tn * 64 + lane], nk_n = base[3 * 4096 + tn * 64 + lane], r_n = base[4 * 4096 + tn * 64 + lane], v_n = base[5 * 4096 + tn * 64 + myrow];
                    float sap;
                    asm volatile("s_nop 1\n\t"
                        "v_mul_f32_dpp %0, %1, %2" DPPB(0) "v_fmac_f32_dpp %0, %1, %3" DPPB(1) "v_fmac_f32_dpp %0, %1, %4" DPPB(2) "v_fmac_f32_dpp %0, %1, %5" DPPB(3)
                        "v_fmac_f32_dpp %0, %1, %6" DPPB(4) "v_fmac_f32_dpp %0, %1, %7" DPPB(5) "v_fmac_f32_dpp %0, %1, %8" DPPB(6) "v_fmac_f32_dpp %0, %1, %9" DPPB(7)
                        "v_fmac_f32_dpp %0, %1, %10" DPPB(8) "v_fmac_f32_dpp %0, %1, %11" DPPB(9) "v_fmac_f32_dpp %0, %1, %12" DPPB(10) "v_fmac_f32_dpp %0, %1, %13" DPPB(11)
                        "v_fmac_f32_dpp %0, %1, %14" DPPB(12) "v_fmac_f32_dpp %0, %1, %15" DPPB(13) "v_fmac_f32_dpp %0, %1, %16" DPPB(14) "v_fmac_f32_dpp %0, %1, %17" DPPB(15)
                        "s_nop 1"
                        : "=&v"(sap)
                        : "v"(nk_c), "v"(s0), "v"(s1), "v"(s2), "v"(s3), "v"(s4), "v"(s5), "v"(s6), "v"(s7), "v"(s8), "v"(s9), "v"(s10), "v"(s11), "v"(s12), "v"(s13), "v"(s14), "v"(s15));
                    const float sa = red_rows(sap);
                    float yp;
                    asm volatile("s_nop 1\n\t"
                        RW_UPD(0, "%0") RW_UPD(1, "%1") RW_UPD(2, "%2") RW_UPD(3, "%3") RW_UPD(4, "%4") RW_UPD(5, "%5") RW_UPD(6, "%6") RW_UPD(7, "%7")
                        RW_UPD(8, "%8") RW_UPD(9, "%9") RW_UPD(10, "%10") RW_UPD(11, "%11") RW_UPD(12, "%12") RW_UPD(13, "%13") RW_UPD(14, "%14") RW_UPD(15, "%15")
                        "v_mul_f32_dpp %16, %20, %0" DPPB(0) "v_fmac_f32_dpp %16, %20, %1" DPPB(1) "v_fmac_f32_dpp %16, %20, %2" DPPB(2) "v_fmac_f32_dpp %16, %20, %3" DPPB(3)
                        "v_fmac_f32_dpp %16, %20, %4" DPPB(4) "v_fmac_f32_dpp %16, %20, %5" DPPB(5) "v_fmac_f32_dpp %16, %20, %6" DPPB(6) "v_fmac_f32_dpp %16, %20, %7" DPPB(7)
                        "v_fmac_f32_dpp %16, %20, %8" DPPB(8) "v_fmac_f32_dpp %16, %20, %9" DPPB(9) "v_fmac_f32_dpp %16, %20, %10" DPPB(10) "v_fmac_f32_dpp %16, %20, %11" DPPB(11)
                        "v_fmac_f32_dpp %16, %20, %12" DPPB(12) "v_fmac_f32_dpp %16, %20, %13" DPPB(13) "v_fmac_f32_dpp %16, %20, %14" DPPB(14) "v_fmac_f32_dpp %16, %20, %15" DPPB(15)
                        "s_nop 1"
                        : "+v"(s0), "+v"(s1), "+v"(s2), "+v"(s3), "+v"(s4), "+v"(s5), "+v"(s6), "+v"(s7), "+v"(s8), "+v"(s9), "+v"(s10), "+v"(s11), "+v"(s12), "+v"(s13), "+v"(s14), "+v"(s15), "=&v"(yp)
                        : "v"(w_c), "v"(bb_c), "v"(kd_c), "v"(r_c), "v"(sa), "v"(v_c));
                    const float y = red_rows(yp);
                    if (cg == 0) yc[t * 64] = y;
                    w_c = w_n; kd_c = kd_n; bb_c = bb_n; nk_c = nk_n; r_c = r_n; v_c = v_n;
                }
            }
            __syncthreads();
        }
    }
    __syncthreads();
}
DI void rwkv_finish(bf16_t* YF, const bf16_t* YB, const bf16_t* RKV, const bf16_t* G, const float* RK, const float* lng, const float* lnb, int Mrows, int gw, int ngw, int lane) {
    for (int row = gw; row < Mrows; row += ngw) {
        const int c0 = 16 * lane, hd = lane >> 2;
        const bf16x8 a0 = *(const bf16x8*)(YF + (size_t)row * 1024 + c0), a1 = *(const bf16x8*)(YF + (size_t)row * 1024 + c0 + 8);
        const bf16x8 b0 = *(const bf16x8*)(YB + (size_t)row * 1024 + c0), b1 = *(const bf16x8*)(YB + (size_t)row * 1024 + c0 + 8);
        const bf16x8 v0 = *(const bf16x8*)(RKV + (size_t)row * 3072 + 2048 + c0), v1 = *(const bf16x8*)(RKV + (size_t)row * 3072 + 2048 + c0 + 8);
        const bf16x8 g0 = *(const bf16x8*)(G + (size_t)row * 1024 + c0), g1 = *(const bf16x8*)(G + (size_t)row * 1024 + c0 + 8);
        const float rk = RK[(size_t)row * 16 + hd] + RK[(size_t)MT * 16 + (size_t)row * 16 + hd];
        float y[16]; float sm = 0.f;
#pragma unroll
        for (int e = 0; e < 8; ++e) { y[e] = bf2f((bf16_t)a0[e]) + bf2f((bf16_t)b0[e]); y[8 + e] = bf2f((bf16_t)a1[e]) + bf2f((bf16_t)b1[e]); }
#pragma unroll
        for (int e = 0; e < 16; ++e) sm += y[e];
        sm += __shfl_xor(sm, 1); sm += __shfl_xor(sm, 2);
        const float mu = sm * (1.f / 64.f);
        float sv = 0.f;
#pragma unroll
        for (int e = 0; e < 16; ++e) { y[e] -= mu; sv += y[e] * y[e]; }
        sv += __shfl_xor(sv, 1); sv += __shfl_xor(sv, 2);
        const float rinv = rsqrtf(sv * (1.f / 64.f) + 64e-5f);
        float o[16];
#pragma unroll
        for (int e = 0; e < 16; ++e) { const float vv = bf2f((bf16_t)(e < 8 ? v0[e] : v1[e - 8])), gg = bf2f((bf16_t)(e < 8 ? g0[e] : g1[e - 8]));
            o[e] = (y[e] * rinv * lng[c0 + e] + lnb[c0 + e] + rk * vv) * gg; }
        u32x4 w0, w1; w0.x = cvtpk(o[0], o[1]); w0.y = cvtpk(o[2], o[3]); w0.z = cvtpk(o[4], o[5]); w0.w = cvtpk(o[6], o[7]);
        w1.x = cvtpk(o[8], o[9]); w1.y = cvtpk(o[10], o[11]); w1.z = cvtpk(o[12], o[13]); w1.w = cvtpk(o[14], o[15]);
        *(u32x4*)(YF + (size_t)row * 1024 + c0) = w0; *(u32x4*)(YF + (size_t)row * 1024 + c0 + 8) = w1;
    }
}

#define WSP(T, off) ((T*)(a.ws + (off)))
#define PHASE(k) if (lo <= (k) && (k) < hi)
#define SEAM(k) do { if ((k) + 1 < hi) grid.sync(); } while (0)
template <int L> DI void run_layer(const Args& a, unsigned char* lds, cg::grid_group& grid, int lo, int hi) {
    constexpr int kind = L % 3, jj = L / 3, P0 = 1 + 8 * L;
    constexpr bool need_ctx = L < 3;
    constexpr int Mact = need_ctx ? MT : ML;
    const int tid = threadIdx.x, lane = tid & 63, wid = __builtin_amdgcn_readfirstlane(tid >> 6);
    const int gw = blockIdx.x * 8 + wid, ngw = gridDim.x * 8;
    LAS unsigned char* ldsl = (LAS unsigned char*)lds;
    PHASE(P0 + 0) {
        float* scr = (float*)(lds + wid * 8704);
        const float* modl = WSP(float, WS_MOD) + (size_t)L * 9 * 6144;
        phase_prenorm(L == 0 ? a.in[0] : a.out, L == 0 ? a.in[2] : WSP(float, WS_ZF), a.in[6] + L * 1024, modl, 0, WSP(bf16_t, WS_H2), kind == 2 ? 2048 : 1024, kind == 2, MT, gw, ngw, lane);
        bf16_t* Wmix = WSP(bf16_t, W_MIX); bf16_t* Wo = WSP(bf16_t, W_O);
        conv_job(a.in[8] + (size_t)L * 1024 * 4096, 4096, 1024, 4096, 1024, 4096, nullptr, 0, WSP(bf16_t, W_1), 1024, 0, 0, scr, gw, ngw, lane);
        conv_job(a.in[9] + (size_t)L * 4096 * 1024, 1024, 4096, 1024, 4096, 1024, nullptr, 0, WSP(bf16_t, W_2), 4096, 0, 0, scr, gw, ngw, lane);
        if (kind == 0) {
            conv_job(a.in[11] + (size_t)jj * 1024 * 3072, 3072, 1024, 3072, 1024, 3072, nullptr, 0, Wmix, 1024, 0, 0, scr, gw, ngw, lane);
            conv_job(a.in[12] + (size_t)jj * 1024 * 1024, 1024, 1024, 1024, 1024, 1024, nullptr, 0, Wo, 1024, 0, 0, scr, gw, ngw, lane);
        } else if (kind == 1) {
            conv_job(a.in[14], 3104, 1024, 3104, 1024, 3328, nullptr, 0, Wmix, 1024, 0, 0, scr, gw, ngw, lane);
            conv_job(a.in[18], 1024, 1024, 1024, 1024, 1024, nullptr, 0, Wo, 1024, 0, 0, scr, gw, ngw, lane);
        } else {
            const float* mix = a.in[19];
            for (int md = 1; md <= 2; ++md) {
                const int co = (md - 1) * 1024;
                for (int q = 0; q < 3; ++q) conv_job(a.in[20] + (size_t)q * 1024 * 1024, 1024, 1024, 1024, 1024, 1024, mix + (q == 0 ? 0 : q + 1) * 1024, md, Wmix, 2048, q * 1024, co, scr, gw, ngw, lane);
                conv_job(a.in[27], 160, 1024, 160, 1024, 256, mix + 5 * 1024, md, Wmix, 2048, 3072, co, scr, gw, ngw, lane);
                for (int q = 0; q < 2; ++q) conv_job(a.in[22] + (size_t)q * 1024 * 64, 64, 1024, 64, 1024, 64, mix + 1 * 1024, md, Wmix, 2048, 3328 + 64 * q, co, scr, gw, ngw, lane);
                for (int q = 0; q < 2; ++q) conv_job(a.in[25] + (size_t)q * 1024 * 64, 64, 1024, 64, 1024, 64, mix + 4 * 1024, md, Wmix, 2048, 3456 + 64 * q, co, scr, gw, ngw, lane);
            }
            conv_job(a.in[28], 1024, 160, 1024, 256, 1024, nullptr, 0, WSP(bf16_t, W_G2), 256, 0, 0, scr, gw, ngw, lane);
            conv_job(a.in[34], 1024, 1024, 1024, 1024, 1024, nullptr, 0, Wo, 1024, 0, 0, scr, gw, ngw, lane);
        }
        SEAM(P0 + 0);
    }
    PHASE(P0 + 1) {
        bf16_t* BIG = WSP(bf16_t, WS_BIG);
        for (int rep = 0; rep < ((DUP & 8) ? 2 : 1); ++rep) {
        if (kind == 0) run_gemm(ldsl, WSP(bf16_t, WS_H2), WSP(bf16_t, W_MIX), MT, 3072, 1024, InNaQkv{BIG, BIG + (size_t)MT * 2048, BIG + (size_t)MT * 2048 + (size_t)ML * 1024});
        else if (kind == 1) run_gemm(ldsl, WSP(bf16_t, WS_H2), WSP(bf16_t, W_MIX), MT, 3328, 1024, InGlaIn{BIG, WSP(float, WS_LR)});
        else run_gemm(ldsl, WSP(bf16_t, WS_H2), WSP(bf16_t, W_MIX), MT, 3584, 2048, InRwL1{BIG, BIG + (size_t)MT * 3072, BIG + (size_t)MT * 3328});
        }
        SEAM(P0 + 1);
    }
    PHASE(P0 + 2) {
        bf16_t* BIG = WSP(bf16_t, WS_BIG); bf16_t* H2 = WSP(bf16_t, WS_H2);
        if (kind == 0) {
            const bf16_t* VTL = BIG + (size_t)MT * 2048; const bf16_t* VTC = VTL + (size_t)ML * 1024;
            const float* rpb = a.in[13] + (size_t)jj * 16 * 15 * 31;
            const int nu = 8192 + (need_ctx ? 512 : 0);
#ifndef NO_ATTN
            for (int rep = 0; rep < ((DUP & 1) ? 2 : 1); ++rep)
            for (int u = gw; u < nu; u += ngw) {
                if (u < 8192) attn_unit(BIG, VTL, VTC, H2, rpb, u >> 10, (u >> 6) & 15, u & 63, 0, lane);
                else { const int v = u - 8192; attn_unit(BIG, VTL, VTC, H2, rpb, v >> 6, (v >> 2) & 15, -1, v & 3, lane); }
            }
#endif
        } else if (kind == 1) {
#ifndef NO_GLA
            for (int rep = 0; rep < ((DUP & 2) ? 2 : 1); ++rep)
            for (int u = blockIdx.x; u < 256; u += gridDim.x) gla_unit(BIG, WSP(float, WS_LR), a.in[15], a.in[16], H2, lds, u, tid);
#endif
        } else {
#ifndef NO_RWKV
            for (int rep = 0; rep < ((DUP & 4) ? 2 : 1); ++rep)
            for (int u = blockIdx.x; u < 256; u += gridDim.x) rwkv_unit(a, BIG, BIG + (size_t)MT * 3328, H2, WSP(float, WS_RK), lds, u, tid);
#endif
            run_gemm(ldsl, BIG + (size_t)MT * 3072, WSP(bf16_t, W_G2), MT, 1024, 256, InStore<0>{WSP(bf16_t, WS_G), 1024});
        }
        SEAM(P0 + 2);
    }
    if (kind != 0) {
        PHASE(P0 + 3) {
            bf16_t* H2 = WSP(bf16_t, WS_H2);
            if (kind == 1) gla_finish(H2, H2 + (size_t)MT * 1024, WSP(bf16_t, WS_BIG), a.in[17], Mact, gw, ngw, lane);
            else rwkv_finish(H2, H2 + (size_t)MT * 1024, WSP(bf16_t, WS_BIG), WSP(bf16_t, WS_G), WSP(float, WS_RK), a.in[32], a.in[33], Mact, gw, ngw, lane);
            SEAM(P0 + 3);
        }
    }
    PHASE(P0 + 4) {
        run_gemm(ldsl, WSP(bf16_t, WS_H2), WSP(bf16_t, W_O), Mact, 1024, 1024, InResid{L == 0 ? a.in[0] : a.out, L == 0 ? a.in[2] : WSP(float, WS_ZF), a.out, WSP(float, WS_ZF), WSP(float, WS_MOD) + (size_t)L * 9 * 6144 + 2 * 1024});
        SEAM(P0 + 4);
    }
    PHASE(P0 + 5) {
        phase_prenorm(a.out, WSP(float, WS_ZF), a.in[7] + L * 1024, WSP(float, WS_MOD) + (size_t)L * 9 * 6144, 3, WSP(bf16_t, WS_H2), 1024, false, Mact, gw, ngw, lane);
        SEAM(P0 + 5);
    }
    PHASE(P0 + 6) {
        for (int rep = 0; rep < ((DUP & 8) ? 2 : 1); ++rep)
        run_gemm(ldsl, WSP(bf16_t, WS_H2), WSP(bf16_t, W_1), Mact, 4096, 1024, InStore<1>{WSP(bf16_t, WS_BIG), 4096});
        SEAM(P0 + 6);
    }
    PHASE(P0 + 7) {
        run_gemm(ldsl, WSP(bf16_t, WS_BIG), WSP(bf16_t, W_2), Mact, 1024, 4096, InResid{a.out, WSP(float, WS_ZF), a.out, WSP(float, WS_ZF), WSP(float, WS_MOD) + (size_t)L * 9 * 6144 + 5 * 1024});
        SEAM(P0 + 7);
    }
}
__global__ void __launch_bounds__(NTHREADS, 2) mega(Args a) {
    extern __shared__ __attribute__((aligned(16))) unsigned char lds[];
    cg::grid_group grid = cg::this_grid();
    const int lo = a.lo, hi = a.hi;
    PHASE(0) { phase_mod(a, (float*)lds, threadIdx.x); SEAM(0); }
    run_layer<0>(a, lds, grid, lo, hi);
    run_layer<1>(a, lds, grid, lo, hi);
    run_layer<2>(a, lds, grid, lo, hi);
    run_layer<3>(a, lds, grid, lo, hi);
    PHASE(33) {
        const int tid = threadIdx.x, lane = tid & 63, wid = tid >> 6;
        const int gw = blockIdx.x * 8 + wid, ngw = gridDim.x * 8;
        const float* fg = a.in[10];
        for (int row = gw; row < ML; row += ngw) {
            float* xr = a.out + (size_t)row * 1024; f32x4 v[4]; float s = 0.f;
#pragma unroll
            for (int j = 0; j < 4; ++j) { v[j] = *(const f32x4*)(xr + 4 * lane + 256 * j); s += (v[j].x * v[j].x + v[j].y * v[j].y) + (v[j].z * v[j].z + v[j].w * v[j].w); }
            s = wave_sum(s); const float rinv = rsqrtf(s * (1.f / 1024.f) + 1e-6f);
#pragma unroll
            for (int j = 0; j < 4; ++j) *(f32x4*)(xr + 4 * lane + 256 * j) = v[j] * rinv * *(const f32x4*)(fg + 4 * lane + 256 * j);
        }
    }
}

#ifndef GM
#define GM 0xffff
#endif
#ifndef MULTI_LAUNCH
#define MULTI_LAUNCH 0
#endif
extern "C" void kernel_launch(void* const* d_in, const int* in_sizes, int n_in, void* d_out, int out_size, void* d_ws, size_t ws_size, hipStream_t stream) {
    static int grid_blocks = 0;
    if (!grid_blocks) {
        int dev = 0, cus = 0, per_cu = 0;
        hipGetDevice(&dev);
        hipDeviceGetAttribute(&cus, hipDeviceAttributeMultiprocessorCount, dev);
        hipFuncSetAttribute((const void*)mega, hipFuncAttributeMaxDynamicSharedMemorySize, LDS_BYTES);
        hipOccupancyMaxActiveBlocksPerMultiprocessor(&per_cu, (const void*)mega, NTHREADS, LDS_BYTES);
        if (per_cu < 1) per_cu = 1;
        grid_blocks = cus * per_cu;
    }
    Args a{};
    for (int i = 0; i < 35; ++i) a.in[i] = (const float*)d_in[i];
    a.out = (float*)d_out; a.ws = (unsigned char*)d_ws;
#if MULTI_LAUNCH
    for (int p = 0; p < 34; ++p) { a.lo = p; a.hi = p + 1; hipLaunchKernelGGL(mega, dim3(grid_blocks), dim3(NTHREADS), LDS_BYTES, stream, a); }
#else
    a.lo = 0; a.hi = 34;
    void* args[] = {&a};
    hipError_t e = hipLaunchCooperativeKernel((const void*)mega, dim3(grid_blocks), dim3(NTHREADS), args, LDS_BYTES, stream);
    if (e != hipSuccess) fprintf(stderr, "cooperative launch failed: %s (grid %d)\n", hipGetErrorString(e), grid_blocks);
#endif
}
```

```cpp
#include <hip/hip_runtime.h>
#include <hip/hip_cooperative_groups.h>
#include <cstdio>
#include <cstdint>
namespace cg = cooperative_groups;

namespace pg8 {
#define PG8_LAS __attribute__((address_space(3)))
typedef unsigned short bf16_t;
typedef short bf16x8 __attribute__((ext_vector_type(8)));
typedef float f32x4 __attribute__((ext_vector_type(4)));
typedef unsigned u32x4 __attribute__((ext_vector_type(4)));
constexpr int BM = 256, BK = 64, HALF = 128, HTB = HALF * BK * 2  , STAGE_BYTES = 8 * HTB, NXCD = 8, WGM = 8;

__host__ __device__ __forceinline__ int lds_byte(int r, int c) { const int st = (r >> 4) * 2 + (c >> 5), rr = r & 15, cc = c & 31, ob = rr * 64 + cc * 2; return st * 1024 + (ob ^ (((ob >> 9) & 1) << 5)); }
__host__ __device__ __forceinline__ void stage_rc(int b, int& R, int& C) { const int st = b / 1024, sb = b % 1024, swz = sb ^ (((sb >> 9) & 1) << 5); R = (st >> 1) * 16 + swz / 64; C = (st & 1) * 32 + (swz % 64) / 2; }
__host__ __device__ __forceinline__ int perm32(int rho) { const int n = rho >> 4, i = rho & 15; return 8 * (i >> 2) + 4 * n + (i & 3); }

struct Unit { int pm, pn; };
struct Gemm { const bf16_t* A; const bf16_t* Bt; int M, N, K; };

struct StaticOrder {
    int nM, nN, nwg, G, c;
    __host__ __device__ void init(int M, int N, int G_, int c_) { nM = M / BM; nN = N / BM; nwg = nM * nN; G = G_; c = c_; }
    __host__ __device__ bool next(int i, Unit& u) const {
        const long L = (long)i * G + c; if (L >= nwg) return false;
        int wgid = (int)L; { const int q = nwg / NXCD, r = nwg % NXCD, xcd = wgid % NXCD, off = wgid / NXCD; wgid = (xcd < r ? xcd * (q + 1) : r * (q + 1) + (xcd - r) * q) + off; }
        const int nig = WGM * nN, gid = wgid / nig, fm = gid * WGM, gsz = (nM - fm) < WGM ? (nM - fm) : WGM;
        u.pm = fm + ((wgid % nig) % gsz); u.pn = (wgid % nig) / gsz; return true;
    }
    __device__ __forceinline__ void a_ready(const Unit&) const {}
    __device__ __forceinline__ void done(const Unit&) const {}
};

__device__ __forceinline__ unsigned cvt_pk_bf16(float lo, float hi) { unsigned r; asm volatile("v_cvt_pk_bf16_f32 %0, %1, %2" : "=v"(r) : "v"(lo), "v"(hi)); return r; }
template <class Epi, class Sched, bool ALIGN_EPI = false, bool SP2 = false>
__device__ __forceinline__ void gemm_phase(PG8_LAS unsigned char* lds, const Gemm g, const Sched& S, const Epi& E) {
    const int tid = threadIdx.x, wid = __builtin_amdgcn_readfirstlane(tid >> 6), lane = tid & 63, wr = wid >> 2, wc = wid & 3, fr = lane & 15, fq = lane >> 4;
    const int K = g.K, nt = K / BK;
    unsigned voffA[2], voffB[2];
#pragma unroll
    for (int i = 0; i < 2; ++i) { int R, C; stage_rc(tid * 16 + i * 8192, R, C); const int Rb = Epi::PERM ? ((R & ~31) + perm32(R & 31)) : R;
        voffA[i] = (unsigned)(R * K + C) * 2u; voffB[i] = (unsigned)(Rb * K + C) * 2u; }
    const size_t kstep = (size_t)(BK * 2);
    const size_t hstep = (size_t)HALF * K * 2;
    const size_t tstep = 2 * hstep;
    const unsigned ldsw = (unsigned)wid * 1024u;
    const int aoff = lds_byte(wr * 64 + fr, fq * 8), boff = lds_byte(wc * 32 + fr, fq * 8);
#define PG8_SA(b, h) (((b) * 2 + (h)) * HTB)
#define PG8_SB(b, h) ((4 + (b) * 2 + (h)) * HTB)
#define PG8_STAGE(bufoff, gbase, voff) do { _Pragma("unroll") for (int _i = 0; _i < 2; ++_i) \
        __builtin_amdgcn_global_load_lds((const unsigned*)((const char*)(gbase) + (voff)[_i]), (PG8_LAS unsigned*)(lds + (bufoff) + ldsw + _i * 8192), 16, 0, 0); } while (0)
#define PG8_LDA(dst, b, h) do { _Pragma("unroll") for (int m = 0; m < 4; ++m) _Pragma("unroll") for (int k = 0; k < 2; ++k) dst[m][k] = *(const PG8_LAS bf16x8*)(lds + PG8_SA(b, h) + aoff + m * 2048 + k * 1024); } while (0)
#define PG8_LDB(dst, b, h) do { _Pragma("unroll") for (int n = 0; n < 2; ++n) _Pragma("unroll") for (int k = 0; k < 2; ++k) dst[n][k] = *(const PG8_LAS bf16x8*)(lds + PG8_SB(b, h) + boff + n * 2048 + k * 1024); } while (0)
#define PG8_MMA(ai, bj, At, Bt) do { __builtin_amdgcn_s_setprio(1); _Pragma("unroll") for (int m = 0; m < 4; ++m) _Pragma("unroll") for (int n = 0; n < 2; ++n) _Pragma("unroll") for (int k = 0; k < 2; ++k) \
        acc[ai][bj][m][n] = __builtin_amdgcn_mfma_f32_16x16x32_bf16(Bt[n][k], At[m][k], acc[ai][bj][m][n], 0, 0, 0); __builtin_amdgcn_s_setprio(0); } while (0)
#define PG8_WAIT_V(n) asm volatile("s_waitcnt vmcnt(" #n ")" ::: "memory")
#define PG8_WAIT_L(n) asm volatile("s_waitcnt lgkmcnt(" #n ")" ::: "memory")
#define PG8_BAR __builtin_amdgcn_s_barrier()
#define PG8_SCHED __builtin_amdgcn_sched_barrier(0)
    Unit cur, nxt; int ui = 0;
    if (!S.next(0, cur)) return;
    f32x4 acc[2][2][4][2];
#pragma unroll
    for (int a = 0; a < 2; ++a)
#pragma unroll
        for (int b = 0; b < 2; ++b)
#pragma unroll
            for (int m = 0; m < 4; ++m)
#pragma unroll
                for (int n = 0; n < 2; ++n) acc[a][b][m][n] = (f32x4){0.f, 0.f, 0.f, 0.f};
    bf16x8 At[4][2], B0[2][2], B1[2][2];
    const char* cA = (const char*)g.A + (size_t)cur.pm * tstep; const char* cB = (const char*)g.Bt + (size_t)cur.pn * tstep;
    S.a_ready(cur);
    if constexpr (SP2) {
        PG8_STAGE(PG8_SB(0, 0), cB, voffB); PG8_STAGE(PG8_SB(0, 1), cB + hstep, voffB); PG8_STAGE(PG8_SA(0, 0), cA, voffA); PG8_STAGE(PG8_SA(0, 1), cA + hstep, voffA);
        if (wr == 1) PG8_BAR;
        PG8_WAIT_V(2); PG8_BAR;
        PG8_STAGE(PG8_SB(1, 0), cB + kstep, voffB); PG8_STAGE(PG8_SA(1, 0), cA + kstep, voffA); PG8_STAGE(PG8_SB(1, 1), cB + hstep + kstep, voffB);
        PG8_WAIT_V(6); PG8_BAR;
    } else {
        PG8_STAGE(PG8_SB(0, 0), cB, voffB); PG8_STAGE(PG8_SA(0, 0), cA, voffA); PG8_STAGE(PG8_SB(0, 1), cB + hstep, voffB); PG8_STAGE(PG8_SA(0, 1), cA + hstep, voffA);
        if (wr == 1) PG8_BAR;
        PG8_WAIT_V(4); PG8_BAR;
        PG8_STAGE(PG8_SB(1, 0), cB + kstep, voffB); PG8_STAGE(PG8_SA(1, 0), cA + kstep, voffA); PG8_STAGE(PG8_SB(1, 1), cB + hstep + kstep, voffB);
        PG8_WAIT_V(6); PG8_BAR;
    }
    for (;;) {
        const bool has_next = S.next(ui + 1, nxt);
        const char* nA = has_next ? (const char*)g.A + (size_t)nxt.pm * tstep : cA; const char* nB = has_next ? (const char*)g.Bt + (size_t)nxt.pn * tstep : cB;
        for (int t = 0; t < nt; t += 2) {
            const bool last = (t == nt - 2);
            const char* a1 = cA + (size_t)(t + 1) * kstep;
            const char* a2 = last ? nA : cA + (size_t)(t + 2) * kstep; const char* b2 = last ? nB : cB + (size_t)(t + 2) * kstep;
            const char* a3 = a2 + kstep; const char* b3 = b2 + kstep;
            if (last && has_next) S.a_ready(nxt);
            if constexpr (SP2) {
            PG8_LDB(B0, 0, 0); PG8_LDB(B1, 0, 1); PG8_SCHED; PG8_LDA(At, 0, 0); PG8_STAGE(PG8_SA(1, 1), a1 + hstep, voffA);
            PG8_WAIT_V(8); PG8_WAIT_L(0); PG8_BAR; PG8_MMA(0, 0, At, B0); PG8_MMA(0, 1, At, B1); PG8_BAR; PG8_SCHED;
            PG8_LDA(At, 0, 1); PG8_STAGE(PG8_SB(0, 0), b2, voffB); PG8_STAGE(PG8_SB(0, 1), b2 + hstep, voffB); PG8_STAGE(PG8_SA(0, 0), a2, voffA);
            PG8_WAIT_V(8); PG8_WAIT_L(0); PG8_BAR; PG8_MMA(1, 0, At, B0); PG8_MMA(1, 1, At, B1); PG8_BAR; PG8_SCHED;
            PG8_LDB(B0, 1, 0); PG8_LDB(B1, 1, 1); PG8_SCHED; PG8_LDA(At, 1, 0); PG8_STAGE(PG8_SA(0, 1), a2 + hstep, voffA);
            PG8_WAIT_V(8); PG8_WAIT_L(0); PG8_BAR; PG8_MMA(0, 0, At, B0); PG8_MMA(0, 1, At, B1); PG8_BAR; PG8_SCHED;
            PG8_LDA(At, 1, 1); PG8_STAGE(PG8_SB(1, 0), b3, voffB); PG8_STAGE(PG8_SB(1, 1), b3 + hstep, voffB); PG8_STAGE(PG8_SA(1, 0), a3, voffA);
            PG8_WAIT_V(8); PG8_WAIT_L(0); PG8_BAR; PG8_MMA(1, 0, At, B0); PG8_MMA(1, 1, At, B1); PG8_BAR; PG8_SCHED;
            } else {
            PG8_LDB(B0, 0, 0); PG8_SCHED; PG8_LDA(At, 0, 0); PG8_STAGE(PG8_SA(1, 1), a1 + hstep, voffA);
            PG8_WAIT_L(8); PG8_BAR; PG8_WAIT_L(0); PG8_MMA(0, 0, At, B0); PG8_BAR; PG8_SCHED;
            PG8_LDB(B1, 0, 1); PG8_STAGE(PG8_SB(0, 0), b2, voffB);
            PG8_BAR; PG8_WAIT_L(0); PG8_MMA(0, 1, At, B1); PG8_BAR;
            PG8_LDA(At, 0, 1); PG8_STAGE(PG8_SA(0, 0), a2, voffA);
            PG8_BAR; PG8_WAIT_L(0); PG8_MMA(1, 0, At, B0); PG8_BAR; PG8_SCHED;
            PG8_STAGE(PG8_SB(0, 1), b2 + hstep, voffB);
            PG8_WAIT_V(6); PG8_BAR; PG8_MMA(1, 1, At, B1); PG8_BAR;
            PG8_LDB(B0, 1, 0); PG8_SCHED; PG8_LDA(At, 1, 0); PG8_STAGE(PG8_SA(0, 1), a2 + hstep, voffA);
            PG8_WAIT_L(8); PG8_BAR; PG8_WAIT_L(0); PG8_MMA(0, 0, At, B0); PG8_BAR; PG8_SCHED;
            PG8_LDB(B1, 1, 1); PG8_STAGE(PG8_SB(1, 0), b3, voffB);
            PG8_BAR; PG8_WAIT_L(0); PG8_MMA(0, 1, At, B1); PG8_BAR;
            PG8_LDA(At, 1, 1); PG8_STAGE(PG8_SA(1, 0), a3, voffA);
            PG8_BAR; PG8_WAIT_L(0); PG8_MMA(1, 0, At, B0); PG8_BAR; PG8_SCHED;
            PG8_STAGE(PG8_SB(1, 1), b3 + hstep, voffB);
            PG8_WAIT_V(6); PG8_BAR; PG8_MMA(1, 1, At, B1); PG8_BAR;
            }
        }
        if constexpr (ALIGN_EPI) { if (wr == 0) PG8_BAR; }
        if constexpr (!Epi::AFTER_DRAIN) { E(acc, cur, wr, wc, fr, fq); S.done(cur); }
        if (!has_next) break;
#pragma unroll
        for (int a = 0; a < 2; ++a)
#pragma unroll
            for (int b = 0; b < 2; ++b)
#pragma unroll
                for (int m = 0; m < 4; ++m)
#pragma unroll
                    for (int n = 0; n < 2; ++n) acc[a][b][m][n] = (f32x4){0.f, 0.f, 0.f, 0.f};
        cur = nxt; cA = nA; cB = nB; ++ui;
        if constexpr (ALIGN_EPI) { if (wr == 1) PG8_BAR; }
    }
    PG8_WAIT_V(0);
    if constexpr (!ALIGN_EPI) { if (wr == 0) PG8_BAR; }
    PG8_BAR;
    if constexpr (Epi::AFTER_DRAIN) { E.fused(acc, cur, wr, wc, fr, fq, lds, wid, lane); S.done(cur); }
#undef PG8_SA
#undef PG8_SB
#undef PG8_STAGE
#undef PG8_LDA
#undef PG8_LDB
#undef PG8_MMA
#undef PG8_WAIT_V
#undef PG8_WAIT_L
#undef PG8_BAR
#undef PG8_SCHED
}
}

#ifndef DUP
#define DUP 0
#endif
#define DI __device__ __forceinline__
#define LAS __attribute__((address_space(3)))
typedef unsigned short bf16_t;
typedef short bf16x8 __attribute__((ext_vector_type(8)));
typedef float f32x4 __attribute__((ext_vector_type(4)));
typedef float f32x16 __attribute__((ext_vector_type(16)));
typedef unsigned u32x4 __attribute__((ext_vector_type(4)));
typedef unsigned u32x2 __attribute__((ext_vector_type(2)));
typedef float f32x2_t __attribute__((ext_vector_type(2)));
typedef __bf16 bf16x2_t __attribute__((ext_vector_type(2)));

constexpr int D = 1024, NB = 8, SEQ = 4096, CTX = 256, FF = 4096;
constexpr int ML = NB * SEQ, MC = NB * CTX, MT = ML + MC;
constexpr size_t MiB = 1u << 20;
constexpr size_t WS_MOD = 0, WS_ZF = 1 * MiB, WS_RK = 9 * MiB, WS_LR = 14 * MiB, WS_W = 20 * MiB, WS_H2 = 56 * MiB, WS_BIG = 192 * MiB, WS_G = 430 * MiB;
constexpr size_t W_MIX = WS_W, W_O = WS_W + 14 * MiB, W_G2 = WS_W + 16 * MiB, W_1 = WS_W + 17 * MiB, W_2 = WS_W + 25 * MiB;
constexpr int LDS_BYTES = 147456;
constexpr size_t WS_BAR = 983040;
constexpr int NTHREADS = 512;

struct Args { const float* in[35]; float* out; unsigned char* ws; int lo, hi; };

DI float bf2f(bf16_t v) { return __uint_as_float(((unsigned)v) << 16); }
DI unsigned cvtpk(float lo, float hi) { f32x2_t v = {lo, hi}; bf16x2_t b = __builtin_convertvector(v, bf16x2_t); return __builtin_bit_cast(unsigned, b); }
DI bf16_t f2bf(float x) { return (bf16_t)(cvtpk(x, 0.f) & 0xffffu); }
DI float wave_sum(float v) {
#pragma unroll
    for (int o = 1; o < 64; o <<= 1) v += __shfl_xor(v, o);
    return v;
}
DI float sigmoidf_(float x) { return 1.f / (1.f + __expf(-x)); }
DI float softplusf_(float x) { return fmaxf(x, 0.f) + log1pf(__expf(-fabsf(x))); }
DI int crow(int i, int h) { return (i & 3) + 8 * (i >> 2) + 4 * h; }
#define MFMA32(a, b, c) __builtin_amdgcn_mfma_f32_32x32x16_bf16((a), (b), (c), 0, 0, 0)

DI void mma_tile(f32x16& acc, const bf16_t* A, int lda, const bf16_t* Bt, int ldb, int ksteps, int lane) {
    const int rho = lane & 31, h = lane >> 5;
    const bf16_t* ap = A + rho * lda + 8 * h; const bf16_t* bp = Bt + rho * ldb + 8 * h;
    for (int s = 0; s < ksteps; ++s) {
        bf16x8 av = *(const bf16x8*)(ap + 16 * s); bf16x8 bv = *(const bf16x8*)(bp + 16 * s);
        acc = MFMA32(av, bv, acc);
    }
}

template <class Inner> struct Epi {
    static constexpr bool PERM = true, AFTER_DRAIN = false;
    Inner in;
    DI void operator()(const pg8::f32x4 (&acc)[2][2][4][2], const pg8::Unit& u, int wr, int wc, int fr, int fq) const {
        const int row0 = u.pm * 256 + wr * 64 + fr, col0 = u.pn * 256 + wc * 32 + 8 * fq;
#pragma unroll
        for (int ai = 0; ai < 2; ++ai)
#pragma unroll
            for (int m = 0; m < 4; ++m) {
                const int row = row0 + ai * 128 + m * 16;
#pragma unroll
                for (int bj = 0; bj < 2; ++bj) in.store8(row, col0 + bj * 128, acc[ai][bj][m][0], acc[ai][bj][m][1]);
            }
    }
};
DI u32x4 pack8(f32x4 a, f32x4 b) { u32x4 w; w.x = cvtpk(a[0], a[1]); w.y = cvtpk(a[2], a[3]); w.z = cvtpk(b[0], b[1]); w.w = cvtpk(b[2], b[3]); return w; }

template <int ACT> struct InStore {
    bf16_t* O; int ldc;
    DI void store8(int row, int col, f32x4 a, f32x4 b) const {
        if (ACT == 1) {
#pragma unroll
            for (int j = 0; j < 4; ++j) { float x = fmaxf(a[j], 0.f); a[j] = x * x; float y = fmaxf(b[j], 0.f); b[j] = y * y; }
        }
        *(u32x4*)(O + (size_t)row * ldc + col) = pack8(a, b);
    }
};
struct InNaQkv {
    bf16_t* QK; bf16_t* VTL; bf16_t* VTC;
    DI void store8(int row, int col, f32x4 a, f32x4 b) const {
        if (col < 2048) {
            const float sc = col < 1024 ? 0.125f : 1.f;
            *(u32x4*)(QK + (size_t)row * 2048 + col) = pack8(a * sc, b * sc);
        } else {
            const int c = col - 2048, hd = c >> 6, d0 = c & 63;
            bf16_t* p; size_t ld;
            if (row < ML) { const int b_ = row >> 12, t = row & 4095; p = VTL + ((size_t)((b_ * 16 + hd) * 64 + d0)) * 4096 + t; ld = 4096; }
            else { const int r2 = row - ML, b_ = r2 >> 8, t = r2 & 255; p = VTC + ((size_t)((b_ * 16 + hd) * 64 + d0)) * 256 + t; ld = 256; }
#pragma unroll
            for (int j = 0; j < 4; ++j) { p[(size_t)j * ld] = f2bf(a[j]); p[(size_t)(j + 4) * ld] = f2bf(b[j]); }
        }
    }
};
struct InResid {
    const float* sl; const float* sc; float* dl; float* dc; const float* gate;
    DI void store8(int row, int col, f32x4 a, f32x4 b) const {
        const float* s; float* d; int mi;
        if (row < ML) { s = sl + (size_t)row * 1024 + col; d = dl + (size_t)row * 1024 + col; mi = row >> 12; }
        else { s = sc + (size_t)(row - ML) * 1024 + col; d = dc + (size_t)(row - ML) * 1024 + col; mi = 8; }
        const float* g = gate + (size_t)mi * 6144 + col;
        const f32x4 g0 = *(const f32x4*)g, g1 = *(const f32x4*)(g + 4);
        const f32x4 x0 = *(const f32x4*)s, x1 = *(const f32x4*)(s + 4);
        *(f32x4*)d = x0 + g0 * a; *(f32x4*)(d + 4) = x1 + g1 * b;
    }
};
struct InGlaIn {
    bf16_t* P; float* LR;
    DI void store8(int row, int col, f32x4 a, f32x4 b) const {
        if (col < 3072) {
            const float sc = col < 512 ? 0.08838834764831845f : 1.f;
            *(u32x4*)(P + (size_t)row * 3072 + col) = pack8(a * sc, b * sc);
        } else if (col < 3104) {
            float* p = LR + (size_t)row * 32 + (col - 3072);
            *(f32x4*)p = a; *(f32x4*)(p + 4) = b;
        }
    }
};
struct InRwL1 {
    bf16_t* RKV; bf16_t* SG; bf16_t* TWAA;
    DI void store8(int row, int col, f32x4 a, f32x4 b) const {
        if (col < 3072) { *(u32x4*)(RKV + (size_t)row * 3072 + col) = pack8(a, b); }
        else if (col < 3328) {
#pragma unroll
            for (int j = 0; j < 4; ++j) { a[j] = sigmoidf_(a[j]); b[j] = sigmoidf_(b[j]); }
            *(u32x4*)(SG + (size_t)row * 256 + (col - 3072)) = pack8(a, b);
        } else {
            const int c = col - 3328;
            if (c < 128) {
#pragma unroll
                for (int j = 0; j < 4; ++j) { a[j] = tanhf(a[j]); b[j] = tanhf(b[j]); }
            }
            *(u32x4*)(TWAA + (size_t)row * 256 + c) = pack8(a, b);
        }
    }
};

template <class Inner> DI void run_gemm(LAS unsigned char* lds, const bf16_t* A, const bf16_t* Bt, int M, int N, int K, const Inner& in) {
    int Kr = K; asm volatile("" : "+s"(Kr));
    pg8::Gemm g{A, Bt, M, N, Kr}; pg8::StaticOrder S; S.init(M, N, (int)gridDim.x, (int)blockIdx.x);
    Epi<Inner> E{in};
#ifndef NO_GEMM
    pg8::gemm_phase<Epi<Inner>, pg8::StaticOrder, true, true>(lds, g, S, E);
#endif
    __syncthreads();
}

DI void conv_item(const float* W, int ldw, int Kv, int Nv, const float* mix, int mode, bf16_t* WT, int ldt, int row_off, int col_off, float* scr, int kb, int nb, int lane) {
    const int k0 = 64 * kb, n0 = 32 * nb;
#pragma unroll 8
    for (int i = 0; i < 32; ++i) {
        const int kk = 2 * i + (lane >> 5), k = k0 + kk, n = n0 + (lane & 31);
        float v = (k < Kv && n < Nv) ? W[(size_t)k * ldw + n] : 0.f;
        if (mode) { const float m = (k < Kv) ? mix[k] : 0.f; v *= (mode == 1) ? (1.f - m) : m; }
        scr[kk * 33 + (lane & 31)] = v;
    }
    __builtin_amdgcn_s_waitcnt(0xc07f); __builtin_amdgcn_wave_barrier();
    const int c = lane & 7;
#pragma unroll
    for (int j = 0; j < 4; ++j) {
        const int n = (lane >> 3) + 8 * j; const float* s = scr + (8 * c) * 33 + n;
        u32x4 o; o.x = cvtpk(s[0 * 33], s[1 * 33]); o.y = cvtpk(s[2 * 33], s[3 * 33]); o.z = cvtpk(s[4 * 33], s[5 * 33]); o.w = cvtpk(s[6 * 33], s[7 * 33]);
        *(u32x4*)(WT + (size_t)(row_off + n0 + n) * ldt + col_off + k0 + 8 * c) = o;
    }
    __builtin_amdgcn_s_waitcnt(0xc07f); __builtin_amdgcn_wave_barrier();
}
DI void conv_job(const float* W, int ldw, int Kv, int Nv, int Kp, int Np, const float* mix, int mode, bf16_t* WT, int ldt, int row_off, int col_off, float* scr, int gw, int ngw, int lane) {
    const int nkb = Kp / 64, nnb = Np / 32, nit = nkb * nnb;
    for (int it = gw; it < nit; it += ngw) conv_item(W, ldw, Kv, Nv, mix, mode, WT, ldt, row_off, col_off, scr, it / nnb, it % nnb, lane);
}

DI void norm_row(const float* xr, const f32x4 (&gs)[4], const f32x4 (&sh)[4], int lane, f32x4 (&out)[4]) {
    f32x4 v[4]; float s = 0.f;
#pragma unroll
    for (int j = 0; j < 4; ++j) { v[j] = *(const f32x4*)(xr + 4 * lane + 256 * j); s += (v[j].x * v[j].x + v[j].y * v[j].y) + (v[j].z * v[j].z + v[j].w * v[j].w); }
    s = wave_sum(s);
    const float rinv = rsqrtf(s * (1.f / 1024.f) + 1e-6f);
#pragma unroll
    for (int j = 0; j < 4; ++j) out[j] = v[j] * rinv * gs[j] + sh[j];
}
DI void store_row_bf16(bf16_t* o, const f32x4 (&v)[4], int lane) {
#pragma unroll
    for (int j = 0; j < 4; ++j) { u32x2 w; w.x = cvtpk(v[j].x, v[j].y); w.y = cvtpk(v[j].z, v[j].w); *(u32x2*)(o + 4 * lane + 256 * j) = w; }
}
DI void phase_prenorm(const float* xl, const float* xc, const float* g, const float* modl  , int shift_chunk, bf16_t* H, int ldh, bool with_hs, int Mrows, int gw, int ngw, int lane) {
#define XROW(r) ((r) < ML ? xl + (size_t)(r) * 1024 : xc + (size_t)((r) - ML) * 1024)
    if (!with_hs) {
        const int nstrips = Mrows / 4;
        for (int st = gw; st < nstrips; st += ngw) {
            const int row0 = 4 * st;
            const int mi = row0 < ML ? row0 >> 12 : 8;
            const float* mp = modl + (size_t)mi * 6144 + shift_chunk * 1024;
            f32x4 v[4][4]; float ss[4];
#pragma unroll
            for (int r = 0; r < 4; ++r) { const float* xr = XROW(row0 + r);
#pragma unroll
                for (int j = 0; j < 4; ++j) v[r][j] = *(const f32x4*)(xr + 4 * lane + 256 * j); }
            f32x4 gs[4], sh[4];
#pragma unroll
            for (int j = 0; j < 4; ++j) { const int c = 4 * lane + 256 * j; sh[j] = *(const f32x4*)(mp + c); const f32x4 sc = *(const f32x4*)(mp + 1024 + c); gs[j] = *(const f32x4*)(g + c) * (sc + 1.f); }
#pragma unroll
            for (int r = 0; r < 4; ++r) { float s = 0.f;
#pragma unroll
                for (int j = 0; j < 4; ++j) s += (v[r][j].x * v[r][j].x + v[r][j].y * v[r][j].y) + (v[r][j].z * v[r][j].z + v[r][j].w * v[r][j].w);
                ss[r] = s; }
#pragma unroll
            for (int o = 1; o < 64; o <<= 1) {
#pragma unroll
                for (int r = 0; r < 4; ++r) ss[r] += __shfl_xor(ss[r], o);
            }
#pragma unroll
            for (int r = 0; r < 4; ++r) { const float rinv = rsqrtf(ss[r] * (1.f / 1024.f) + 1e-6f); f32x4 o[4];
#pragma unroll
                for (int j = 0; j < 4; ++j) o[j] = v[r][j] * rinv * gs[j] + sh[j];
                store_row_bf16(H + (size_t)(row0 + r) * ldh, o, lane); }
        }
    } else {
        const int nstrips = Mrows / 8;
        for (int st = gw; st < nstrips; st += ngw) {
            const int row0 = 8 * st;
            int mi, seg0, seg1;
            if (row0 < ML) { mi = row0 >> 12; seg0 = row0 & ~4095; seg1 = seg0 + 4096; } else { mi = 8; seg0 = ML + ((row0 - ML) & ~255); seg1 = seg0 + 256; }
            const float* mp = modl + (size_t)mi * 6144 + shift_chunk * 1024;
            f32x4 gs[4], sh[4];
#pragma unroll
            for (int j = 0; j < 4; ++j) { const int c = 4 * lane + 256 * j; sh[j] = *(const f32x4*)(mp + c); const f32x4 sc = *(const f32x4*)(mp + 1024 + c); gs[j] = *(const f32x4*)(g + c) * (sc + 1.f); }
            f32x4 prev[4], cur[4], nxt[4];
            if (row0 > seg0) norm_row(XROW(row0 - 1), gs, sh, lane, prev); else { for (int j = 0; j < 4; ++j) prev[j] = (f32x4){0.f, 0.f, 0.f, 0.f}; }
            norm_row(XROW(row0), gs, sh, lane, cur);
            for (int r = row0; r < row0 + 8; ++r) {
                if (r + 1 < seg1) norm_row(XROW(r + 1), gs, sh, lane, nxt); else { for (int j = 0; j < 4; ++j) nxt[j] = (f32x4){0.f, 0.f, 0.f, 0.f}; }
                store_row_bf16(H + (size_t)r * ldh, cur, lane);
                f32x4 hs[4];
#pragma unroll
                for (int j = 0; j < 4; ++j) hs[j] = (prev[j] + nxt[j]) * 0.5f;
                store_row_bf16(H + (size_t)r * ldh + 1024, hs, lane);
#pragma unroll
                for (int j = 0; j < 4; ++j) { prev[j] = cur[j]; cur[j] = nxt[j]; }
            }
        }
    }
#undef XROW
}

DI void phase_mod(const Args& a, float* lds, int tid) {
    float* sc = lds;
    float* red = lds + 1024 * 12;
    const float* c = a.in[1]; const float* cctx = a.in[3]; const float* ada_w = a.in[4]; const float* ada_b = a.in[5];
    float* mod = (float*)(a.ws + WS_MOD);
    for (int idx = tid; idx < 9 * 1024; idx += NTHREADS) { const int j = idx >> 10, k = idx & 1023; const float v = j < 8 ? c[j * 1024 + k] : cctx[k]; sc[k * 12 + j] = v * sigmoidf_(v); }
    __syncthreads();
    for (int unit = blockIdx.x; unit < 384; unit += gridDim.x) {
        const int l = unit / 96, n0 = (unit % 96) * 64, col = tid & 63, ks = tid >> 6;
        const float* w = ada_w + ((size_t)l * 1024 + ks * 128) * 6144 + n0 + col;
        float acc[9];
#pragma unroll
        for (int j = 0; j < 9; ++j) acc[j] = 0.f;
#pragma unroll 8
        for (int kk = 0; kk < 128; ++kk) {
            const float wv = w[(size_t)kk * 6144]; const float* s = sc + (ks * 128 + kk) * 12;
            const f32x4 s0 = *(const f32x4*)s, s1 = *(const f32x4*)(s + 4); const float s8 = s[8];
            acc[0] += s0.x * wv; acc[1] += s0.y * wv; acc[2] += s0.z * wv; acc[3] += s0.w * wv;
            acc[4] += s1.x * wv; acc[5] += s1.y * wv; acc[6] += s1.z * wv; acc[7] += s1.w * wv; acc[8] += s8 * wv;
        }
#pragma unroll
        for (int j = 0; j < 9; ++j) red[(ks * 9 + j) * 64 + col] = acc[j];
        __syncthreads();
        for (int idx = tid; idx < 576; idx += NTHREADS) {
            const int j = idx >> 6, cc = idx & 63; float s = ada_b[l * 6144 + n0 + cc];
#pragma unroll
            for (int k2 = 0; k2 < 8; ++k2) s += red[(k2 * 9 + j) * 64 + cc];
            mod[((size_t)(l * 9 + j)) * 6144 + n0 + cc] = s;
        }
        __syncthreads();
    }
}

DI void attn_unit(const bf16_t* QK, const bf16_t* VTL, const bf16_t* VTC, bf16_t* O, const float* tbl, int b, int hd, int r, int cq, int lane) {
    const int n = lane & 31, h = lane >> 5;
    const bool lat = r >= 0;
    const int qrow0 = lat ? b * 4096 + r * 64 : ML + b * 256 + cq * 64;
    const int pin = (n & 0x13) | ((n & 4) << 1) | ((n & 8) >> 1);
    bf16x8 bq[2][4];
#pragma unroll
    for (int qb = 0; qb < 2; ++qb)
#pragma unroll
        for (int s = 0; s < 4; ++s) bq[qb][s] = *(const bf16x8*)(QK + (size_t)(qrow0 + 32 * qb + n) * 2048 + hd * 64 + 32 * h + 8 * s);
    f32x16 o[2][2];
#pragma unroll
    for (int x = 0; x < 2; ++x)
#pragma unroll
        for (int y = 0; y < 2; ++y)
#pragma unroll
            for (int i = 0; i < 16; ++i) o[x][y][i] = 0.f;
    float mrun[2] = {-1e30f, -1e30f}, lrun[2] = {0.f, 0.f};
    const int r0 = lat ? min(max(r - 4, 0), 56) : 0;
    const int nblk = lat ? 24 : 8;
    const bf16_t* vtc = VTC + (size_t)((b * 16 + hd) * 64) * 256;
    const bf16_t* vtl = VTL + (size_t)((b * 16 + hd) * 64) * 4096;
    for (int blk = 0; blk < nblk; ++blk) {
        int krow0, ldv, kc0 = 0, ridx = 0; const bf16_t* vt;
        const bool lb_ = blk >= 8;
        if (!lb_) { krow0 = ML + b * 256 + blk * 32; vt = vtc + blk * 32; ldv = 256; }
        else { const int lb = blk - 8, kr = r0 + (lb >> 1); kc0 = (lb & 1) * 32; krow0 = b * 4096 + kr * 64 + kc0; vt = vtl + kr * 64 + kc0; ldv = 4096; ridx = kr - r + 7; }
        bf16x8 ka[4];
#pragma unroll
        for (int s = 0; s < 4; ++s) ka[s] = *(const bf16x8*)(QK + (size_t)(krow0 + pin) * 2048 + 1024 + hd * 64 + 32 * h + 8 * s);
        bf16x8 va[2][2];
#pragma unroll
        for (int db = 0; db < 2; ++db)
#pragma unroll
            for (int s2 = 0; s2 < 2; ++s2) va[db][s2] = *(const bf16x8*)(vt + (size_t)(32 * db + n) * ldv + 16 * s2 + 8 * h);
        f32x16 sa[2];
#pragma unroll
        for (int qb = 0; qb < 2; ++qb) {
#pragma unroll
            for (int i = 0; i < 16; ++i) sa[qb][i] = 0.f;
#pragma unroll
            for (int s = 0; s < 4; ++s) sa[qb] = MFMA32(ka[s], bq[qb][s], sa[qb]);
        }
        bf16x8 pb[2][2];
#pragma unroll
        for (int qb = 0; qb < 2; ++qb) {
            if (lb_) {
                const int qc = 32 * qb + n, cs = min(max(qc - 8, 0), 48);
                const float* bp = tbl + ridx * 128 + 48 + 15 + kc0 + 8 * h - qc;
                const int okb = kc0 + 8 * h - cs;
#pragma unroll
                for (int i = 0; i < 16; ++i) {
                    const int ko = (i & 7) + 16 * (i >> 3);
                    const bool ok = (unsigned)(okb + ko) < 16u;
                    const float bv = bp[ko];
                    sa[qb][i] = ok ? sa[qb][i] + bv : -1e30f;
                }
            }
            float bm = sa[qb][0];
#pragma unroll
            for (int i = 1; i < 16; ++i) bm = fmaxf(bm, sa[qb][i]);
            bm = fmaxf(bm, __shfl_xor(bm, 32));
            const float mnew = fmaxf(mrun[qb], bm);
            const float alpha = __expf(mrun[qb] - mnew);
            mrun[qb] = mnew;
            float ps = 0.f;
#pragma unroll
            for (int i = 0; i < 16; ++i) { const float p = __expf(sa[qb][i] - mnew); sa[qb][i] = p; ps += p; }
            lrun[qb] = lrun[qb] * alpha + ps;
#pragma unroll
            for (int db = 0; db < 2; ++db)
#pragma unroll
                for (int i = 0; i < 16; ++i) o[db][qb][i] *= alpha;
#pragma unroll
            for (int s2 = 0; s2 < 2; ++s2) {
                u32x4 w; w.x = cvtpk(sa[qb][8 * s2 + 0], sa[qb][8 * s2 + 1]); w.y = cvtpk(sa[qb][8 * s2 + 2], sa[qb][8 * s2 + 3]);
                w.z = cvtpk(sa[qb][8 * s2 + 4], sa[qb][8 * s2 + 5]); w.w = cvtpk(sa[qb][8 * s2 + 6], sa[qb][8 * s2 + 7]);
                pb[qb][s2] = __builtin_bit_cast(bf16x8, w);
            }
        }
#pragma unroll
        for (int db = 0; db < 2; ++db)
#pragma unroll
            for (int qb = 0; qb < 2; ++qb)
#pragma unroll
                for (int s2 = 0; s2 < 2; ++s2) o[db][qb] = MFMA32(va[db][s2], pb[qb][s2], o[db][qb]);
    }
#pragma unroll
    for (int qb = 0; qb < 2; ++qb) {
        const float lt = lrun[qb] + __shfl_xor(lrun[qb], 32);
        const float inv = 1.f / lt;
        bf16_t* op = O + (size_t)(qrow0 + 32 * qb + n) * 1024 + hd * 64;
#pragma unroll
        for (int db = 0; db < 2; ++db)
#pragma unroll
            for (int g = 0; g < 4; ++g) {
                u32x2 w; w.x = cvtpk(o[db][qb][4 * g] * inv, o[db][qb][4 * g + 1] * inv); w.y = cvtpk(o[db][qb][4 * g + 2] * inv, o[db][qb][4 * g + 3] * inv);
                *(u32x2*)(op + 32 * db + 8 * g + 4 * h) = w;
            }
    }
}

DI void gla_unit(const bf16_t* P, const float* LR, const float* wdec, const float* bdec, bf16_t* OUT  , unsigned char* lds, int unit, int tid) {
    const int lane = tid & 63, wid = __builtin_amdgcn_readfirstlane(tid >> 6);
    const int vs = unit & 3, dir = (unit >> 2) & 1, hd = (unit >> 3) & 3, b = unit >> 5;
    bf16_t* QE = (bf16_t*)lds;
    bf16_t* KE = QE + 64 * 136;
    bf16_t* ST = KE + 64 * 136;
    bf16_t* KDT = ST + 64 * 136;
    bf16_t* VT = KDT + 128 * 72;
    bf16_t* AM = VT + 64 * 72;
    float* Bc = (float*)(AM + 64 * 72);
    float* LRs = Bc + 64 * 128;
    float* GRP = LRs + 64 * 16;
    float* DEC = GRP + 4 * 128;
    const int dcol = tid & 127, lg = tid >> 7;
    float wd[16];
#pragma unroll
    for (int r = 0; r < 16; ++r) wd[r] = wdec[(dir * 16 + r) * 512 + hd * 128 + dcol];
    const float bd = bdec[dir * 512 + hd * 128 + dcol];
    const int col_q = hd * 128, col_k = 512 + hd * 128, col_v = 1024 + hd * 256 + vs * 64;
    f32x16 st;
#pragma unroll
    for (int i = 0; i < 16; ++i) st[i] = 0.f;
    const int svt = wid >> 2, sdt = wid & 3, rho = lane & 31, hh = lane >> 5;
    bf16_t* outp = OUT + (size_t)dir * MT * 1024;
    for (int side = 0; side < 2; ++side) {
        const int T = side == 0 ? 256 : 4096, base = side == 0 ? ML + b * 256 : b * 4096, nch = T / 64;
        for (int n = 0; n < nch; ++n) {
#define GROW(l) (base + (dir ? (T - 1 - (n * 64 + (l))) : (n * 64 + (l))))
            { const int idx = tid * 2, l = idx >> 4, r = idx & 15; const float* p = LR + (size_t)GROW(l) * 32 + dir * 16 + r; LRs[l * 16 + r] = p[0]; LRs[l * 16 + r + 1] = p[1]; }
            __syncthreads();
            { float run = 0.f;
              for (int li = 0; li < 16; ++li) { const int l = 16 * lg + li; float z = bd;
#pragma unroll
                  for (int r = 0; r < 16; ++r) z += LRs[l * 16 + r] * wd[r];
                  const float g = -softplusf_(-z) * (1.f / 16.f); run += g; Bc[l * 128 + dcol] = run; }
              GRP[lg * 128 + dcol] = run; }
            __syncthreads();
            { float off = 0.f, blast = 0.f;
#pragma unroll
              for (int g2 = 0; g2 < 4; ++g2) { const float t = GRP[g2 * 128 + dcol]; blast += t; if (g2 < lg) off += t; }
              if (lg == 0) DEC[dcol] = __expf(blast);
              for (int li = 0; li < 16; ++li) { const int l = 16 * lg + li; const float bv = Bc[l * 128 + dcol] + off; const size_t ro = (size_t)GROW(l) * 3072;
                  const float qv = bf2f(P[ro + col_q + dcol]), kv = bf2f(P[ro + col_k + dcol]);
                  QE[l * 136 + dcol] = f2bf(qv * __expf(bv)); KE[l * 136 + dcol] = f2bf(kv * __expf(-bv)); KDT[dcol * 72 + l] = f2bf(kv * __expf(blast - bv)); }
              { const int l = tid >> 3, v0 = (tid & 7) * 8; const bf16x8 vv = *(const bf16x8*)(P + (size_t)GROW(l) * 3072 + col_v + v0);
#pragma unroll
                for (int e = 0; e < 8; ++e) VT[(v0 + e) * 72 + l] = (bf16_t)vv[e]; }
#pragma unroll
              for (int i = 0; i < 16; ++i) ST[(32 * svt + crow(i, hh)) * 136 + 32 * sdt + rho] = f2bf(st[i]);
            }
            __syncthreads();
            if (wid < 4) { const int lt = wid >> 1, mt = wid & 1; f32x16 acc;
#pragma unroll
                for (int i = 0; i < 16; ++i) acc[i] = 0.f;
                mma_tile(acc, QE + 32 * lt * 136, 136, KE + 32 * mt * 136, 136, 8, lane);
#pragma unroll
                for (int i = 0; i < 16; ++i) { const int l = 32 * lt + crow(i, hh), m = 32 * mt + rho; AM[l * 72 + m] = f2bf(m <= l ? acc[i] : 0.f); } }
            __syncthreads();
            if (wid < 4) { const int lt = wid >> 1, vt2 = wid & 1; f32x16 acc;
#pragma unroll
                for (int i = 0; i < 16; ++i) acc[i] = 0.f;
                mma_tile(acc, AM + 32 * lt * 72, 72, VT + 32 * vt2 * 72, 72, 4, lane);
                mma_tile(acc, QE + 32 * lt * 136, 136, ST + 32 * vt2 * 136, 136, 8, lane);
#pragma unroll
                for (int i = 0; i < 16; ++i) { const int l = 32 * lt + crow(i, hh); outp[(size_t)GROW(l) * 1024 + hd * 256 + vs * 64 + 32 * vt2 + rho] = f2bf(acc[i]); } }
            { const float dc = DEC[32 * sdt + rho];
#pragma unroll
              for (int i = 0; i < 16; ++i) st[i] *= dc;
              mma_tile(st, VT + 32 * svt * 72, 72, KDT + 32 * sdt * 72, 72, 4, lane); }
            __syncthreads();
#undef GROW
        }
    }
}
DI void gla_finish(bf16_t* OF, const bf16_t* OB, const bf16_t* P, const float* ng, int Mrows, int gw, int ngw, int lane) {
    for (int row = gw; row < Mrows; row += ngw) {
        const int c0 = 16 * lane;
        const bf16x8 a0 = *(const bf16x8*)(OF + (size_t)row * 1024 + c0), a1 = *(const bf16x8*)(OF + (size_t)row * 1024 + c0 + 8);
        const bf16x8 b0 = *(const bf16x8*)(OB + (size_t)row * 1024 + c0), b1 = *(const bf16x8*)(OB + (size_t)row * 1024 + c0 + 8);
        const bf16x8 g0 = *(const bf16x8*)(P + (size_t)row * 3072 + 2048 + c0), g1 = *(const bf16x8*)(P + (size_t)row * 3072 + 2048 + c0 + 8);
        float o[16]; float ss = 0.f;
#pragma unroll
        for (int e = 0; e < 8; ++e) { o[e] = bf2f((bf16_t)a0[e]) + bf2f((bf16_t)b0[e]); o[8 + e] = bf2f((bf16_t)a1[e]) + bf2f((bf16_t)b1[e]); }
#pragma unroll
        for (int e = 0; e < 16; ++e) ss += o[e] * o[e];
        ss += __shfl_xor(ss, 1); ss += __shfl_xor(ss, 2); ss += __shfl_xor(ss, 4); ss += __shfl_xor(ss, 8);
        const float rinv = rsqrtf(ss * (1.f / 256.f) + 1e-6f);
        float y[16];
#pragma unroll
        for (int e = 0; e < 16; ++e) { const float gt = bf2f((bf16_t)(e < 8 ? g0[e] : g1[e - 8])); y[e] = o[e] * rinv * ng[(c0 + e) & 255] * (gt * sigmoidf_(gt)); }
        u32x4 w0, w1; w0.x = cvtpk(y[0], y[1]); w0.y = cvtpk(y[2], y[3]); w0.z = cvtpk(y[4], y[5]); w0.w = cvtpk(y[6], y[7]);
        w1.x = cvtpk(y[8], y[9]); w1.y = cvtpk(y[10], y[11]); w1.z = cvtpk(y[12], y[13]); w1.w = cvtpk(y[14], y[15]);
        *(u32x4*)(OF + (size_t)row * 1024 + c0) = w0; *(u32x4*)(OF + (size_t)row * 1024 + c0 + 8) = w1;
    }
}

typedef unsigned u32x2_t __attribute__((ext_vector_type(2)));
DI float red_rows(float x) {
    unsigned u = __float_as_uint(x);
    u32x2_t r = __builtin_amdgcn_permlane16_swap(u, u, false, false);
    const float y = __uint_as_float(r.x) + __uint_as_float(r.y);
    unsigned v = __float_as_uint(y);
    u32x2_t q = __builtin_amdgcn_permlane32_swap(v, v, false, false);
    return __uint_as_float(q.x) + __uint_as_float(q.y);
}
DI int rw_row(int q, int l, int dir, int b) {
    int T, base, n;
    if (q < 8) { T = 256; base = ML + b * 256; n = q; } else { T = 4096; base = b * 4096; n = q - 8; }
    const int t = n * 32 + l;
    return base + (dir ? T - 1 - t : t);
}
#define DPPB(n) " row_newbcast:" #n " row_mask:0xf bank_mask:0xf\n\t"
#define RW_UPD(n, sreg) "v_mul_f32_dpp " sreg ", %17, " sreg DPPB(n) "v_fmac_f32_dpp " sreg ", %18, %21" DPPB(n) "v_fmac_f32_dpp " sreg ", %19, %22" DPPB(n)
DI void rwkv_unit(const Args& a, const bf16_t* RKV, const bf16_t* TWAA, bf16_t* Y  , float* RK  , unsigned char* lds, int unit, int tid) {
    const int lane = tid & 63, wid = __builtin_amdgcn_readfirstlane(tid >> 6);
    const int dir = unit & 1, hd = (unit >> 1) & 15, b = unit >> 5;
    float* SA = (float*)lds;
    float* YC = SA + 6 * 4096;
    bf16_t* W2T = (bf16_t*)(YC + 4096);
    bf16_t* A2T = W2T + 64 * 72;
    constexpr int NCH = 136;
    {
        const float* w2 = a.in[23] + (size_t)dir * 64 * 1024; const float* a2 = a.in[26] + (size_t)dir * 64 * 1024;
        for (int e = 0; e < 8; ++e) { const int idx = tid + 512 * e, j = idx >> 6, c = idx & 63; W2T[c * 72 + j] = f2bf(w2[(size_t)j * 1024 + hd * 64 + c]); A2T[c * 72 + j] = f2bf(a2[(size_t)j * 1024 + hd * 64 + c]); }
    }
    __syncthreads();
    bf16_t* yout = Y + (size_t)dir * MT * 1024; float* rkout = RK + (size_t)dir * MT * 16;
    if (wid >= 4) {
        const int pw = wid - 4, rho = lane & 31, h = lane >> 5, ptid = tid - 256;
        float cw0[2], ca0[2], ckk[2], cka[2], crk[2];
#pragma unroll
        for (int ct = 0; ct < 2; ++ct) { const int c = hd * 64 + 32 * ct + rho; cw0[ct] = a.in[21][dir * 1024 + c]; ca0[ct] = a.in[24][dir * 1024 + c]; ckk[ct] = a.in[29][c]; cka[ct] = a.in[30][c]; crk[ct] = a.in[31][c]; }
        for (int p = 0; p <= NCH + 1; ++p) {
            if (p < NCH) {
                const int buf = p & 1;
                const int rowA = rw_row(p, 8 * pw + (rho & 7), dir, b);
                const bf16_t* ta = TWAA + (size_t)rowA * 256 + dir * 64 + 8 * h;
                f32x16 zw0, zw1, za0, za1;
#pragma unroll
                for (int i = 0; i < 16; ++i) { zw0[i] = 0.f; zw1[i] = 0.f; za0[i] = 0.f; za1[i] = 0.f; }
#pragma unroll
                for (int s = 0; s < 4; ++s) {
                    const bf16x8 atw = *(const bf16x8*)(ta + 16 * s), aaa = *(const bf16x8*)(ta + 128 + 16 * s);
                    const bf16x8 bw0 = *(const bf16x8*)(W2T + rho * 72 + 16 * s + 8 * h), bw1 = *(const bf16x8*)(W2T + (32 + rho) * 72 + 16 * s + 8 * h);
                    const bf16x8 ba0 = *(const bf16x8*)(A2T + rho * 72 + 16 * s + 8 * h), ba1 = *(const bf16x8*)(A2T + (32 + rho) * 72 + 16 * s + 8 * h);
                    zw0 = MFMA32(atw, bw0, zw0); zw1 = MFMA32(atw, bw1, zw1); za0 = MFMA32(aaa, ba0, za0); za1 = MFMA32(aaa, ba1, za1);
                }
#pragma unroll
                for (int i = 0; i < 4; ++i) {
                    const int tok = 8 * pw + i + 4 * h; const int row = rw_row(p, tok, dir, b);
                    const bf16_t* pr = RKV + (size_t)row * 3072 + hd * 64 + rho;
                    float rv[2], kv[2], vv[2], av[2], kkv[2], kd[2]; float ss = 0.f, rk = 0.f;
#pragma unroll
                    for (int ct = 0; ct < 2; ++ct) {
                        rv[ct] = bf2f(pr[32 * ct]); kv[ct] = bf2f(pr[1024 + 32 * ct]); vv[ct] = bf2f(pr[2048 + 32 * ct]);
                        const float zav = ct ? za1[i] : za0[i];
                        av[ct] = 1.f / (1.f + __expf(-(ca0[ct] + zav)));
                        kkv[ct] = kv[ct] * ckk[ct]; ss += kkv[ct] * kkv[ct];
                        kd[ct] = kv[ct] * (1.f + (av[ct] - 1.f) * cka[ct]); rk += rv[ct] * kd[ct] * crk[ct];
                    }
#pragma unroll
                    for (int o = 1; o < 32; o <<= 1) { ss += __shfl_xor(ss, o); rk += __shfl_xor(rk, o); }
                    const float kinv = rsqrtf(fmaxf(ss, 1e-24f));
                    if (rho == 0) rkout[(size_t)row * 16 + hd] = rk;
#pragma unroll
                    for (int ct = 0; ct < 2; ++ct) {
                        const float zwv = ct ? zw1[i] : zw0[i];
                        const float x = -(cw0[ct] + zwv);
                        const float sp = fmaxf(x, 0.f) + __logf(1.f + __expf(-fabsf(x)));
                        const float dec = __expf(-__expf(-sp - 0.5f));
                        const float kn = kkv[ct] * kinv;
                        float* o = SA + buf * 2048 + tok * 64 + 32 * ct + rho;
                        o[0 * 4096] = dec; o[1 * 4096] = kd[ct]; o[2 * 4096] = kn * av[ct]; o[3 * 4096] = -kn; o[4 * 4096] = rv[ct]; o[5 * 4096] = vv[ct];
                    }
                }
            }
            if (p >= 2) {
                const int tok = ptid >> 3, i0 = (ptid & 7) * 8; const int row = rw_row(p - 2, tok, dir, b);
                const float* y = YC + (p & 1) * 2048 + tok * 64 + i0;
                const f32x4 y0 = *(const f32x4*)y, y1 = *(const f32x4*)(y + 4);
                *(u32x4*)(yout + (size_t)row * 1024 + hd * 64 + i0) = pack8(y0, y1);
            }
            __syncthreads();
        }
    } else {
        __builtin_amdgcn_s_setprio(3);
        const int rl = lane & 15, cg = lane >> 4, myrow = 16 * wid + rl;
        float s0 = 0.f, s1 = 0.f, s2 = 0.f, s3 = 0.f, s4 = 0.f, s5 = 0.f, s6 = 0.f, s7 = 0.f, s8 = 0.f, s9 = 0.f, s10 = 0.f, s11 = 0.f, s12 = 0.f, s13 = 0.f, s14 = 0.f, s15 = 0.f;
        for (int p = 0; p <= NCH + 1; ++p) {
            if (p >= 1 && p <= NCH) {
                const int buf = (p - 1) & 1;
                const float* base = SA + buf * 2048;
                float* yc = YC + buf * 2048 + myrow;
                float w_c = base[lane], kd_c = base[4096 + lane], bb_c = base[2 * 4096 + lane], nk_c = base[3 * 4096 + lane], r_c = base[4 * 4096 + lane], v_c = base[5 * 4096 + myrow];
                for (int t = 0; t < 32; ++t) {
                    const int tn = (t + 1) & 31;
                    const float w_n = base[tn * 64 + lane], kd_n = base[4096 + tn * 64 + lane], bb_n = base[2 * 4096 + tn * 64 + lane], nk_n = base[3 * 4096 + tn * 64 + lane], r_n = base[4 * 4096 + tn * 64 + lane], v_n = base[5 * 4096 + tn * 64 + myrow];
                    float sap;
                    asm volatile("s_nop 1\n\t"
                        "v_mul_f32_dpp %0, %1, %2" DPPB(0) "v_fmac_f32_dpp %0, %1, %3" DPPB(1) "v_fmac_f32_dpp %0, %1, %4" DPPB(2) "v_fmac_f32_dpp %0, %1, %5" DPPB(3)
                        "v_fmac_f32_dpp %0, %1, %6" DPPB(4) "v_fmac_f32_dpp %0, %1, %7" DPPB(5) "v_fmac_f32_dpp %0, %1, %8" DPPB(6) "v_fmac_f32_dpp %0, %1, %9" DPPB(7)
                        "v_fmac_f32_dpp %0, %1, %10" DPPB(8) "v_fmac_f32_dpp %0, %1, %11" DPPB(9) "v_fmac_f32_dpp %0, %1, %12" DPPB(10) "v_fmac_f32_dpp %0, %1, %13" DPPB(11)
                        "v_fmac_f32_dpp %0, %1, %14" DPPB(12) "v_fmac_f32_dpp %0, %1, %15" DPPB(13) "v_fmac_f32_dpp %0, %1, %16" DPPB(14) "v_fmac_f32_dpp %0, %1, %17" DPPB(15)
                        "s_nop 1"
                        : "=&v"(sap)
                        : "v"(nk_c), "v"(s0), "v"(s1), "v"(s2), "v"(s3), "v"(s4), "v"(s5), "v"(s6), "v"(s7), "v"(s8), "v"(s9), "v"(s10), "v"(s11), "v"(s12), "v"(s13), "v"(s14), "v"(s15));
                    const float sa = red_rows(sap);
                    float yp;
                    asm volatile("s_nop 1\n\t"
                        RW_UPD(0, "%0") RW_UPD(1, "%1") RW_UPD(2, "%2") RW_UPD(3, "%3") RW_UPD(4, "%4") RW_UPD(5, "%5") RW_UPD(6, "%6") RW_UPD(7, "%7")
                        RW_UPD(8, "%8") RW_UPD(9, "%9") RW_UPD(10, "%10") RW_UPD(11, "%11") RW_UPD(12, "%12") RW_UPD(13, "%13") RW_UPD(14, "%14") RW_UPD(15, "%15")
                        "v_mul_f32_dpp %16, %20, %0" DPPB(0) "v_fmac_f32_dpp %16, %20, %1" DPPB(1) "v_fmac_f32_dpp %16, %20, %2" DPPB(2) "v_fmac_f32_dpp %16, %20, %3" DPPB(3)
                        "v_fmac_f32_dpp %16, %20, %4" DPPB(4) "v_fmac_f32_dpp %16, %20, %5" DPPB(5) "v_fmac_f32_dpp %16, %20, %6" DPPB(6) "v_fmac_f32_dpp %16, %20, %7" DPPB(7)
                        "v_fmac_f32_dpp %16, %20, %8" DPPB(8) "v_fmac_f32_dpp %16, %20, %9" DPPB(9) "v_fmac_f32_dpp %16, %20, %10" DPPB(10) "v_fmac_f32_dpp %16, %20, %11" DPPB(11)
                        "v_fmac_f32_dpp %16, %20, %12" DPPB(12) "v_fmac_f32_dpp %16, %20, %13" DPPB(13) "v_fmac_f32_dpp %16, %20, %14" DPPB(14) "v_fmac_f32_dpp %16, %20, %15" DPPB(15)
                        "s_nop 1"
                        : "+v"(s0), "+v"(s1), "+v"(s2), "+v"(s3), "+v"(s4), "+v"(s5), "+v"(s6), "+v"(s7), "+v"(s8), "+v"(s9), "+v"(s10), "+v"(s11), "+v"(s12), "+v"(s13), "+v"(s14), "+v"(s15), "=&v"(yp)
                        : "v"(w_c), "v"(bb_c), "v"(kd_c), "v"(r_c), "v"(sa), "v"(v_c));
                    const float y = red_rows(yp);
                    if (cg == 0) yc[t * 64] = y;
                    w_c = w_n; kd_c = kd_n; bb_c = bb_n; nk_c = nk_n; r_c = r_n; v_c = v_n;
                }
            }
            __syncthreads();
        }
        __builtin_amdgcn_s_setprio(0);
    }
    __syncthreads();
}
DI void rwkv_finish(bf16_t* YF, const bf16_t* YB, const bf16_t* RKV, const bf16_t* G, const float* RK, const float* lng, const float* lnb, int Mrows, int gw, int ngw, int lane) {
    for (int row = gw; row < Mrows; row += ngw) {
        const int c0 = 16 * lane, hd = lane >> 2;
        const bf16x8 a0 = *(const bf16x8*)(YF + (size_t)row * 1024 + c0), a1 = *(const bf16x8*)(YF + (size_t)row * 1024 + c0 + 8);
        const bf16x8 b0 = *(const bf16x8*)(YB + (size_t)row * 1024 + c0), b1 = *(const bf16x8*)(YB + (size_t)row * 1024 + c0 + 8);
        const bf16x8 v0 = *(const bf16x8*)(RKV + (size_t)row * 3072 + 2048 + c0), v1 = *(const bf16x8*)(RKV + (size_t)row * 3072 + 2048 + c0 + 8);
        const bf16x8 g0 = *(const bf16x8*)(G + (size_t)row * 1024 + c0), g1 = *(const bf16x8*)(G + (size_t)row * 1024 + c0 + 8);
        const float rk = RK[(size_t)row * 16 + hd] + RK[(size_t)MT * 16 + (size_t)row * 16 + hd];
        float y[16]; float sm = 0.f;
#pragma unroll
        for (int e = 0; e < 8; ++e) { y[e] = bf2f((bf16_t)a0[e]) + bf2f((bf16_t)b0[e]); y[8 + e] = bf2f((bf16_t)a1[e]) + bf2f((bf16_t)b1[e]); }
#pragma unroll
        for (int e = 0; e < 16; ++e) sm += y[e];
        sm += __shfl_xor(sm, 1); sm += __shfl_xor(sm, 2);
        const float mu = sm * (1.f / 64.f);
        float sv = 0.f;
#pragma unroll
        for (int e = 0; e < 16; ++e) { y[e] -= mu; sv += y[e] * y[e]; }
        sv += __shfl_xor(sv, 1); sv += __shfl_xor(sv, 2);
        const float rinv = rsqrtf(sv * (1.f / 64.f) + 64e-5f);
        float o[16];
#pragma unroll
        for (int e = 0; e < 16; ++e) { const float vv = bf2f((bf16_t)(e < 8 ? v0[e] : v1[e - 8])), gg = bf2f((bf16_t)(e < 8 ? g0[e] : g1[e - 8]));
            o[e] = (y[e] * rinv * lng[c0 + e] + lnb[c0 + e] + rk * vv) * gg; }
        u32x4 w0, w1; w0.x = cvtpk(o[0], o[1]); w0.y = cvtpk(o[2], o[3]); w0.z = cvtpk(o[4], o[5]); w0.w = cvtpk(o[6], o[7]);
        w1.x = cvtpk(o[8], o[9]); w1.y = cvtpk(o[10], o[11]); w1.z = cvtpk(o[12], o[13]); w1.w = cvtpk(o[14], o[15]);
        *(u32x4*)(YF + (size_t)row * 1024 + c0) = w0; *(u32x4*)(YF + (size_t)row * 1024 + c0 + 8) = w1;
    }
}

#define XB_TMO      128
#define XB_XCNT(j)  (256  + 64 * (j))
#define XB_XSUB(j)  (1280 + 64 * (j))
#define XB_XGEN(j)  (2304 + 64 * (j))
#define XB_TOP      3328
#define XB_TOPGEN   3392
#define XCD_BAR_WORDS 3456
#define XB_SPIN_CAP (1u << 18)

__device__ __forceinline__ unsigned xb_ld(unsigned* p)              { return __hip_atomic_load(p, __ATOMIC_RELAXED, __HIP_MEMORY_SCOPE_AGENT); }
__device__ __forceinline__ unsigned xb_add(unsigned* p, unsigned v) { return __hip_atomic_fetch_add(p, v, __ATOMIC_RELAXED, __HIP_MEMORY_SCOPE_AGENT); }
__device__ __forceinline__ unsigned xb_xcc_id() { return (unsigned)__builtin_amdgcn_s_getreg((3 << 11) | 20) & 0xFu; }
#define XB_SPIN(cond, bar) do { unsigned _sp = 0; while (cond) { __builtin_amdgcn_s_sleep(1); \
    if ((++_sp & 255u) == 0u) { if (xb_ld(&(bar)[XB_TMO])) break; if (_sp > XB_SPIN_CAP) { atomicAdd(&(bar)[XB_TMO], 1u); break; } } } } while (0)

struct XcdBarrier {
    unsigned* bar; unsigned x;
    volatile LAS unsigned* st;
};

__device__ __forceinline__ XcdBarrier xcd_barrier_post(unsigned* bar, volatile LAS unsigned* st) {
    XcdBarrier b; b.bar = bar; b.x = xb_xcc_id(); b.st = st;
    if (threadIdx.x == 0) (void)xb_add(&bar[XB_XCNT(b.x)], 1u);
    return b;
}
__device__ __forceinline__ void xcd_barrier_complete(unsigned* bar, unsigned x, unsigned& nloc, unsigned& nx) {
    const unsigned G = gridDim.x * gridDim.y * gridDim.z;
    unsigned sum, cnt, mine, sp = 0u;
    for (;;) {
        sum = 0u; cnt = 0u; mine = 0u;
#pragma unroll
        for (unsigned j = 0; j < 16; ++j) { const unsigned c = xb_ld(&bar[XB_XCNT(j)]); sum += c; cnt += (c > 0u) ? 1u : 0u; mine = (j == x) ? c : mine; }
        if (sum == G) break;
        __builtin_amdgcn_s_sleep(1);
        if ((++sp & 255u) == 0u) { if (xb_ld(&bar[XB_TMO])) break; if (sp > XB_SPIN_CAP) { atomicAdd(&bar[XB_TMO], 1u); break; } }
    }
    nloc = mine > 0u ? mine : 1u; nx = cnt > 0u ? cnt : 1u;
}

__device__ __forceinline__ void xcd_barrier(const XcdBarrier& b) {
    asm volatile("s_waitcnt vmcnt(0)" ::: "memory");
    __syncthreads();
    if (threadIdx.x == 0) {
        unsigned* bar = b.bar;
        __builtin_amdgcn_s_waitcnt(0);
        unsigned nloc = b.st[0], nx = b.st[1];
        if (nloc == 0u) { xcd_barrier_complete(bar, b.x, nloc, nx); b.st[0] = nloc; b.st[1] = nx; }
        const unsigned old = xb_add(&bar[XB_XSUB(b.x)], 1u);
        const unsigned gen = old / nloc;
        if (old + 1u == (gen + 1u) * nloc) {
            __builtin_amdgcn_fence(__ATOMIC_RELEASE, "agent");
            asm volatile("s_waitcnt vmcnt(0)" ::: "memory");
            const unsigned og = xb_add(&bar[XB_TOP], 1u);
            const unsigned tg = og / nx;
            if (og + 1u == (tg + 1u) * nx) xb_add(&bar[XB_TOPGEN], 1u);
            else XB_SPIN(xb_ld(&bar[XB_TOPGEN]) == tg, bar);
            __builtin_amdgcn_fence(__ATOMIC_ACQUIRE, "agent");
            xb_add(&bar[XB_XGEN(b.x)], 1u);
            asm volatile("s_waitcnt vmcnt(0)" ::: "memory");
        } else {
            XB_SPIN(xb_ld(&bar[XB_XGEN(b.x)]) == gen, bar);
            __builtin_amdgcn_fence(__ATOMIC_ACQUIRE, "agent");
            asm volatile("s_waitcnt vmcnt(0)" ::: "memory");
        }
    }
    __syncthreads();
}

#define WSP(T, off) ((T*)(a.ws + (off)))
#define PHASE(k) if (lo <= (k) && (k) < hi)
#define SEAM(k) do { if ((k) + 1 < hi) xcd_barrier(xbar); } while (0)
template <int L> DI void run_layer(const Args& a, unsigned char* lds, const XcdBarrier& xbar, int lo, int hi) {
    constexpr int kind = L % 3, jj = L / 3, P0 = 1 + 8 * L;
    constexpr bool need_ctx = L < 3;
    constexpr int Mact = need_ctx ? MT : ML;
    const int tid = threadIdx.x, lane = tid & 63, wid = __builtin_amdgcn_readfirstlane(tid >> 6);
    const int gw = blockIdx.x * 8 + wid, ngw = gridDim.x * 8;
    LAS unsigned char* ldsl = (LAS unsigned char*)lds;
    PHASE(P0 + 0) {
        float* scr = (float*)(lds + wid * 8704);
        for (int rep = 0; rep < ((DUP & 16) ? 2 : 1); ++rep) {
        const float* modl = WSP(float, WS_MOD) + (size_t)L * 9 * 6144;
        phase_prenorm(L == 0 ? a.in[0] : a.out, L == 0 ? a.in[2] : WSP(float, WS_ZF), a.in[6] + L * 1024, modl, 0, WSP(bf16_t, WS_H2), kind == 2 ? 2048 : 1024, kind == 2, MT, gw, ngw, lane);
        bf16_t* Wmix = WSP(bf16_t, W_MIX); bf16_t* Wo = WSP(bf16_t, W_O);
        conv_job(a.in[8] + (size_t)L * 1024 * 4096, 4096, 1024, 4096, 1024, 4096, nullptr, 0, WSP(bf16_t, W_1), 1024, 0, 0, scr, gw, ngw, lane);
        conv_job(a.in[9] + (size_t)L * 4096 * 1024, 1024, 4096, 1024, 4096, 1024, nullptr, 0, WSP(bf16_t, W_2), 4096, 0, 0, scr, gw, ngw, lane);
        if (kind == 0) {
            conv_job(a.in[11] + (size_t)jj * 1024 * 3072, 3072, 1024, 3072, 1024, 3072, nullptr, 0, Wmix, 1024, 0, 0, scr, gw, ngw, lane);
            conv_job(a.in[12] + (size_t)jj * 1024 * 1024, 1024, 1024, 1024, 1024, 1024, nullptr, 0, Wo, 1024, 0, 0, scr, gw, ngw, lane);
        } else if (kind == 1) {
            conv_job(a.in[14], 3104, 1024, 3104, 1024, 3328, nullptr, 0, Wmix, 1024, 0, 0, scr, gw, ngw, lane);
            conv_job(a.in[18], 1024, 1024, 1024, 1024, 1024, nullptr, 0, Wo, 1024, 0, 0, scr, gw, ngw, lane);
        } else {
            const float* mix = a.in[19];
            for (int md = 1; md <= 2; ++md) {
                const int co = (md - 1) * 1024;
                for (int q = 0; q < 3; ++q) conv_job(a.in[20] + (size_t)q * 1024 * 1024, 1024, 1024, 1024, 1024, 1024, mix + (q == 0 ? 0 : q + 1) * 1024, md, Wmix, 2048, q * 1024, co, scr, gw, ngw, lane);
                conv_job(a.in[27], 160, 1024, 160, 1024, 256, mix + 5 * 1024, md, Wmix, 2048, 3072, co, scr, gw, ngw, lane);
                for (int q = 0; q < 2; ++q) conv_job(a.in[22] + (size_t)q * 1024 * 64, 64, 1024, 64, 1024, 64, mix + 1 * 1024, md, Wmix, 2048, 3328 + 64 * q, co, scr, gw, ngw, lane);
                for (int q = 0; q < 2; ++q) conv_job(a.in[25] + (size_t)q * 1024 * 64, 64, 1024, 64, 1024, 64, mix + 4 * 1024, md, Wmix, 2048, 3456 + 64 * q, co, scr, gw, ngw, lane);
            }
            conv_job(a.in[28], 1024, 160, 1024, 256, 1024, nullptr, 0, WSP(bf16_t, W_G2), 256, 0, 0, scr, gw, ngw, lane);
            conv_job(a.in[34], 1024, 1024, 1024, 1024, 1024, nullptr, 0, Wo, 1024, 0, 0, scr, gw, ngw, lane);
        }
        }
        SEAM(P0 + 0);
    }
    PHASE(P0 + 1) {
        bf16_t* BIG = WSP(bf16_t, WS_BIG);
        for (int rep = 0; rep < ((DUP & 8) ? 2 : 1); ++rep) {
        if (kind == 0) run_gemm(ldsl, WSP(bf16_t, WS_H2), WSP(bf16_t, W_MIX), MT, 3072, 1024, InNaQkv{BIG, BIG + (size_t)MT * 2048, BIG + (size_t)MT * 2048 + (size_t)ML * 1024});
        else if (kind == 1) run_gemm(ldsl, WSP(bf16_t, WS_H2), WSP(bf16_t, W_MIX), MT, 3328, 1024, InGlaIn{BIG, WSP(float, WS_LR)});
        else run_gemm(ldsl, WSP(bf16_t, WS_H2), WSP(bf16_t, W_MIX), MT, 3584, 2048, InRwL1{BIG, BIG + (size_t)MT * 3072, BIG + (size_t)MT * 3328});
        }
        SEAM(P0 + 1);
    }
    PHASE(P0 + 2) {
        bf16_t* BIG = WSP(bf16_t, WS_BIG); bf16_t* H2 = WSP(bf16_t, WS_H2);
        if (kind == 0) {
            const bf16_t* VTL = BIG + (size_t)MT * 2048; const bf16_t* VTC = VTL + (size_t)ML * 1024;
            const float* rpb = a.in[13] + (size_t)jj * 16 * 15 * 31;
            const int nu = 8192 + (need_ctx ? 512 : 0);
#ifndef NO_ATTN
            float* tbl = (float*)(lds + wid * 7680);
            int tbl_hd = -1;
            for (int rep = 0; rep < ((DUP & 1) ? 2 : 1); ++rep)
            for (int u = gw; u < nu; u += ngw) {
                if (u < 8192) {
                    const int hd_ = (u >> 6) & 15;
                    if (hd_ != tbl_hd) {
                        for (int e = lane; e < 465; e += 64) { const int rr = e / 31, cc = e - rr * 31; tbl[rr * 128 + 48 + cc] = rpb[hd_ * 465 + e]; }
                        tbl_hd = hd_;
                    }
                    attn_unit(BIG, VTL, VTC, H2, tbl, u >> 10, hd_, u & 63, 0, lane);
                }
                else { const int v = u - 8192; attn_unit(BIG, VTL, VTC, H2, tbl, v >> 6, (v >> 2) & 15, -1, v & 3, lane); }
            }
#endif
        } else if (kind == 1) {
#ifndef NO_GLA
            for (int rep = 0; rep < ((DUP & 2) ? 2 : 1); ++rep)
            for (int u = blockIdx.x; u < 256; u += gridDim.x) gla_unit(BIG, WSP(float, WS_LR), a.in[15], a.in[16], H2, lds, u, tid);
#endif
        } else {
#ifndef NO_RWKV
            for (int rep = 0; rep < ((DUP & 4) ? 2 : 1); ++rep)
            for (int u = blockIdx.x; u < 256; u += gridDim.x) rwkv_unit(a, BIG, BIG + (size_t)MT * 3328, H2, WSP(float, WS_RK), lds, u, tid);
#endif
            run_gemm(ldsl, BIG + (size_t)MT * 3072, WSP(bf16_t, W_G2), MT, 1024, 256, InStore<0>{WSP(bf16_t, WS_G), 1024});
        }
        SEAM(P0 + 2);
    }
    if (kind != 0) {
        PHASE(P0 + 3) {
            bf16_t* H2 = WSP(bf16_t, WS_H2);
            if (kind == 1) gla_finish(H2, H2 + (size_t)MT * 1024, WSP(bf16_t, WS_BIG), a.in[17], Mact, gw, ngw, lane);
            else rwkv_finish(H2, H2 + (size_t)MT * 1024, WSP(bf16_t, WS_BIG), WSP(bf16_t, WS_G), WSP(float, WS_RK), a.in[32], a.in[33], Mact, gw, ngw, lane);
            SEAM(P0 + 3);
        }
    }
    PHASE(P0 + 4) {
        if (DUP & 32) run_gemm(ldsl, WSP(bf16_t, WS_H2), WSP(bf16_t, W_O), Mact, 1024, 1024, InResid{L == 0 ? a.in[0] : a.out, L == 0 ? a.in[2] : WSP(float, WS_ZF), WSP(float, WS_BIG), WSP(float, WS_BIG) + (size_t)ML * 1024, WSP(float, WS_MOD) + (size_t)L * 9 * 6144 + 2 * 1024});
        run_gemm(ldsl, WSP(bf16_t, WS_H2), WSP(bf16_t, W_O), Mact, 1024, 1024, InResid{L == 0 ? a.in[0] : a.out, L == 0 ? a.in[2] : WSP(float, WS_ZF), a.out, WSP(float, WS_ZF), WSP(float, WS_MOD) + (size_t)L * 9 * 6144 + 2 * 1024});
        SEAM(P0 + 4);
    }
    PHASE(P0 + 5) {
        for (int rep = 0; rep < ((DUP & 16) ? 2 : 1); ++rep)
        phase_prenorm(a.out, WSP(float, WS_ZF), a.in[7] + L * 1024, WSP(float, WS_MOD) + (size_t)L * 9 * 6144, 3, WSP(bf16_t, WS_H2), 1024, false, Mact, gw, ngw, lane);
        SEAM(P0 + 5);
    }
    PHASE(P0 + 6) {
        for (int rep = 0; rep < ((DUP & 8) ? 2 : 1); ++rep)
        run_gemm(ldsl, WSP(bf16_t, WS_H2), WSP(bf16_t, W_1), Mact, 4096, 1024, InStore<1>{WSP(bf16_t, WS_BIG), 4096});
        SEAM(P0 + 6);
    }
    PHASE(P0 + 7) {
        if (DUP & 32) run_gemm(ldsl, WSP(bf16_t, WS_BIG), WSP(bf16_t, W_2), Mact, 1024, 4096, InResid{a.out, WSP(float, WS_ZF), WSP(float, WS_H2), WSP(float, WS_H2) + (size_t)ML * 1024, WSP(float, WS_MOD) + (size_t)L * 9 * 6144 + 5 * 1024});
        run_gemm(ldsl, WSP(bf16_t, WS_BIG), WSP(bf16_t, W_2), Mact, 1024, 4096, InResid{a.out, WSP(float, WS_ZF), a.out, WSP(float, WS_ZF), WSP(float, WS_MOD) + (size_t)L * 9 * 6144 + 5 * 1024});
        SEAM(P0 + 7);
    }
}
__global__ void __launch_bounds__(NTHREADS, 2) mega(Args a) {
    extern __shared__ __attribute__((aligned(16))) unsigned char lds[];
    cg::grid_group grid = cg::this_grid();
    const int lo = a.lo, hi = a.hi;
    volatile LAS unsigned* xst = (volatile LAS unsigned*)((LAS unsigned char*)lds + (LDS_BYTES - 64));
    if (threadIdx.x < 2) xst[threadIdx.x] = 0u;
    __syncthreads();
    const XcdBarrier xbar = xcd_barrier_post((unsigned*)(a.ws + WS_BAR), xst);
    PHASE(0) { phase_mod(a, (float*)lds, threadIdx.x); if (1 < hi) grid.sync(); }
    run_layer<0>(a, lds, xbar, lo, hi);
    run_layer<1>(a, lds, xbar, lo, hi);
    run_layer<2>(a, lds, xbar, lo, hi);
    run_layer<3>(a, lds, xbar, lo, hi);
    PHASE(33) {
        const int tid = threadIdx.x, lane = tid & 63, wid = tid >> 6;
        const int gw = blockIdx.x * 8 + wid, ngw = gridDim.x * 8;
        const float* fg = a.in[10];
        for (int row = gw; row < ML; row += ngw) {
            float* xr = a.out + (size_t)row * 1024; f32x4 v[4]; float s = 0.f;
#pragma unroll
            for (int j = 0; j < 4; ++j) { v[j] = *(const f32x4*)(xr + 4 * lane + 256 * j); s += (v[j].x * v[j].x + v[j].y * v[j].y) + (v[j].z * v[j].z + v[j].w * v[j].w); }
            s = wave_sum(s); const float rinv = rsqrtf(s * (1.f / 1024.f) + 1e-6f);
#pragma unroll
            for (int j = 0; j < 4; ++j) *(f32x4*)(xr + 4 * lane + 256 * j) = v[j] * rinv * *(const f32x4*)(fg + 4 * lane + 256 * j);
        }
    }
}

#ifndef GM
#define GM 0xffff
#endif
#ifndef MULTI_LAUNCH
#define MULTI_LAUNCH 0
#endif
extern "C" void kernel_launch(void* const* d_in, const int* in_sizes, int n_in, void* d_out, int out_size, void* d_ws, size_t ws_size, hipStream_t stream) {
    static int grid_blocks = 0;
    if (!grid_blocks) {
        int dev = 0, cus = 0, per_cu = 0;
        hipGetDevice(&dev);
        hipDeviceGetAttribute(&cus, hipDeviceAttributeMultiprocessorCount, dev);
        hipFuncSetAttribute((const void*)mega, hipFuncAttributeMaxDynamicSharedMemorySize, LDS_BYTES);
        hipOccupancyMaxActiveBlocksPerMultiprocessor(&per_cu, (const void*)mega, NTHREADS, LDS_BYTES);
        if (per_cu < 1) per_cu = 1;
        grid_blocks = cus * per_cu;
    }
    (void)hipMemsetAsync((char*)d_ws + WS_BAR, 0, XCD_BAR_WORDS * 4, stream);
    Args a{};
    for (int i = 0; i < 35; ++i) a.in[i] = (const float*)d_in[i];
    a.out = (float*)d_out; a.ws = (unsigned char*)d_ws;
#if MULTI_LAUNCH
    for (int p = 0; p < 34; ++p) { a.lo = p; a.hi = p + 1; hipLaunchKernelGGL(mega, dim3(grid_blocks), dim3(NTHREADS), LDS_BYTES, stream, a); }
#else
    a.lo = 0; a.hi = 34;
    void* args[] = {&a};
    hipError_t e = hipLaunchCooperativeKernel((const void*)mega, dim3(grid_blocks), dim3(NTHREADS), args, LDS_BYTES, stream);
    if (e != hipSuccess) fprintf(stderr, "cooperative launch failed: %s (grid %d)\n", hipGetErrorString(e), grid_blocks);
#endif
}
```

```cpp
#include <hip/hip_runtime.h>
#include <hip/hip_cooperative_groups.h>
#include <cstdio>
#include <cstdint>
namespace cg = cooperative_groups;

namespace pg8 {
#define PG8_LAS __attribute__((address_space(3)))
typedef unsigned short bf16_t;
typedef short bf16x8 __attribute__((ext_vector_type(8)));
typedef float f32x4 __attribute__((ext_vector_type(4)));
typedef unsigned u32x4 __attribute__((ext_vector_type(4)));
constexpr int BM = 256, BK = 64, HALF = 128, HTB = HALF * BK * 2  , STAGE_BYTES = 8 * HTB, NXCD = 8, WGM = 8;

__host__ __device__ __forceinline__ int lds_byte(int r, int c) { const int st = (r >> 4) * 2 + (c >> 5), rr = r & 15, cc = c & 31, ob = rr * 64 + cc * 2; return st * 1024 + (ob ^ (((ob >> 9) & 1) << 5)); }
__host__ __device__ __forceinline__ void stage_rc(int b, int& R, int& C) { const int st = b / 1024, sb = b % 1024, swz = sb ^ (((sb >> 9) & 1) << 5); R = (st >> 1) * 16 + swz / 64; C = (st & 1) * 32 + (swz % 64) / 2; }
__host__ __device__ __forceinline__ int perm32(int rho) { const int n = rho >> 4, i = rho & 15; return 8 * (i >> 2) + 4 * n + (i & 3); }

struct Unit { int pm, pn; };
struct Gemm { const bf16_t* A; const bf16_t* Bt; int M, N, K; };

struct StaticOrder {
    int nM, nN, nwg, G, c;
    __host__ __device__ void init(int M, int N, int G_, int c_) { nM = M / BM; nN = N / BM; nwg = nM * nN; G = G_; c = c_; }
    __host__ __device__ bool next(int i, Unit& u) const {
        const long L = (long)i * G + c; if (L >= nwg) return false;
        int wgid = (int)L; { const int q = nwg / NXCD, r = nwg % NXCD, xcd = wgid % NXCD, off = wgid / NXCD; wgid = (xcd < r ? xcd * (q + 1) : r * (q + 1) + (xcd - r) * q) + off; }
        const int nig = WGM * nN, gid = wgid / nig, fm = gid * WGM, gsz = (nM - fm) < WGM ? (nM - fm) : WGM;
        u.pm = fm + ((wgid % nig) % gsz); u.pn = (wgid % nig) / gsz; return true;
    }
    __device__ __forceinline__ void a_ready(const Unit&) const {}
    __device__ __forceinline__ void done(const Unit&) const {}
};

__device__ __forceinline__ unsigned cvt_pk_bf16(float lo, float hi) { unsigned r; asm volatile("v_cvt_pk_bf16_f32 %0, %1, %2" : "=v"(r) : "v"(lo), "v"(hi)); return r; }
template <class Epi, class Sched, bool ALIGN_EPI = false, bool SP2 = false>
__device__ __forceinline__ void gemm_phase(PG8_LAS unsigned char* lds, const Gemm g, const Sched& S, const Epi& E) {
    const int tid = threadIdx.x, wid = __builtin_amdgcn_readfirstlane(tid >> 6), lane = tid & 63, wr = wid >> 2, wc = wid & 3, fr = lane & 15, fq = lane >> 4;
    const int K = g.K, nt = K / BK;
    unsigned voffA[2], voffB[2];
#pragma unroll
    for (int i = 0; i < 2; ++i) { int R, C; stage_rc(tid * 16 + i * 8192, R, C); const int Rb = Epi::PERM ? ((R & ~31) + perm32(R & 31)) : R;
        voffA[i] = (unsigned)(R * K + C) * 2u; voffB[i] = (unsigned)(Rb * K + C) * 2u; }
    const size_t kstep = (size_t)(BK * 2);
    const size_t hstep = (size_t)HALF * K * 2;
    const size_t tstep = 2 * hstep;
    const unsigned ldsw = (unsigned)wid * 1024u;
    const int aoff = lds_byte(wr * 64 + fr, fq * 8), boff = lds_byte(wc * 32 + fr, fq * 8);
#define PG8_SA(b, h) (((b) * 2 + (h)) * HTB)
#define PG8_SB(b, h) ((4 + (b) * 2 + (h)) * HTB)
#define PG8_STAGE(bufoff, gbase, voff) do { _Pragma("unroll") for (int _i = 0; _i < 2; ++_i) \
        __builtin_amdgcn_global_load_lds((const unsigned*)((const char*)(gbase) + (voff)[_i]), (PG8_LAS unsigned*)(lds + (bufoff) + ldsw + _i * 8192), 16, 0, 0); } while (0)
#define PG8_LDA(dst, b, h) do { _Pragma("unroll") for (int m = 0; m < 4; ++m) _Pragma("unroll") for (int k = 0; k < 2; ++k) dst[m][k] = *(const PG8_LAS bf16x8*)(lds + PG8_SA(b, h) + aoff + m * 2048 + k * 1024); } while (0)
#define PG8_LDB(dst, b, h) do { _Pragma("unroll") for (int n = 0; n < 2; ++n) _Pragma("unroll") for (int k = 0; k < 2; ++k) dst[n][k] = *(const PG8_LAS bf16x8*)(lds + PG8_SB(b, h) + boff + n * 2048 + k * 1024); } while (0)
#define PG8_MMA(ai, bj, At, Bt) do { __builtin_amdgcn_s_setprio(1); _Pragma("unroll") for (int m = 0; m < 4; ++m) _Pragma("unroll") for (int n = 0; n < 2; ++n) _Pragma("unroll") for (int k = 0; k < 2; ++k) \
        acc[ai][bj][m][n] = __builtin_amdgcn_mfma_f32_16x16x32_bf16(Bt[n][k], At[m][k], acc[ai][bj][m][n], 0, 0, 0); __builtin_amdgcn_s_setprio(0); } while (0)
#define PG8_WAIT_V(n) asm volatile("s_waitcnt vmcnt(" #n ")" ::: "memory")
#define PG8_WAIT_L(n) asm volatile("s_waitcnt lgkmcnt(" #n ")" ::: "memory")
#define PG8_BAR __builtin_amdgcn_s_barrier()
#define PG8_SCHED __builtin_amdgcn_sched_barrier(0)
    Unit cur, nxt; int ui = 0;
    if (!S.next(0, cur)) return;
    f32x4 acc[2][2][4][2];
#pragma unroll
    for (int a = 0; a < 2; ++a)
#pragma unroll
        for (int b = 0; b < 2; ++b)
#pragma unroll
            for (int m = 0; m < 4; ++m)
#pragma unroll
                for (int n = 0; n < 2; ++n) acc[a][b][m][n] = (f32x4){0.f, 0.f, 0.f, 0.f};
    bf16x8 At[4][2], B0[2][2], B1[2][2];
    const char* cA = (const char*)g.A + (size_t)cur.pm * tstep; const char* cB = (const char*)g.Bt + (size_t)cur.pn * tstep;
    S.a_ready(cur);
    if constexpr (SP2) {
        PG8_STAGE(PG8_SB(0, 0), cB, voffB); PG8_STAGE(PG8_SB(0, 1), cB + hstep, voffB); PG8_STAGE(PG8_SA(0, 0), cA, voffA); PG8_STAGE(PG8_SA(0, 1), cA + hstep, voffA);
        if (wr == 1) PG8_BAR;
        PG8_WAIT_V(2); PG8_BAR;
        PG8_STAGE(PG8_SB(1, 0), cB + kstep, voffB); PG8_STAGE(PG8_SA(1, 0), cA + kstep, voffA); PG8_STAGE(PG8_SB(1, 1), cB + hstep + kstep, voffB);
        PG8_WAIT_V(6); PG8_BAR;
    } else {
        PG8_STAGE(PG8_SB(0, 0), cB, voffB); PG8_STAGE(PG8_SA(0, 0), cA, voffA); PG8_STAGE(PG8_SB(0, 1), cB + hstep, voffB); PG8_STAGE(PG8_SA(0, 1), cA + hstep, voffA);
        if (wr == 1) PG8_BAR;
        PG8_WAIT_V(4); PG8_BAR;
        PG8_STAGE(PG8_SB(1, 0), cB + kstep, voffB); PG8_STAGE(PG8_SA(1, 0), cA + kstep, voffA); PG8_STAGE(PG8_SB(1, 1), cB + hstep + kstep, voffB);
        PG8_WAIT_V(6); PG8_BAR;
    }
    for (;;) {
        const bool has_next = S.next(ui + 1, nxt);
        const char* nA = has_next ? (const char*)g.A + (size_t)nxt.pm * tstep : cA; const char* nB = has_next ? (const char*)g.Bt + (size_t)nxt.pn * tstep : cB;
        for (int t = 0; t < nt; t += 2) {
            const bool last = (t == nt - 2);
            const char* a1 = cA + (size_t)(t + 1) * kstep;
            const char* a2 = last ? nA : cA + (size_t)(t + 2) * kstep; const char* b2 = last ? nB : cB + (size_t)(t + 2) * kstep;
            const char* a3 = a2 + kstep; const char* b3 = b2 + kstep;
            if (last && has_next) S.a_ready(nxt);
            if constexpr (SP2) {
            PG8_LDB(B0, 0, 0); PG8_LDB(B1, 0, 1); PG8_SCHED; PG8_LDA(At, 0, 0); PG8_STAGE(PG8_SA(1, 1), a1 + hstep, voffA);
            PG8_WAIT_V(8); PG8_WAIT_L(0); PG8_BAR; PG8_MMA(0, 0, At, B0); PG8_MMA(0, 1, At, B1); PG8_BAR; PG8_SCHED;
            PG8_LDA(At, 0, 1); PG8_STAGE(PG8_SB(0, 0), b2, voffB); PG8_STAGE(PG8_SB(0, 1), b2 + hstep, voffB); PG8_STAGE(PG8_SA(0, 0), a2, voffA);
            PG8_WAIT_V(8); PG8_WAIT_L(0); PG8_BAR; PG8_MMA(1, 0, At, B0); PG8_MMA(1, 1, At, B1); PG8_BAR; PG8_SCHED;
            PG8_LDB(B0, 1, 0); PG8_LDB(B1, 1, 1); PG8_SCHED; PG8_LDA(At, 1, 0); PG8_STAGE(PG8_SA(0, 1), a2 + hstep, voffA);
            PG8_WAIT_V(8); PG8_WAIT_L(0); PG8_BAR; PG8_MMA(0, 0, At, B0); PG8_MMA(0, 1, At, B1); PG8_BAR; PG8_SCHED;
            PG8_LDA(At, 1, 1); PG8_STAGE(PG8_SB(1, 0), b3, voffB); PG8_STAGE(PG8_SB(1, 1), b3 + hstep, voffB); PG8_STAGE(PG8_SA(1, 0), a3, voffA);
            PG8_WAIT_V(8); PG8_WAIT_L(0); PG8_BAR; PG8_MMA(1, 0, At, B0); PG8_MMA(1, 1, At, B1); PG8_BAR; PG8_SCHED;
            } else {
            PG8_LDB(B0, 0, 0); PG8_SCHED; PG8_LDA(At, 0, 0); PG8_STAGE(PG8_SA(1, 1), a1 + hstep, voffA);
            PG8_WAIT_L(8); PG8_BAR; PG8_WAIT_L(0); PG8_MMA(0, 0, At, B0); PG8_BAR; PG8_SCHED;
            PG8_LDB(B1, 0, 1); PG8_STAGE(PG8_SB(0, 0), b2, voffB);
            PG8_BAR; PG8_WAIT_L(0); PG8_MMA(0, 1, At, B1); PG8_BAR;
            PG8_LDA(At, 0, 1); PG8_STAGE(PG8_SA(0, 0), a2, voffA);
            PG8_BAR; PG8_WAIT_L(0); PG8_MMA(1, 0, At, B0); PG8_BAR; PG8_SCHED;
            PG8_STAGE(PG8_SB(0, 1), b2 + hstep, voffB);
            PG8_WAIT_V(6); PG8_BAR; PG8_MMA(1, 1, At, B1); PG8_BAR;
            PG8_LDB(B0, 1, 0); PG8_SCHED; PG8_LDA(At, 1, 0); PG8_STAGE(PG8_SA(0, 1), a2 + hstep, voffA);
            PG8_WAIT_L(8); PG8_BAR; PG8_WAIT_L(0); PG8_MMA(0, 0, At, B0); PG8_BAR; PG8_SCHED;
            PG8_LDB(B1, 1, 1); PG8_STAGE(PG8_SB(1, 0), b3, voffB);
            PG8_BAR; PG8_WAIT_L(0); PG8_MMA(0, 1, At, B1); PG8_BAR;
            PG8_LDA(At, 1, 1); PG8_STAGE(PG8_SA(1, 0), a3, voffA);
            PG8_BAR; PG8_WAIT_L(0); PG8_MMA(1, 0, At, B0); PG8_BAR; PG8_SCHED;
            PG8_STAGE(PG8_SB(1, 1), b3 + hstep, voffB);
            PG8_WAIT_V(6); PG8_BAR; PG8_MMA(1, 1, At, B1); PG8_BAR;
            }
        }
        if constexpr (ALIGN_EPI) { if (wr == 0) PG8_BAR; }
        if constexpr (!Epi::AFTER_DRAIN) { E(acc, cur, wr, wc, fr, fq); S.done(cur); }
        if (!has_next) break;
#pragma unroll
        for (int a = 0; a < 2; ++a)
#pragma unroll
            for (int b = 0; b < 2; ++b)
#pragma unroll
                for (int m = 0; m < 4; ++m)
#pragma unroll
                    for (int n = 0; n < 2; ++n) acc[a][b][m][n] = (f32x4){0.f, 0.f, 0.f, 0.f};
        cur = nxt; cA = nA; cB = nB; ++ui;
        if constexpr (ALIGN_EPI) { if (wr == 1) PG8_BAR; }
    }
    PG8_WAIT_V(0);
    if constexpr (!ALIGN_EPI) { if (wr == 0) PG8_BAR; }
    PG8_BAR;
    if constexpr (Epi::AFTER_DRAIN) { E.fused(acc, cur, wr, wc, fr, fq, lds, wid, lane); S.done(cur); }
#undef PG8_SA
#undef PG8_SB
#undef PG8_STAGE
#undef PG8_LDA
#undef PG8_LDB
#undef PG8_MMA
#undef PG8_WAIT_V
#undef PG8_WAIT_L
#undef PG8_BAR
#undef PG8_SCHED
}
}

#ifndef DUP
#define DUP 0
#endif
#define DI __device__ __forceinline__
#define LAS __attribute__((address_space(3)))
typedef unsigned short bf16_t;
typedef short bf16x8 __attribute__((ext_vector_type(8)));
typedef float f32x4 __attribute__((ext_vector_type(4)));
typedef float f32x16 __attribute__((ext_vector_type(16)));
typedef unsigned u32x4 __attribute__((ext_vector_type(4)));
typedef unsigned u32x2 __attribute__((ext_vector_type(2)));
typedef float f32x2_t __attribute__((ext_vector_type(2)));
typedef __bf16 bf16x2_t __attribute__((ext_vector_type(2)));

constexpr int D = 1024, NB = 8, SEQ = 4096, CTX = 256, FF = 4096;
constexpr int ML = NB * SEQ, MC = NB * CTX, MT = ML + MC;
constexpr size_t MiB = 1u << 20;
constexpr size_t WS_MOD = 0, WS_ZF = 1 * MiB, WS_RK = 9 * MiB, WS_LR = 14 * MiB, WS_W = 20 * MiB, WS_H2 = 56 * MiB, WS_BIG = 192 * MiB, WS_G = 430 * MiB;
constexpr size_t W_MIX = WS_W, W_O = WS_W + 14 * MiB, W_G2 = WS_W + 16 * MiB, W_1 = WS_W + 17 * MiB, W_2 = WS_W + 25 * MiB;
constexpr int LDS_BYTES = 147456;
constexpr size_t WS_BAR = 983040;
constexpr int NTHREADS = 512;

struct Args { const float* in[35]; float* out; unsigned char* ws; int lo, hi; };

DI float bf2f(bf16_t v) { return __uint_as_float(((unsigned)v) << 16); }
DI unsigned cvtpk(float lo, float hi) { f32x2_t v = {lo, hi}; bf16x2_t b = __builtin_convertvector(v, bf16x2_t); return __builtin_bit_cast(unsigned, b); }
DI bf16_t f2bf(float x) { return (bf16_t)(cvtpk(x, 0.f) & 0xffffu); }
DI float wave_sum(float v) {
#pragma unroll
    for (int o = 1; o < 64; o <<= 1) v += __shfl_xor(v, o);
    return v;
}
DI float sigmoidf_(float x) { return 1.f / (1.f + __expf(-x)); }
DI float softplusf_(float x) { return fmaxf(x, 0.f) + log1pf(__expf(-fabsf(x))); }
DI int crow(int i, int h) { return (i & 3) + 8 * (i >> 2) + 4 * h; }
#define MFMA32(a, b, c) __builtin_amdgcn_mfma_f32_32x32x16_bf16((a), (b), (c), 0, 0, 0)

DI void mma_tile(f32x16& acc, const bf16_t* A, int lda, const bf16_t* Bt, int ldb, int ksteps, int lane) {
    const int rho = lane & 31, h = lane >> 5;
    const bf16_t* ap = A + rho * lda + 8 * h; const bf16_t* bp = Bt + rho * ldb + 8 * h;
    for (int s = 0; s < ksteps; ++s) {
        bf16x8 av = *(const bf16x8*)(ap + 16 * s); bf16x8 bv = *(const bf16x8*)(bp + 16 * s);
        acc = MFMA32(av, bv, acc);
    }
}

template <class Inner> struct Epi {
    static constexpr bool PERM = true, AFTER_DRAIN = false;
    Inner in;
    DI void operator()(const pg8::f32x4 (&acc)[2][2][4][2], const pg8::Unit& u, int wr, int wc, int fr, int fq) const {
        const int row0 = u.pm * 256 + wr * 64 + fr, col0 = u.pn * 256 + wc * 32 + 8 * fq;
#pragma unroll
        for (int ai = 0; ai < 2; ++ai)
#pragma unroll
            for (int m = 0; m < 4; ++m) {
                const int row = row0 + ai * 128 + m * 16;
#pragma unroll
                for (int bj = 0; bj < 2; ++bj) in.store8(row, col0 + bj * 128, acc[ai][bj][m][0], acc[ai][bj][m][1]);
            }
    }
};
DI u32x4 pack8(f32x4 a, f32x4 b) { u32x4 w; w.x = cvtpk(a[0], a[1]); w.y = cvtpk(a[2], a[3]); w.z = cvtpk(b[0], b[1]); w.w = cvtpk(b[2], b[3]); return w; }

template <int ACT> struct InStore {
    bf16_t* O; int ldc;
    DI void store8(int row, int col, f32x4 a, f32x4 b) const {
        if (ACT == 1) {
#pragma unroll
            for (int j = 0; j < 4; ++j) { float x = fmaxf(a[j], 0.f); a[j] = x * x; float y = fmaxf(b[j], 0.f); b[j] = y * y; }
        }
        *(u32x4*)(O + (size_t)row * ldc + col) = pack8(a, b);
    }
};
struct InNaQkv {
    bf16_t* QK; bf16_t* VTL; bf16_t* VTC;
    DI void store8(int row, int col, f32x4 a, f32x4 b) const {
        if (col < 2048) {
            const float sc = col < 1024 ? 0.125f : 1.f;
            *(u32x4*)(QK + (size_t)row * 2048 + col) = pack8(a * sc, b * sc);
        } else {
            const int c = col - 2048, hd = c >> 6, d0 = c & 63;
            bf16_t* p; size_t ld;
            if (row < ML) { const int b_ = row >> 12, t = row & 4095; p = VTL + ((size_t)((b_ * 16 + hd) * 64 + d0)) * 4096 + t; ld = 4096; }
            else { const int r2 = row - ML, b_ = r2 >> 8, t = r2 & 255; p = VTC + ((size_t)((b_ * 16 + hd) * 64 + d0)) * 256 + t; ld = 256; }
#pragma unroll
            for (int j = 0; j < 4; ++j) { p[(size_t)j * ld] = f2bf(a[j]); p[(size_t)(j + 4) * ld] = f2bf(b[j]); }
        }
    }
};
struct InResid {
    const float* sl; const float* sc; float* dl; float* dc; const float* gate;
    DI void store8(int row, int col, f32x4 a, f32x4 b) const {
        const float* s; float* d; int mi;
        if (row < ML) { s = sl + (size_t)row * 1024 + col; d = dl + (size_t)row * 1024 + col; mi = row >> 12; }
        else { s = sc + (size_t)(row - ML) * 1024 + col; d = dc + (size_t)(row - ML) * 1024 + col; mi = 8; }
        const float* g = gate + (size_t)mi * 6144 + col;
        const f32x4 g0 = *(const f32x4*)g, g1 = *(const f32x4*)(g + 4);
        const f32x4 x0 = *(const f32x4*)s, x1 = *(const f32x4*)(s + 4);
        *(f32x4*)d = x0 + g0 * a; *(f32x4*)(d + 4) = x1 + g1 * b;
    }
};
struct InGlaIn {
    bf16_t* P; float* LR;
    DI void store8(int row, int col, f32x4 a, f32x4 b) const {
        if (col < 3072) {
            const float sc = col < 512 ? 0.08838834764831845f : 1.f;
            *(u32x4*)(P + (size_t)row * 3072 + col) = pack8(a * sc, b * sc);
        } else if (col < 3104) {
            float* p = LR + (size_t)row * 32 + (col - 3072);
            *(f32x4*)p = a; *(f32x4*)(p + 4) = b;
        }
    }
};
struct InRwL1 {
    bf16_t* RKV; bf16_t* SG; bf16_t* TWAA;
    DI void store8(int row, int col, f32x4 a, f32x4 b) const {
        if (col < 3072) { *(u32x4*)(RKV + (size_t)row * 3072 + col) = pack8(a, b); }
        else if (col < 3328) {
#pragma unroll
            for (int j = 0; j < 4; ++j) { a[j] = sigmoidf_(a[j]); b[j] = sigmoidf_(b[j]); }
            *(u32x4*)(SG + (size_t)row * 256 + (col - 3072)) = pack8(a, b);
        } else {
            const int c = col - 3328;
            if (c < 128) {
#pragma unroll
                for (int j = 0; j < 4; ++j) { a[j] = tanhf(a[j]); b[j] = tanhf(b[j]); }
            }
            *(u32x4*)(TWAA + (size_t)row * 256 + c) = pack8(a, b);
        }
    }
};

template <class Inner> DI void run_gemm(LAS unsigned char* lds, const bf16_t* A, const bf16_t* Bt, int M, int N, int K, const Inner& in) {
    int Kr = K; asm volatile("" : "+s"(Kr));
    pg8::Gemm g{A, Bt, M, N, Kr}; pg8::StaticOrder S; S.init(M, N, (int)gridDim.x, (int)blockIdx.x);
    Epi<Inner> E{in};
#ifndef NO_GEMM
    pg8::gemm_phase<Epi<Inner>, pg8::StaticOrder, true, true>(lds, g, S, E);
#endif
    __syncthreads();
}

DI void conv_item(const float* W, int ldw, int Kv, int Nv, const float* mix, int mode, bf16_t* WT, int ldt, int row_off, int col_off, float* scr, int kb, int nb, int lane) {
    const int k0 = 64 * kb, n0 = 32 * nb;
#pragma unroll 8
    for (int i = 0; i < 32; ++i) {
        const int kk = 2 * i + (lane >> 5), k = k0 + kk, n = n0 + (lane & 31);
        float v = (k < Kv && n < Nv) ? W[(size_t)k * ldw + n] : 0.f;
        if (mode) { const float m = (k < Kv) ? mix[k] : 0.f; v *= (mode == 1) ? (1.f - m) : m; }
        scr[kk * 33 + (lane & 31)] = v;
    }
    __builtin_amdgcn_s_waitcnt(0xc07f); __builtin_amdgcn_wave_barrier();
    const int c = lane & 7;
#pragma unroll
    for (int j = 0; j < 4; ++j) {
        const int n = (lane >> 3) + 8 * j; const float* s = scr + (8 * c) * 33 + n;
        u32x4 o; o.x = cvtpk(s[0 * 33], s[1 * 33]); o.y = cvtpk(s[2 * 33], s[3 * 33]); o.z = cvtpk(s[4 * 33], s[5 * 33]); o.w = cvtpk(s[6 * 33], s[7 * 33]);
        *(u32x4*)(WT + (size_t)(row_off + n0 + n) * ldt + col_off + k0 + 8 * c) = o;
    }
    __builtin_amdgcn_s_waitcnt(0xc07f); __builtin_amdgcn_wave_barrier();
}
DI void conv_job(const float* W, int ldw, int Kv, int Nv, int Kp, int Np, const float* mix, int mode, bf16_t* WT, int ldt, int row_off, int col_off, float* scr, int gw, int ngw, int lane) {
    const int nkb = Kp / 64, nnb = Np / 32, nit = nkb * nnb;
    for (int it = gw; it < nit; it += ngw) conv_item(W, ldw, Kv, Nv, mix, mode, WT, ldt, row_off, col_off, scr, it / nnb, it % nnb, lane);
}

DI void norm_row(const float* xr, const f32x4 (&gs)[4], const f32x4 (&sh)[4], int lane, f32x4 (&out)[4]) {
    f32x4 v[4]; float s = 0.f;
#pragma unroll
    for (int j = 0; j < 4; ++j) { v[j] = *(const f32x4*)(xr + 4 * lane + 256 * j); s += (v[j].x * v[j].x + v[j].y * v[j].y) + (v[j].z * v[j].z + v[j].w * v[j].w); }
    s = wave_sum(s);
    const float rinv = rsqrtf(s * (1.f / 1024.f) + 1e-6f);
#pragma unroll
    for (int j = 0; j < 4; ++j) out[j] = v[j] * rinv * gs[j] + sh[j];
}
DI void store_row_bf16(bf16_t* o, const f32x4 (&v)[4], int lane) {
#pragma unroll
    for (int j = 0; j < 4; ++j) { u32x2 w; w.x = cvtpk(v[j].x, v[j].y); w.y = cvtpk(v[j].z, v[j].w); *(u32x2*)(o + 4 * lane + 256 * j) = w; }
}
DI void phase_prenorm(const float* xl, const float* xc, const float* g, const float* modl  , int shift_chunk, bf16_t* H, int ldh, bool with_hs, int Mrows, int gw, int ngw, int lane) {
#define XROW(r) ((r) < ML ? xl + (size_t)(r) * 1024 : xc + (size_t)((r) - ML) * 1024)
    if (!with_hs) {
        const int nstrips = Mrows / 4;
        for (int st = gw; st < nstrips; st += ngw) {
            const int row0 = 4 * st;
            const int mi = row0 < ML ? row0 >> 12 : 8;
            const float* mp = modl + (size_t)mi * 6144 + shift_chunk * 1024;
            f32x4 v[4][4]; float ss[4];
#pragma unroll
            for (int r = 0; r < 4; ++r) { const float* xr = XROW(row0 + r);
#pragma unroll
                for (int j = 0; j < 4; ++j) v[r][j] = *(const f32x4*)(xr + 4 * lane + 256 * j); }
            f32x4 gs[4], sh[4];
#pragma unroll
            for (int j = 0; j < 4; ++j) { const int c = 4 * lane + 256 * j; sh[j] = *(const f32x4*)(mp + c); const f32x4 sc = *(const f32x4*)(mp + 1024 + c); gs[j] = *(const f32x4*)(g + c) * (sc + 1.f); }
#pragma unroll
            for (int r = 0; r < 4; ++r) { float s = 0.f;
#pragma unroll
                for (int j = 0; j < 4; ++j) s += (v[r][j].x * v[r][j].x + v[r][j].y * v[r][j].y) + (v[r][j].z * v[r][j].z + v[r][j].w * v[r][j].w);
                ss[r] = s; }
#pragma unroll
            for (int o = 1; o < 64; o <<= 1) {
#pragma unroll
                for (int r = 0; r < 4; ++r) ss[r] += __shfl_xor(ss[r], o);
            }
#pragma unroll
            for (int r = 0; r < 4; ++r) { const float rinv = rsqrtf(ss[r] * (1.f / 1024.f) + 1e-6f); f32x4 o[4];
#pragma unroll
                for (int j = 0; j < 4; ++j) o[j] = v[r][j] * rinv * gs[j] + sh[j];
                store_row_bf16(H + (size_t)(row0 + r) * ldh, o, lane); }
        }
    } else {
        const int nstrips = Mrows / 8;
        for (int st = gw; st < nstrips; st += ngw) {
            const int row0 = 8 * st;
            int mi, seg0, seg1;
            if (row0 < ML) { mi = row0 >> 12; seg0 = row0 & ~4095; seg1 = seg0 + 4096; } else { mi = 8; seg0 = ML + ((row0 - ML) & ~255); seg1 = seg0 + 256; }
            const float* mp = modl + (size_t)mi * 6144 + shift_chunk * 1024;
            f32x4 gs[4], sh[4];
#pragma unroll
            for (int j = 0; j < 4; ++j) { const int c = 4 * lane + 256 * j; sh[j] = *(const f32x4*)(mp + c); const f32x4 sc = *(const f32x4*)(mp + 1024 + c); gs[j] = *(const f32x4*)(g + c) * (sc + 1.f); }
            f32x4 prev[4], cur[4], nxt[4];
            if (row0 > seg0) norm_row(XROW(row0 - 1), gs, sh, lane, prev); else { for (int j = 0; j < 4; ++j) prev[j] = (f32x4){0.f, 0.f, 0.f, 0.f}; }
            norm_row(XROW(row0), gs, sh, lane, cur);
            for (int r = row0; r < row0 + 8; ++r) {
                if (r + 1 < seg1) norm_row(XROW(r + 1), gs, sh, lane, nxt); else { for (int j = 0; j < 4; ++j) nxt[j] = (f32x4){0.f, 0.f, 0.f, 0.f}; }
                store_row_bf16(H + (size_t)r * ldh, cur, lane);
                f32x4 hs[4];
#pragma unroll
                for (int j = 0; j < 4; ++j) hs[j] = (prev[j] + nxt[j]) * 0.5f;
                store_row_bf16(H + (size_t)r * ldh + 1024, hs, lane);
#pragma unroll
                for (int j = 0; j < 4; ++j) { prev[j] = cur[j]; cur[j] = nxt[j]; }
            }
        }
    }
#undef XROW
}

DI void phase_mod(const Args& a, float* lds, int tid) {
    float* sc = lds;
    float* red = lds + 1024 * 12;
    const float* c = a.in[1]; const float* cctx = a.in[3]; const float* ada_w = a.in[4]; const float* ada_b = a.in[5];
    float* mod = (float*)(a.ws + WS_MOD);
    for (int idx = tid; idx < 9 * 1024; idx += NTHREADS) { const int j = idx >> 10, k = idx & 1023; const float v = j < 8 ? c[j * 1024 + k] : cctx[k]; sc[k * 12 + j] = v * sigmoidf_(v); }
    __syncthreads();
    for (int unit = blockIdx.x; unit < 384; unit += gridDim.x) {
        const int l = unit / 96, n0 = (unit % 96) * 64, col = tid & 63, ks = tid >> 6;
        const float* w = ada_w + ((size_t)l * 1024 + ks * 128) * 6144 + n0 + col;
        float acc[9];
#pragma unroll
        for (int j = 0; j < 9; ++j) acc[j] = 0.f;
#pragma unroll 8
        for (int kk = 0; kk < 128; ++kk) {
            const float wv = w[(size_t)kk * 6144]; const float* s = sc + (ks * 128 + kk) * 12;
            const f32x4 s0 = *(const f32x4*)s, s1 = *(const f32x4*)(s + 4); const float s8 = s[8];
            acc[0] += s0.x * wv; acc[1] += s0.y * wv; acc[2] += s0.z * wv; acc[3] += s0.w * wv;
            acc[4] += s1.x * wv; acc[5] += s1.y * wv; acc[6] += s1.z * wv; acc[7] += s1.w * wv; acc[8] += s8 * wv;
        }
#pragma unroll
        for (int j = 0; j < 9; ++j) red[(ks * 9 + j) * 64 + col] = acc[j];
        __syncthreads();
        for (int idx = tid; idx < 576; idx += NTHREADS) {
            const int j = idx >> 6, cc = idx & 63; float s = ada_b[l * 6144 + n0 + cc];
#pragma unroll
            for (int k2 = 0; k2 < 8; ++k2) s += red[(k2 * 9 + j) * 64 + cc];
            mod[((size_t)(l * 9 + j)) * 6144 + n0 + cc] = s;
        }
        __syncthreads();
    }
}

DI void attn_unit(const bf16_t* QK, const bf16_t* VTL, const bf16_t* VTC, bf16_t* O, const float* tbl, int b, int hd, int r, int cq, int lane) {
    const int n = lane & 31, h = lane >> 5;
    const bool lat = r >= 0;
    const int qrow0 = lat ? b * 4096 + r * 64 : ML + b * 256 + cq * 64;
    const int pin = (n & 0x13) | ((n & 4) << 1) | ((n & 8) >> 1);
    bf16x8 bq[2][4];
#pragma unroll
    for (int qb = 0; qb < 2; ++qb)
#pragma unroll
        for (int s = 0; s < 4; ++s) bq[qb][s] = *(const bf16x8*)(QK + (size_t)(qrow0 + 32 * qb + n) * 2048 + hd * 64 + 32 * h + 8 * s);
    f32x16 o[2][2];
#pragma unroll
    for (int x = 0; x < 2; ++x)
#pragma unroll
        for (int y = 0; y < 2; ++y)
#pragma unroll
            for (int i = 0; i < 16; ++i) o[x][y][i] = 0.f;
    float mrun[2] = {-1e30f, -1e30f}, lrun[2] = {0.f, 0.f};
    const int r0 = lat ? min(max(r - 4, 0), 56) : 0;
    const int nblk = lat ? 24 : 8;
    const bf16_t* vtc = VTC + (size_t)((b * 16 + hd) * 64) * 256;
    const bf16_t* vtl = VTL + (size_t)((b * 16 + hd) * 64) * 4096;
    for (int blk = 0; blk < nblk; ++blk) {
        int krow0, ldv, kc0 = 0, ridx = 0; const bf16_t* vt;
        const bool lb_ = blk >= 8;
        if (!lb_) { krow0 = ML + b * 256 + blk * 32; vt = vtc + blk * 32; ldv = 256; }
        else { const int lb = blk - 8, kr = r0 + (lb >> 1); kc0 = (lb & 1) * 32; krow0 = b * 4096 + kr * 64 + kc0; vt = vtl + kr * 64 + kc0; ldv = 4096; ridx = kr - r + 7; }
        bf16x8 ka[4];
#pragma unroll
        for (int s = 0; s < 4; ++s) ka[s] = *(const bf16x8*)(QK + (size_t)(krow0 + pin) * 2048 + 1024 + hd * 64 + 32 * h + 8 * s);
        bf16x8 va[2][2];
#pragma unroll
        for (int db = 0; db < 2; ++db)
#pragma unroll
            for (int s2 = 0; s2 < 2; ++s2) va[db][s2] = *(const bf16x8*)(vt + (size_t)(32 * db + n) * ldv + 16 * s2 + 8 * h);
        f32x16 sa[2];
#pragma unroll
        for (int qb = 0; qb < 2; ++qb) {
#pragma unroll
            for (int i = 0; i < 16; ++i) sa[qb][i] = 0.f;
#pragma unroll
            for (int s = 0; s < 4; ++s) sa[qb] = MFMA32(ka[s], bq[qb][s], sa[qb]);
        }
        bf16x8 pb[2][2];
#pragma unroll
        for (int qb = 0; qb < 2; ++qb) {
            if (lb_) {
                const int qc = 32 * qb + n, cs = min(max(qc - 8, 0), 48);
                const float* bp = tbl + ridx * 128 + 48 + 15 + kc0 + 8 * h - qc;
                const int okb = kc0 + 8 * h - cs;
#pragma unroll
                for (int i = 0; i < 16; ++i) {
                    const int ko = (i & 7) + 16 * (i >> 3);
                    const bool ok = (unsigned)(okb + ko) < 16u;
                    const float bv = bp[ko];
                    sa[qb][i] = ok ? sa[qb][i] + bv : -1e30f;
                }
            }
            float bm = sa[qb][0];
#pragma unroll
            for (int i = 1; i < 16; ++i) bm = fmaxf(bm, sa[qb][i]);
            bm = fmaxf(bm, __shfl_xor(bm, 32));
            const float mnew = fmaxf(mrun[qb], bm);
            const float alpha = __expf(mrun[qb] - mnew);
            mrun[qb] = mnew;
            float ps = 0.f;
#pragma unroll
            for (int i = 0; i < 16; ++i) { const float p = __expf(sa[qb][i] - mnew); sa[qb][i] = p; ps += p; }
            lrun[qb] = lrun[qb] * alpha + ps;
#pragma unroll
            for (int db = 0; db < 2; ++db)
#pragma unroll
                for (int i = 0; i < 16; ++i) o[db][qb][i] *= alpha;
#pragma unroll
            for (int s2 = 0; s2 < 2; ++s2) {
                u32x4 w; w.x = cvtpk(sa[qb][8 * s2 + 0], sa[qb][8 * s2 + 1]); w.y = cvtpk(sa[qb][8 * s2 + 2], sa[qb][8 * s2 + 3]);
                w.z = cvtpk(sa[qb][8 * s2 + 4], sa[qb][8 * s2 + 5]); w.w = cvtpk(sa[qb][8 * s2 + 6], sa[qb][8 * s2 + 7]);
                pb[qb][s2] = __builtin_bit_cast(bf16x8, w);
            }
        }
#pragma unroll
        for (int db = 0; db < 2; ++db)
#pragma unroll
            for (int qb = 0; qb < 2; ++qb)
#pragma unroll
                for (int s2 = 0; s2 < 2; ++s2) o[db][qb] = MFMA32(va[db][s2], pb[qb][s2], o[db][qb]);
    }
#pragma unroll
    for (int qb = 0; qb < 2; ++qb) {
        const float lt = lrun[qb] + __shfl_xor(lrun[qb], 32);
        const float inv = 1.f / lt;
        bf16_t* op = O + (size_t)(qrow0 + 32 * qb + n) * 1024 + hd * 64;
#pragma unroll
        for (int db = 0; db < 2; ++db)
#pragma unroll
            for (int g = 0; g < 4; ++g) {
                u32x2 w; w.x = cvtpk(o[db][qb][4 * g] * inv, o[db][qb][4 * g + 1] * inv); w.y = cvtpk(o[db][qb][4 * g + 2] * inv, o[db][qb][4 * g + 3] * inv);
                *(u32x2*)(op + 32 * db + 8 * g + 4 * h) = w;
            }
    }
}

DI void gla_unit(const bf16_t* P, const float* LR, const float* wdec, const float* bdec, bf16_t* OUT  , unsigned char* lds, int unit, int tid) {
    const int lane = tid & 63, wid = __builtin_amdgcn_readfirstlane(tid >> 6);
    const int vs = unit & 3, dir = (unit >> 2) & 1, hd = (unit >> 3) & 3, b = unit >> 5;
    bf16_t* QE = (bf16_t*)lds;
    bf16_t* KE = QE + 64 * 136;
    bf16_t* ST = KE + 64 * 136;
    bf16_t* KDT = ST + 64 * 136;
    bf16_t* VT = KDT + 128 * 72;
    bf16_t* AM = VT + 64 * 72;
    float* Bc = (float*)(AM + 64 * 72);
    float* LRs = Bc + 64 * 132;
    float* GRP = LRs + 64 * 16;
    float* DEC = GRP + 4 * 128;
    const int dcol = tid & 127, lg = tid >> 7;
    float wd[16];
#pragma unroll
    for (int r = 0; r < 16; ++r) wd[r] = wdec[(dir * 16 + r) * 512 + hd * 128 + dcol];
    const float bd = bdec[dir * 512 + hd * 128 + dcol];
    const int col_q = hd * 128, col_k = 512 + hd * 128, col_v = 1024 + hd * 256 + vs * 64;
    f32x16 st;
#pragma unroll
    for (int i = 0; i < 16; ++i) st[i] = 0.f;
    const int svt = wid >> 2, sdt = wid & 3, rho = lane & 31, hh = lane >> 5;
    bf16_t* outp = OUT + (size_t)dir * MT * 1024;
    const int el = tid >> 3, eg = tid & 7;
    constexpr int NCHT = 68;
#define GROWQ(q, l) ((q) < 4 ? ML + b * 256 + (dir ? 255 - ((q) * 64 + (l)) : (q) * 64 + (l)) : b * 4096 + (dir ? 4095 - (((q) - 4) * 64 + (l)) : ((q) - 4) * 64 + (l)))
    u32x4 rq0, rq1, rk0, rk1, rv; f32x2_t rlr;
#define GLA_FETCH(q) do { const size_t ro_ = (size_t)GROWQ(q, el) * 3072; \
        rq0 = *(const u32x4*)(P + ro_ + col_q + 16 * eg); rq1 = *(const u32x4*)(P + ro_ + col_q + 16 * eg + 8); \
        rk0 = *(const u32x4*)(P + ro_ + col_k + 16 * eg); rk1 = *(const u32x4*)(P + ro_ + col_k + 16 * eg + 8); \
        rv = *(const u32x4*)(P + ro_ + col_v + 8 * eg); \
        { const int idx_ = tid * 2, l_ = idx_ >> 4, r_ = idx_ & 15; rlr = *(const f32x2_t*)(LR + (size_t)GROWQ(q, l_) * 32 + dir * 16 + r_); } } while (0)
    GLA_FETCH(0);
    for (int q = 0; q < NCHT; ++q) {
        const u32x4 cq0 = rq0, cq1 = rq1, ck0 = rk0, ck1 = rk1, cv = rv;
        { const int idx = tid * 2, l = idx >> 4, r = idx & 15; LRs[l * 16 + r] = rlr.x; LRs[l * 16 + r + 1] = rlr.y; }
        __syncthreads();
        if (q + 1 < NCHT) GLA_FETCH(q + 1);
        { float run = 0.f;
          for (int li = 0; li < 16; ++li) { const int l = 16 * lg + li; float z = bd;
              const f32x4 l0 = *(const f32x4*)(LRs + l * 16), l1 = *(const f32x4*)(LRs + l * 16 + 4), l2 = *(const f32x4*)(LRs + l * 16 + 8), l3 = *(const f32x4*)(LRs + l * 16 + 12);
              z += l0.x * wd[0] + l0.y * wd[1] + l0.z * wd[2] + l0.w * wd[3]; z += l1.x * wd[4] + l1.y * wd[5] + l1.z * wd[6] + l1.w * wd[7];
              z += l2.x * wd[8] + l2.y * wd[9] + l2.z * wd[10] + l2.w * wd[11]; z += l3.x * wd[12] + l3.y * wd[13] + l3.z * wd[14] + l3.w * wd[15];
              const float x = -z; const float sp = fmaxf(x, 0.f) + __logf(1.f + __expf(-fabsf(x)));
              run -= sp * (1.f / 16.f); Bc[l * 132 + dcol] = run; }
          GRP[lg * 128 + dcol] = run; }
        __syncthreads();
        {
          const int g_ = el >> 4;
          float bv[16], bl[16];
#pragma unroll
          for (int e4 = 0; e4 < 4; ++e4) {
              const f32x4 t = *(const f32x4*)(Bc + el * 132 + 16 * eg + 4 * e4);
              f32x4 off = (f32x4){0.f, 0.f, 0.f, 0.f}, tot = (f32x4){0.f, 0.f, 0.f, 0.f};
#pragma unroll
              for (int g2 = 0; g2 < 4; ++g2) { const f32x4 gq = *(const f32x4*)(GRP + g2 * 128 + 16 * eg + 4 * e4); tot += gq; if (g2 < g_) off += gq; }
#pragma unroll
              for (int j = 0; j < 4; ++j) { bv[4 * e4 + j] = t[j] + off[j]; bl[4 * e4 + j] = tot[j]; }
          }
          if (el == 0) {
#pragma unroll
              for (int e = 0; e < 16; ++e) DEC[16 * eg + e] = __expf(bl[e]);
          }
          unsigned qw[8] = {cq0.x, cq0.y, cq0.z, cq0.w, cq1.x, cq1.y, cq1.z, cq1.w}, kw[8] = {ck0.x, ck0.y, ck0.z, ck0.w, ck1.x, ck1.y, ck1.z, ck1.w};
          unsigned qo[8], ko[8];
#pragma unroll
          for (int e2 = 0; e2 < 8; ++e2) {
              const float q0 = __uint_as_float(qw[e2] << 16), q1 = __uint_as_float(qw[e2] & 0xffff0000u), k0 = __uint_as_float(kw[e2] << 16), k1 = __uint_as_float(kw[e2] & 0xffff0000u);
              const float b0 = bv[2 * e2], b1 = bv[2 * e2 + 1];
              const float e0 = __expf(b0), e1 = __expf(b1);
              qo[e2] = cvtpk(q0 * e0, q1 * e1);
              ko[e2] = cvtpk(k0 * __builtin_amdgcn_rcpf(e0), k1 * __builtin_amdgcn_rcpf(e1));
              KDT[(16 * eg + 2 * e2) * 72 + el] = f2bf(k0 * __expf(bl[2 * e2] - b0)); KDT[(16 * eg + 2 * e2 + 1) * 72 + el] = f2bf(k1 * __expf(bl[2 * e2 + 1] - b1));
          }
          *(u32x4*)(QE + el * 136 + 16 * eg) = (u32x4){qo[0], qo[1], qo[2], qo[3]}; *(u32x4*)(QE + el * 136 + 16 * eg + 8) = (u32x4){qo[4], qo[5], qo[6], qo[7]};
          *(u32x4*)(KE + el * 136 + 16 * eg) = (u32x4){ko[0], ko[1], ko[2], ko[3]}; *(u32x4*)(KE + el * 136 + 16 * eg + 8) = (u32x4){ko[4], ko[5], ko[6], ko[7]};
          { const unsigned vw[4] = {cv.x, cv.y, cv.z, cv.w};
#pragma unroll
            for (int e2 = 0; e2 < 4; ++e2) { VT[(8 * eg + 2 * e2) * 72 + el] = (bf16_t)(vw[e2] & 0xffffu); VT[(8 * eg + 2 * e2 + 1) * 72 + el] = (bf16_t)(vw[e2] >> 16); } }
#pragma unroll
          for (int i = 0; i < 16; ++i) ST[(32 * svt + crow(i, hh)) * 136 + 32 * sdt + rho] = f2bf(st[i]);
        }
        __syncthreads();
        if (wid < 4) { const int lt = wid >> 1, mt = wid & 1; f32x16 acc;
#pragma unroll
            for (int i = 0; i < 16; ++i) acc[i] = 0.f;
            mma_tile(acc, QE + 32 * lt * 136, 136, KE + 32 * mt * 136, 136, 8, lane);
#pragma unroll
            for (int i = 0; i < 16; ++i) { const int l = 32 * lt + crow(i, hh), m = 32 * mt + rho; AM[l * 72 + m] = f2bf(m <= l ? acc[i] : 0.f); } }
        __syncthreads();
        if (wid < 4) { const int lt = wid >> 1, vt2 = wid & 1; f32x16 acc;
#pragma unroll
            for (int i = 0; i < 16; ++i) acc[i] = 0.f;
            mma_tile(acc, AM + 32 * lt * 72, 72, VT + 32 * vt2 * 72, 72, 4, lane);
            mma_tile(acc, QE + 32 * lt * 136, 136, ST + 32 * vt2 * 136, 136, 8, lane);
#pragma unroll
            for (int i = 0; i < 16; ++i) { const int l = 32 * lt + crow(i, hh); outp[(size_t)GROWQ(q, l) * 1024 + hd * 256 + vs * 64 + 32 * vt2 + rho] = f2bf(acc[i]); } }
        { const float dc = DEC[32 * sdt + rho];
#pragma unroll
          for (int i = 0; i < 16; ++i) st[i] *= dc;
          mma_tile(st, VT + 32 * svt * 72, 72, KDT + 32 * sdt * 72, 72, 4, lane); }
        __syncthreads();
    }
#undef GROWQ
#undef GLA_FETCH
}
struct GlaFinRow { bf16x8 a0, a1, b0, b1, g0, g1; };
DI void gla_fin_load(GlaFinRow& R, const bf16_t* OF, const bf16_t* OB, const bf16_t* P, int row, int c0) {
    R.a0 = *(const bf16x8*)(OF + (size_t)row * 1024 + c0); R.a1 = *(const bf16x8*)(OF + (size_t)row * 1024 + c0 + 8);
    R.b0 = *(const bf16x8*)(OB + (size_t)row * 1024 + c0); R.b1 = *(const bf16x8*)(OB + (size_t)row * 1024 + c0 + 8);
    R.g0 = *(const bf16x8*)(P + (size_t)row * 3072 + 2048 + c0); R.g1 = *(const bf16x8*)(P + (size_t)row * 3072 + 2048 + c0 + 8);
}
DI void gla_fin_store(const GlaFinRow& R, bf16_t* OF, const float* ng, int row, int c0) {
    float o[16]; float ss = 0.f;
#pragma unroll
    for (int e = 0; e < 8; ++e) { o[e] = bf2f((bf16_t)R.a0[e]) + bf2f((bf16_t)R.b0[e]); o[8 + e] = bf2f((bf16_t)R.a1[e]) + bf2f((bf16_t)R.b1[e]); }
#pragma unroll
    for (int e = 0; e < 16; ++e) ss += o[e] * o[e];
    ss += __shfl_xor(ss, 1); ss += __shfl_xor(ss, 2); ss += __shfl_xor(ss, 4); ss += __shfl_xor(ss, 8);
    const float rinv = rsqrtf(ss * (1.f / 256.f) + 1e-6f);
    float y[16];
#pragma unroll
    for (int e = 0; e < 16; ++e) { const float gt = bf2f((bf16_t)(e < 8 ? R.g0[e] : R.g1[e - 8])); y[e] = o[e] * rinv * ng[(c0 + e) & 255] * (gt * sigmoidf_(gt)); }
    u32x4 w0, w1; w0.x = cvtpk(y[0], y[1]); w0.y = cvtpk(y[2], y[3]); w0.z = cvtpk(y[4], y[5]); w0.w = cvtpk(y[6], y[7]);
    w1.x = cvtpk(y[8], y[9]); w1.y = cvtpk(y[10], y[11]); w1.z = cvtpk(y[12], y[13]); w1.w = cvtpk(y[14], y[15]);
    *(u32x4*)(OF + (size_t)row * 1024 + c0) = w0; *(u32x4*)(OF + (size_t)row * 1024 + c0 + 8) = w1;
}
DI void gla_finish(bf16_t* OF, const bf16_t* OB, const bf16_t* P, const float* ng, int Mrows, int gw, int ngw, int lane) {
    const int c0 = 16 * lane;
    for (int row = gw; row < Mrows; row += 2 * ngw) {
        const int rowB = row + ngw < Mrows ? row + ngw : row;
        GlaFinRow A, B;
        gla_fin_load(A, OF, OB, P, row, c0); gla_fin_load(B, OF, OB, P, rowB, c0);
        gla_fin_store(A, OF, ng, row, c0);
        if (rowB != row) gla_fin_store(B, OF, ng, rowB, c0);
    }
}

typedef unsigned u32x2_t __attribute__((ext_vector_type(2)));
DI float red_rows(float x) {
    unsigned u = __float_as_uint(x);
    u32x2_t r = __builtin_amdgcn_permlane16_swap(u, u, false, false);
    const float y = __uint_as_float(r.x) + __uint_as_float(r.y);
    unsigned v = __float_as_uint(y);
    u32x2_t q = __builtin_amdgcn_permlane32_swap(v, v, false, false);
    return __uint_as_float(q.x) + __uint_as_float(q.y);
}
DI int rw_row(int q, int l, int dir, int b) {
    int T, base, n;
    if (q < 8) { T = 256; base = ML + b * 256; n = q; } else { T = 4096; base = b * 4096; n = q - 8; }
    const int t = n * 32 + l;
    return base + (dir ? T - 1 - t : t);
}
#define DPPB(n) " row_newbcast:" #n " row_mask:0xf bank_mask:0xf\n\t"
#define RW_UPD(n, sreg) "v_mul_f32_dpp " sreg ", %17, " sreg DPPB(n) "v_fmac_f32_dpp " sreg ", %18, %21" DPPB(n) "v_fmac_f32_dpp " sreg ", %19, %22" DPPB(n)
DI void rwkv_unit(const Args& a, const bf16_t* RKV, const bf16_t* TWAA, bf16_t* Y  , float* RK  , unsigned char* lds, int unit, int tid) {
    const int lane = tid & 63, wid = __builtin_amdgcn_readfirstlane(tid >> 6);
    const int dir = unit & 1, hd = (unit >> 1) & 15, b = unit >> 5;
    float* SA = (float*)lds;
    float* YC = SA + 6 * 4096;
    bf16_t* W2T = (bf16_t*)(YC + 4096);
    bf16_t* A2T = W2T + 64 * 72;
    constexpr int NCH = 136;
    {
        const float* w2 = a.in[23] + (size_t)dir * 64 * 1024; const float* a2 = a.in[26] + (size_t)dir * 64 * 1024;
        for (int e = 0; e < 8; ++e) { const int idx = tid + 512 * e, j = idx >> 6, c = idx & 63; W2T[c * 72 + j] = f2bf(w2[(size_t)j * 1024 + hd * 64 + c]); A2T[c * 72 + j] = f2bf(a2[(size_t)j * 1024 + hd * 64 + c]); }
    }
    __syncthreads();
    bf16_t* yout = Y + (size_t)dir * MT * 1024; float* rkout = RK + (size_t)dir * MT * 16;
    if (wid >= 4) {
        const int pw = wid - 4, rho = lane & 31, h = lane >> 5, ptid = tid - 256;
        float cw0[2], ca0[2], ckk[2], cka[2], crk[2];
#pragma unroll
        for (int ct = 0; ct < 2; ++ct) { const int c = hd * 64 + 32 * ct + rho; cw0[ct] = a.in[21][dir * 1024 + c]; ca0[ct] = a.in[24][dir * 1024 + c]; ckk[ct] = a.in[29][c]; cka[ct] = a.in[30][c]; crk[ct] = a.in[31][c]; }
        for (int p = 0; p <= NCH + 1; ++p) {
            if (p < NCH) {
                const int buf = p & 1;
                const int rowA = rw_row(p, 8 * pw + (rho & 7), dir, b);
                const bf16_t* ta = TWAA + (size_t)rowA * 256 + dir * 64 + 8 * h;
                f32x16 zw0, zw1, za0, za1;
#pragma unroll
                for (int i = 0; i < 16; ++i) { zw0[i] = 0.f; zw1[i] = 0.f; za0[i] = 0.f; za1[i] = 0.f; }
#pragma unroll
                for (int s = 0; s < 4; ++s) {
                    const bf16x8 atw = *(const bf16x8*)(ta + 16 * s), aaa = *(const bf16x8*)(ta + 128 + 16 * s);
                    const bf16x8 bw0 = *(const bf16x8*)(W2T + rho * 72 + 16 * s + 8 * h), bw1 = *(const bf16x8*)(W2T + (32 + rho) * 72 + 16 * s + 8 * h);
                    const bf16x8 ba0 = *(const bf16x8*)(A2T + rho * 72 + 16 * s + 8 * h), ba1 = *(const bf16x8*)(A2T + (32 + rho) * 72 + 16 * s + 8 * h);
                    zw0 = MFMA32(atw, bw0, zw0); zw1 = MFMA32(atw, bw1, zw1); za0 = MFMA32(aaa, ba0, za0); za1 = MFMA32(aaa, ba1, za1);
                }
#pragma unroll
                for (int i = 0; i < 4; ++i) {
                    const int tok = 8 * pw + i + 4 * h; const int row = rw_row(p, tok, dir, b);
                    const bf16_t* pr = RKV + (size_t)row * 3072 + hd * 64 + rho;
                    float rv[2], kv[2], vv[2], av[2], kkv[2], kd[2]; float ss = 0.f, rk = 0.f;
#pragma unroll
                    for (int ct = 0; ct < 2; ++ct) {
                        rv[ct] = bf2f(pr[32 * ct]); kv[ct] = bf2f(pr[1024 + 32 * ct]); vv[ct] = bf2f(pr[2048 + 32 * ct]);
                        const float zav = ct ? za1[i] : za0[i];
                        av[ct] = 1.f / (1.f + __expf(-(ca0[ct] + zav)));
                        kkv[ct] = kv[ct] * ckk[ct]; ss += kkv[ct] * kkv[ct];
                        kd[ct] = kv[ct] * (1.f + (av[ct] - 1.f) * cka[ct]); rk += rv[ct] * kd[ct] * crk[ct];
                    }
#pragma unroll
                    for (int o = 1; o < 32; o <<= 1) { ss += __shfl_xor(ss, o); rk += __shfl_xor(rk, o); }
                    const float kinv = rsqrtf(fmaxf(ss, 1e-24f));
                    if (rho == 0) rkout[(size_t)row * 16 + hd] = rk;
#pragma unroll
                    for (int ct = 0; ct < 2; ++ct) {
                        const float zwv = ct ? zw1[i] : zw0[i];
                        const float x = -(cw0[ct] + zwv);
                        const float sp = fmaxf(x, 0.f) + __logf(1.f + __expf(-fabsf(x)));
                        const float dec = __expf(-__expf(-sp - 0.5f));
                        const float kn = kkv[ct] * kinv;
                        float* o = SA + buf * 2048 + tok * 64 + 32 * ct + rho;
                        o[0 * 4096] = dec; o[1 * 4096] = kd[ct]; o[2 * 4096] = kn * av[ct]; o[3 * 4096] = -kn; o[4 * 4096] = rv[ct]; o[5 * 4096] = vv[ct];
                    }
                }
            }
            if (p >= 2) {
                const int tok = ptid >> 3, i0 = (ptid & 7) * 8; const int row = rw_row(p - 2, tok, dir, b);
                const float* y = YC + (p & 1) * 2048 + tok * 64 + i0;
                const f32x4 y0 = *(const f32x4*)y, y1 = *(const f32x4*)(y + 4);
                *(u32x4*)(yout + (size_t)row * 1024 + hd * 64 + i0) = pack8(y0, y1);
            }
            __syncthreads();
        }
    } else {
        __builtin_amdgcn_s_setprio(3);
        const int rl = lane & 15, cg = lane >> 4, myrow = 16 * wid + rl;
        float s0 = 0.f, s1 = 0.f, s2 = 0.f, s3 = 0.f, s4 = 0.f, s5 = 0.f, s6 = 0.f, s7 = 0.f, s8 = 0.f, s9 = 0.f, s10 = 0.f, s11 = 0.f, s12 = 0.f, s13 = 0.f, s14 = 0.f, s15 = 0.f;
        for (int p = 0; p <= NCH + 1; ++p) {
            if (p >= 1 && p <= NCH) {
                const int buf = (p - 1) & 1;
                const float* base = SA + buf * 2048;
                float* yc = YC + buf * 2048 + myrow;
                float w_c = base[lane], kd_c = base[4096 + lane], bb_c = base[2 * 4096 + lane], nk_c = base[3 * 4096 + lane], r_c = base[4 * 4096 + lane], v_c = base[5 * 4096 + myrow];
                for (int t = 0; t < 32; ++t) {
                    const int tn = (t + 1) & 31;
                    const float w_n = base[tn * 64 + lane], kd_n = base[4096 + tn * 64 + lane], bb_n = base[2 * 4096 + tn * 64 + lane], nk_n = base[3 * 4096 + tn * 64 + lane], r_n = base[4 * 4096 + tn * 64 + lane], v_n = base[5 * 4096 + tn * 64 + myrow];
                    float sap;
                    asm volatile("s_nop 1\n\t"
                        "v_mul_f32_dpp %0, %1, %2" DPPB(0) "v_fmac_f32_dpp %0, %1, %3" DPPB(1) "v_fmac_f32_dpp %0, %1, %4" DPPB(2) "v_fmac_f32_dpp %0, %1, %5" DPPB(3)
                        "v_fmac_f32_dpp %0, %1, %6" DPPB(4) "v_fmac_f32_dpp %0, %1, %7" DPPB(5) "v_fmac_f32_dpp %0, %1, %8" DPPB(6) "v_fmac_f32_dpp %0, %1, %9" DPPB(7)
                        "v_fmac_f32_dpp %0, %1, %10" DPPB(8) "v_fmac_f32_dpp %0, %1, %11" DPPB(9) "v_fmac_f32_dpp %0, %1, %12" DPPB(10) "v_fmac_f32_dpp %0, %1, %13" DPPB(11)
                        "v_fmac_f32_dpp %0, %1, %14" DPPB(12) "v_fmac_f32_dpp %0, %1, %15" DPPB(13) "v_fmac_f32_dpp %0, %1, %16" DPPB(14) "v_fmac_f32_dpp %0, %1, %17" DPPB(15)
                        "s_nop 1"
                        : "=&v"(sap)
                        : "v"(nk_c), "v"(s0), "v"(s1), "v"(s2), "v"(s3), "v"(s4), "v"(s5), "v"(s6), "v"(s7), "v"(s8), "v"(s9), "v"(s10), "v"(s11), "v"(s12), "v"(s13), "v"(s14), "v"(s15));
                    const float sa = red_rows(sap);
                    float yp;
                    asm volatile("s_nop 1\n\t"
                        RW_UPD(0, "%0") RW_UPD(1, "%1") RW_UPD(2, "%2") RW_UPD(3, "%3") RW_UPD(4, "%4") RW_UPD(5, "%5") RW_UPD(6, "%6") RW_UPD(7, "%7")
                        RW_UPD(8, "%8") RW_UPD(9, "%9") RW_UPD(10, "%10") RW_UPD(11, "%11") RW_UPD(12, "%12") RW_UPD(13, "%13") RW_UPD(14, "%14") RW_UPD(15, "%15")
                        "v_mul_f32_dpp %16, %20, %0" DPPB(0) "v_fmac_f32_dpp %16, %20, %1" DPPB(1) "v_fmac_f32_dpp %16, %20, %2" DPPB(2) "v_fmac_f32_dpp %16, %20, %3" DPPB(3)
                        "v_fmac_f32_dpp %16, %20, %4" DPPB(4) "v_fmac_f32_dpp %16, %20, %5" DPPB(5) "v_fmac_f32_dpp %16, %20, %6" DPPB(6) "v_fmac_f32_dpp %16, %20, %7" DPPB(7)
                        "v_fmac_f32_dpp %16, %20, %8" DPPB(8) "v_fmac_f32_dpp %16, %20, %9" DPPB(9) "v_fmac_f32_dpp %16, %20, %10" DPPB(10) "v_fmac_f32_dpp %16, %20, %11" DPPB(11)
                        "v_fmac_f32_dpp %16, %20, %12" DPPB(12) "v_fmac_f32_dpp %16, %20, %13" DPPB(13) "v_fmac_f32_dpp %16, %20, %14" DPPB(14) "v_fmac_f32_dpp %16, %20, %15" DPPB(15)
                        "s_nop 1"
                        : "+v"(s0), "+v"(s1), "+v"(s2), "+v"(s3), "+v"(s4), "+v"(s5), "+v"(s6), "+v"(s7), "+v"(s8), "+v"(s9), "+v"(s10), "+v"(s11), "+v"(s12), "+v"(s13), "+v"(s14), "+v"(s15), "=&v"(yp)
                        : "v"(w_c), "v"(bb_c), "v"(kd_c), "v"(r_c), "v"(sa), "v"(v_c));
                    const float y = red_rows(yp);
                    if (cg == 0) yc[t * 64] = y;
                    w_c = w_n; kd_c = kd_n; bb_c = bb_n; nk_c = nk_n; r_c = r_n; v_c = v_n;
                }
            }
            __syncthreads();
        }
        __builtin_amdgcn_s_setprio(0);
    }
    __syncthreads();
}
struct RwFinRow { bf16x8 a0, a1, b0, b1, v0, v1, g0, g1; float rk; };
DI void rw_fin_load(RwFinRow& R, const bf16_t* YF, const bf16_t* YB, const bf16_t* RKV, const bf16_t* G, const float* RK, int row, int c0, int hd) {
    R.a0 = *(const bf16x8*)(YF + (size_t)row * 1024 + c0); R.a1 = *(const bf16x8*)(YF + (size_t)row * 1024 + c0 + 8);
    R.b0 = *(const bf16x8*)(YB + (size_t)row * 1024 + c0); R.b1 = *(const bf16x8*)(YB + (size_t)row * 1024 + c0 + 8);
    R.v0 = *(const bf16x8*)(RKV + (size_t)row * 3072 + 2048 + c0); R.v1 = *(const bf16x8*)(RKV + (size_t)row * 3072 + 2048 + c0 + 8);
    R.g0 = *(const bf16x8*)(G + (size_t)row * 1024 + c0); R.g1 = *(const bf16x8*)(G + (size_t)row * 1024 + c0 + 8);
    R.rk = RK[(size_t)row * 16 + hd] + RK[(size_t)MT * 16 + (size_t)row * 16 + hd];
}
DI void rw_fin_store(const RwFinRow& R, bf16_t* YF, const float* lng, const float* lnb, int row, int c0) {
    float y[16]; float sm = 0.f;
#pragma unroll
    for (int e = 0; e < 8; ++e) { y[e] = bf2f((bf16_t)R.a0[e]) + bf2f((bf16_t)R.b0[e]); y[8 + e] = bf2f((bf16_t)R.a1[e]) + bf2f((bf16_t)R.b1[e]); }
#pragma unroll
    for (int e = 0; e < 16; ++e) sm += y[e];
    sm += __shfl_xor(sm, 1); sm += __shfl_xor(sm, 2);
    const float mu = sm * (1.f / 64.f);
    float sv = 0.f;
#pragma unroll
    for (int e = 0; e < 16; ++e) { y[e] -= mu; sv += y[e] * y[e]; }
    sv += __shfl_xor(sv, 1); sv += __shfl_xor(sv, 2);
    const float rinv = rsqrtf(sv * (1.f / 64.f) + 64e-5f);
    float o[16];
#pragma unroll
    for (int e = 0; e < 16; ++e) { const float vv = bf2f((bf16_t)(e < 8 ? R.v0[e] : R.v1[e - 8])), gg = bf2f((bf16_t)(e < 8 ? R.g0[e] : R.g1[e - 8]));
        o[e] = (y[e] * rinv * lng[c0 + e] + lnb[c0 + e] + R.rk * vv) * gg; }
    u32x4 w0, w1; w0.x = cvtpk(o[0], o[1]); w0.y = cvtpk(o[2], o[3]); w0.z = cvtpk(o[4], o[5]); w0.w = cvtpk(o[6], o[7]);
    w1.x = cvtpk(o[8], o[9]); w1.y = cvtpk(o[10], o[11]); w1.z = cvtpk(o[12], o[13]); w1.w = cvtpk(o[14], o[15]);
    *(u32x4*)(YF + (size_t)row * 1024 + c0) = w0; *(u32x4*)(YF + (size_t)row * 1024 + c0 + 8) = w1;
}
DI void rwkv_finish(bf16_t* YF, const bf16_t* YB, const bf16_t* RKV, const bf16_t* G, const float* RK, const float* lng, const float* lnb, int Mrows, int gw, int ngw, int lane) {
    const int c0 = 16 * lane, hd = lane >> 2;
    for (int row = gw; row < Mrows; row += 2 * ngw) {
        const int rowB = row + ngw < Mrows ? row + ngw : row;
        RwFinRow A, B;
        rw_fin_load(A, YF, YB, RKV, G, RK, row, c0, hd); rw_fin_load(B, YF, YB, RKV, G, RK, rowB, c0, hd);
        rw_fin_store(A, YF, lng, lnb, row, c0);
        if (rowB != row) rw_fin_store(B, YF, lng, lnb, rowB, c0);
    }
}

#define XB_TMO      128
#define XB_XCNT(j)  (256  + 64 * (j))
#define XB_XSUB(j)  (1280 + 64 * (j))
#define XB_XGEN(j)  (2304 + 64 * (j))
#define XB_TOP      3328
#define XB_TOPGEN   3392
#define XCD_BAR_WORDS 3456
#define XB_SPIN_CAP (1u << 18)

__device__ __forceinline__ unsigned xb_ld(unsigned* p)              { return __hip_atomic_load(p, __ATOMIC_RELAXED, __HIP_MEMORY_SCOPE_AGENT); }
__device__ __forceinline__ unsigned xb_add(unsigned* p, unsigned v) { return __hip_atomic_fetch_add(p, v, __ATOMIC_RELAXED, __HIP_MEMORY_SCOPE_AGENT); }
__device__ __forceinline__ unsigned xb_xcc_id() { return (unsigned)__builtin_amdgcn_s_getreg((3 << 11) | 20) & 0xFu; }
#define XB_SPIN(cond, bar) do { unsigned _sp = 0; while (cond) { __builtin_amdgcn_s_sleep(1); \
    if ((++_sp & 255u) == 0u) { if (xb_ld(&(bar)[XB_TMO])) break; if (_sp > XB_SPIN_CAP) { atomicAdd(&(bar)[XB_TMO], 1u); break; } } } } while (0)

struct XcdBarrier {
    unsigned* bar; unsigned x;
    volatile LAS unsigned* st;
};

__device__ __forceinline__ XcdBarrier xcd_barrier_post(unsigned* bar, volatile LAS unsigned* st) {
    XcdBarrier b; b.bar = bar; b.x = xb_xcc_id(); b.st = st;
    if (threadIdx.x == 0) (void)xb_add(&bar[XB_XCNT(b.x)], 1u);
    return b;
}
__device__ __forceinline__ void xcd_barrier_complete(unsigned* bar, unsigned x, unsigned& nloc, unsigned& nx) {
    const unsigned G = gridDim.x * gridDim.y * gridDim.z;
    unsigned sum, cnt, mine, sp = 0u;
    for (;;) {
        sum = 0u; cnt = 0u; mine = 0u;
#pragma unroll
        for (unsigned j = 0; j < 16; ++j) { const unsigned c = xb_ld(&bar[XB_XCNT(j)]); sum += c; cnt += (c > 0u) ? 1u : 0u; mine = (j == x) ? c : mine; }
        if (sum == G) break;
        __builtin_amdgcn_s_sleep(1);
        if ((++sp & 255u) == 0u) { if (xb_ld(&bar[XB_TMO])) break; if (sp > XB_SPIN_CAP) { atomicAdd(&bar[XB_TMO], 1u); break; } }
    }
    nloc = mine > 0u ? mine : 1u; nx = cnt > 0u ? cnt : 1u;
}

__device__ __forceinline__ void xcd_barrier(const XcdBarrier& b) {
    asm volatile("s_waitcnt vmcnt(0)" ::: "memory");
    __syncthreads();
    if (threadIdx.x == 0) {
        unsigned* bar = b.bar;
        __builtin_amdgcn_s_waitcnt(0);
        unsigned nloc = b.st[0], nx = b.st[1];
        if (nloc == 0u) { xcd_barrier_complete(bar, b.x, nloc, nx); b.st[0] = nloc; b.st[1] = nx; }
        const unsigned old = xb_add(&bar[XB_XSUB(b.x)], 1u);
        const unsigned gen = old / nloc;
        if (old + 1u == (gen + 1u) * nloc) {
            __builtin_amdgcn_fence(__ATOMIC_RELEASE, "agent");
            asm volatile("s_waitcnt vmcnt(0)" ::: "memory");
            const unsigned og = xb_add(&bar[XB_TOP], 1u);
            const unsigned tg = og / nx;
            if (og + 1u == (tg + 1u) * nx) xb_add(&bar[XB_TOPGEN], 1u);
            else XB_SPIN(xb_ld(&bar[XB_TOPGEN]) == tg, bar);
            __builtin_amdgcn_fence(__ATOMIC_ACQUIRE, "agent");
            xb_add(&bar[XB_XGEN(b.x)], 1u);
            asm volatile("s_waitcnt vmcnt(0)" ::: "memory");
        } else {
            XB_SPIN(xb_ld(&bar[XB_XGEN(b.x)]) == gen, bar);
            __builtin_amdgcn_fence(__ATOMIC_ACQUIRE, "agent");
            asm volatile("s_waitcnt vmcnt(0)" ::: "memory");
        }
    }
    __syncthreads();
}

#define WSP(T, off) ((T*)(a.ws + (off)))
#define PHASE(k) if (lo <= (k) && (k) < hi)
#define SEAM(k) do { if ((k) + 1 < hi) xcd_barrier(xbar); } while (0)
template <int L> DI void run_layer(const Args& a, unsigned char* lds, const XcdBarrier& xbar, int lo, int hi) {
    constexpr int kind = L % 3, jj = L / 3, P0 = 1 + 8 * L;
    constexpr bool need_ctx = L < 3;
    constexpr int Mact = need_ctx ? MT : ML;
    const int tid = threadIdx.x, lane = tid & 63, wid = __builtin_amdgcn_readfirstlane(tid >> 6);
    const int gw = blockIdx.x * 8 + wid, ngw = gridDim.x * 8;
    LAS unsigned char* ldsl = (LAS unsigned char*)lds;
    PHASE(P0 + 0) {
        float* scr = (float*)(lds + wid * 8704);
        for (int rep = 0; rep < ((DUP & 16) ? 2 : 1); ++rep) {
        const float* modl = WSP(float, WS_MOD) + (size_t)L * 9 * 6144;
        phase_prenorm(L == 0 ? a.in[0] : a.out, L == 0 ? a.in[2] : WSP(float, WS_ZF), a.in[6] + L * 1024, modl, 0, WSP(bf16_t, WS_H2), kind == 2 ? 2048 : 1024, kind == 2, MT, gw, ngw, lane);
        bf16_t* Wmix = WSP(bf16_t, W_MIX); bf16_t* Wo = WSP(bf16_t, W_O);
        conv_job(a.in[8] + (size_t)L * 1024 * 4096, 4096, 1024, 4096, 1024, 4096, nullptr, 0, WSP(bf16_t, W_1), 1024, 0, 0, scr, gw, ngw, lane);
        conv_job(a.in[9] + (size_t)L * 4096 * 1024, 1024, 4096, 1024, 4096, 1024, nullptr, 0, WSP(bf16_t, W_2), 4096, 0, 0, scr, gw, ngw, lane);
        if (kind == 0) {
            conv_job(a.in[11] + (size_t)jj * 1024 * 3072, 3072, 1024, 3072, 1024, 3072, nullptr, 0, Wmix, 1024, 0, 0, scr, gw, ngw, lane);
            conv_job(a.in[12] + (size_t)jj * 1024 * 1024, 1024, 1024, 1024, 1024, 1024, nullptr, 0, Wo, 1024, 0, 0, scr, gw, ngw, lane);
        } else if (kind == 1) {
            conv_job(a.in[14], 3104, 1024, 3104, 1024, 3328, nullptr, 0, Wmix, 1024, 0, 0, scr, gw, ngw, lane);
            conv_job(a.in[18], 1024, 1024, 1024, 1024, 1024, nullptr, 0, Wo, 1024, 0, 0, scr, gw, ngw, lane);
        } else {
            const float* mix = a.in[19];
            for (int md = 1; md <= 2; ++md) {
                const int co = (md - 1) * 1024;
                for (int q = 0; q < 3; ++q) conv_job(a.in[20] + (size_t)q * 1024 * 1024, 1024, 1024, 1024, 1024, 1024, mix + (q == 0 ? 0 : q + 1) * 1024, md, Wmix, 2048, q * 1024, co, scr, gw, ngw, lane);
                conv_job(a.in[27], 160, 1024, 160, 1024, 256, mix + 5 * 1024, md, Wmix, 2048, 3072, co, scr, gw, ngw, lane);
                for (int q = 0; q < 2; ++q) conv_job(a.in[22] + (size_t)q * 1024 * 64, 64, 1024, 64, 1024, 64, mix + 1 * 1024, md, Wmix, 2048, 3328 + 64 * q, co, scr, gw, ngw, lane);
                for (int q = 0; q < 2; ++q) conv_job(a.in[25] + (size_t)q * 1024 * 64, 64, 1024, 64, 1024, 64, mix + 4 * 1024, md, Wmix, 2048, 3456 + 64 * q, co, scr, gw, ngw, lane);
            }
            conv_job(a.in[28], 1024, 160, 1024, 256, 1024, nullptr, 0, WSP(bf16_t, W_G2), 256, 0, 0, scr, gw, ngw, lane);
            conv_job(a.in[34], 1024, 1024, 1024, 1024, 1024, nullptr, 0, Wo, 1024, 0, 0, scr, gw, ngw, lane);
        }
        }
        SEAM(P0 + 0);
    }
    PHASE(P0 + 1) {
        bf16_t* BIG = WSP(bf16_t, WS_BIG);
        for (int rep = 0; rep < ((DUP & 8) ? 2 : 1); ++rep) {
        if (kind == 0) run_gemm(ldsl, WSP(bf16_t, WS_H2), WSP(bf16_t, W_MIX), MT, 3072, 1024, InNaQkv{BIG, BIG + (size_t)MT * 2048, BIG + (size_t)MT * 2048 + (size_t)ML * 1024});
        else if (kind == 1) run_gemm(ldsl, WSP(bf16_t, WS_H2), WSP(bf16_t, W_MIX), MT, 3328, 1024, InGlaIn{BIG, WSP(float, WS_LR)});
        else run_gemm(ldsl, WSP(bf16_t, WS_H2), WSP(bf16_t, W_MIX), MT, 3584, 2048, InRwL1{BIG, BIG + (size_t)MT * 3072, BIG + (size_t)MT * 3328});
        }
        SEAM(P0 + 1);
    }
    PHASE(P0 + 2) {
        bf16_t* BIG = WSP(bf16_t, WS_BIG); bf16_t* H2 = WSP(bf16_t, WS_H2);
        if (kind == 0) {
            const bf16_t* VTL = BIG + (size_t)MT * 2048; const bf16_t* VTC = VTL + (size_t)ML * 1024;
            const float* rpb = a.in[13] + (size_t)jj * 16 * 15 * 31;
            const int nu = 8192 + (need_ctx ? 512 : 0);
#ifndef NO_ATTN
            float* tbl = (float*)(lds + wid * 7680);
            int tbl_hd = -1;
            for (int rep = 0; rep < ((DUP & 1) ? 2 : 1); ++rep)
            for (int u = gw; u < nu; u += ngw) {
                if (u < 8192) {
                    const int hd_ = (u >> 6) & 15;
                    if (hd_ != tbl_hd) {
                        for (int e = lane; e < 465; e += 64) { const int rr = e / 31, cc = e - rr * 31; tbl[rr * 128 + 48 + cc] = rpb[hd_ * 465 + e]; }
                        tbl_hd = hd_;
                    }
                    attn_unit(BIG, VTL, VTC, H2, tbl, u >> 10, hd_, u & 63, 0, lane);
                }
                else { const int v = u - 8192; attn_unit(BIG, VTL, VTC, H2, tbl, v >> 6, (v >> 2) & 15, -1, v & 3, lane); }
            }
#endif
        } else if (kind == 1) {
#ifndef NO_GLA
            for (int rep = 0; rep < ((DUP & 2) ? 2 : 1); ++rep)
            for (int u = blockIdx.x; u < 256; u += gridDim.x) gla_unit(BIG, WSP(float, WS_LR), a.in[15], a.in[16], H2, lds, u, tid);
#endif
        } else {
#ifndef NO_RWKV
            for (int rep = 0; rep < ((DUP & 4) ? 2 : 1); ++rep)
            for (int u = blockIdx.x; u < 256; u += gridDim.x) rwkv_unit(a, BIG, BIG + (size_t)MT * 3328, H2, WSP(float, WS_RK), lds, u, tid);
#endif
            run_gemm(ldsl, BIG + (size_t)MT * 3072, WSP(bf16_t, W_G2), MT, 1024, 256, InStore<0>{WSP(bf16_t, WS_G), 1024});
        }
        SEAM(P0 + 2);
    }
    if (kind != 0) {
        PHASE(P0 + 3) {
            bf16_t* H2 = WSP(bf16_t, WS_H2);
            if (kind == 1) gla_finish(H2, H2 + (size_t)MT * 1024, WSP(bf16_t, WS_BIG), a.in[17], Mact, gw, ngw, lane);
            else rwkv_finish(H2, H2 + (size_t)MT * 1024, WSP(bf16_t, WS_BIG), WSP(bf16_t, WS_G), WSP(float, WS_RK), a.in[32], a.in[33], Mact, gw, ngw, lane);
            SEAM(P0 + 3);
        }
    }
    PHASE(P0 + 4) {
        if (DUP & 32) run_gemm(ldsl, WSP(bf16_t, WS_H2), WSP(bf16_t, W_O), Mact, 1024, 1024, InResid{L == 0 ? a.in[0] : a.out, L == 0 ? a.in[2] : WSP(float, WS_ZF), WSP(float, WS_BIG), WSP(float, WS_BIG) + (size_t)ML * 1024, WSP(float, WS_MOD) + (size_t)L * 9 * 6144 + 2 * 1024});
        run_gemm(ldsl, WSP(bf16_t, WS_H2), WSP(bf16_t, W_O), Mact, 1024, 1024, InResid{L == 0 ? a.in[0] : a.out, L == 0 ? a.in[2] : WSP(float, WS_ZF), a.out, WSP(float, WS_ZF), WSP(float, WS_MOD) + (size_t)L * 9 * 6144 + 2 * 1024});
        SEAM(P0 + 4);
    }
    PHASE(P0 + 5) {
        for (int rep = 0; rep < ((DUP & 16) ? 2 : 1); ++rep)
        phase_prenorm(a.out, WSP(float, WS_ZF), a.in[7] + L * 1024, WSP(float, WS_MOD) + (size_t)L * 9 * 6144, 3, WSP(bf16_t, WS_H2), 1024, false, Mact, gw, ngw, lane);
        SEAM(P0 + 5);
    }
    PHASE(P0 + 6) {
        for (int rep = 0; rep < ((DUP & 8) ? 2 : 1); ++rep)
        run_gemm(ldsl, WSP(bf16_t, WS_H2), WSP(bf16_t, W_1), Mact, 4096, 1024, InStore<1>{WSP(bf16_t, WS_BIG), 4096});
        SEAM(P0 + 6);
    }
    PHASE(P0 + 7) {
        if (DUP & 32) run_gemm(ldsl, WSP(bf16_t, WS_BIG), WSP(bf16_t, W_2), Mact, 1024, 4096, InResid{a.out, WSP(float, WS_ZF), WSP(float, WS_H2), WSP(float, WS_H2) + (size_t)ML * 1024, WSP(float, WS_MOD) + (size_t)L * 9 * 6144 + 5 * 1024});
        run_gemm(ldsl, WSP(bf16_t, WS_BIG), WSP(bf16_t, W_2), Mact, 1024, 4096, InResid{a.out, WSP(float, WS_ZF), a.out, WSP(float, WS_ZF), WSP(float, WS_MOD) + (size_t)L * 9 * 6144 + 5 * 1024});
        SEAM(P0 + 7);
    }
}
__global__ void __launch_bounds__(NTHREADS, 2) mega(Args a) {
    extern __shared__ __attribute__((aligned(16))) unsigned char lds[];
    cg::grid_group grid = cg::this_grid();
    const int lo = a.lo, hi = a.hi;
    volatile LAS unsigned* xst = (volatile LAS unsigned*)((LAS unsigned char*)lds + (LDS_BYTES - 64));
    if (threadIdx.x < 2) xst[threadIdx.x] = 0u;
    __syncthreads();
    const XcdBarrier xbar = xcd_barrier_post((unsigned*)(a.ws + WS_BAR), xst);
    PHASE(0) { phase_mod(a, (float*)lds, threadIdx.x); if (1 < hi) grid.sync(); }
    run_layer<0>(a, lds, xbar, lo, hi);
    run_layer<1>(a, lds, xbar, lo, hi);
    run_layer<2>(a, lds, xbar, lo, hi);
    run_layer<3>(a, lds, xbar, lo, hi);
    PHASE(33) {
        const int tid = threadIdx.x, lane = tid & 63, wid = tid >> 6;
        const int gw = blockIdx.x * 8 + wid, ngw = gridDim.x * 8;
        const float* fg = a.in[10];
        for (int st = gw; st < ML / 4; st += ngw) {
            f32x4 v[4][4]; float ss[4];
#pragma unroll
            for (int r = 0; r < 4; ++r) { const float* xr = a.out + (size_t)(4 * st + r) * 1024;
#pragma unroll
                for (int j = 0; j < 4; ++j) v[r][j] = *(const f32x4*)(xr + 4 * lane + 256 * j); }
#pragma unroll
            for (int r = 0; r < 4; ++r) { float s = 0.f;
#pragma unroll
                for (int j = 0; j < 4; ++j) s += (v[r][j].x * v[r][j].x + v[r][j].y * v[r][j].y) + (v[r][j].z * v[r][j].z + v[r][j].w * v[r][j].w);
                ss[r] = s; }
#pragma unroll
            for (int o = 1; o < 64; o <<= 1) {
#pragma unroll
                for (int r = 0; r < 4; ++r) ss[r] += __shfl_xor(ss[r], o);
            }
#pragma unroll
            for (int r = 0; r < 4; ++r) { const float rinv = rsqrtf(ss[r] * (1.f / 1024.f) + 1e-6f); float* xr = a.out + (size_t)(4 * st + r) * 1024;
#pragma unroll
                for (int j = 0; j < 4; ++j) *(f32x4*)(xr + 4 * lane + 256 * j) = v[r][j] * rinv * *(const f32x4*)(fg + 4 * lane + 256 * j); }
        }
    }
}

#ifndef GM
#define GM 0xffff
#endif
#ifndef MULTI_LAUNCH
#define MULTI_LAUNCH 0
#endif
extern "C" void kernel_launch(void* const* d_in, const int* in_sizes, int n_in, void* d_out, int out_size, void* d_ws, size_t ws_size, hipStream_t stream) {
    static int grid_blocks = 0;
    if (!grid_blocks) {
        int dev = 0, cus = 0, per_cu = 0;
        hipGetDevice(&dev);
        hipDeviceGetAttribute(&cus, hipDeviceAttributeMultiprocessorCount, dev);
        hipFuncSetAttribute((const void*)mega, hipFuncAttributeMaxDynamicSharedMemorySize, LDS_BYTES);
        hipOccupancyMaxActiveBlocksPerMultiprocessor(&per_cu, (const void*)mega, NTHREADS, LDS_BYTES);
        if (per_cu < 1) per_cu = 1;
        grid_blocks = cus * per_cu;
    }
    (void)hipMemsetAsync((char*)d_ws + WS_BAR, 0, XCD_BAR_WORDS * 4, stream);
    Args a{};
    for (int i = 0; i < 35; ++i) a.in[i] = (const float*)d_in[i];
    a.out = (float*)d_out; a.ws = (unsigned char*)d_ws;
#if MULTI_LAUNCH
    for (int p = 0; p < 34; ++p) { a.lo = p; a.hi = p + 1; hipLaunchKernelGGL(mega, dim3(grid_blocks), dim3(NTHREADS), LDS_BYTES, stream, a); }
#else
    a.lo = 0; a.hi = 34;
    void* args[] = {&a};
    hipError_t e = hipLaunchCooperativeKernel((const void*)mega, dim3(grid_blocks), dim3(NTHREADS), args, LDS_BYTES, stream);
    if (e != hipSuccess) fprintf(stderr, "cooperative launch failed: %s (grid %d)\n", hipGetErrorString(e), grid_blocks);
#endif
}
```

```cpp
#include <hip/hip_runtime.h>
#include <hip/hip_cooperative_groups.h>
#include <cstdio>
#include <cstdint>
namespace cg = cooperative_groups;

namespace pg8 {
#define PG8_LAS __attribute__((address_space(3)))
typedef unsigned short bf16_t;
typedef short bf16x8 __attribute__((ext_vector_type(8)));
typedef float f32x4 __attribute__((ext_vector_type(4)));
typedef unsigned u32x4 __attribute__((ext_vector_type(4)));
constexpr int BM = 256, BK = 64, HALF = 128, HTB = HALF * BK * 2  , STAGE_BYTES = 8 * HTB, NXCD = 8, WGM = 8;

__host__ __device__ __forceinline__ int lds_byte(int r, int c) { const int st = (r >> 4) * 2 + (c >> 5), rr = r & 15, cc = c & 31, ob = rr * 64 + cc * 2; return st * 1024 + (ob ^ (((ob >> 9) & 1) << 5)); }
__host__ __device__ __forceinline__ void stage_rc(int b, int& R, int& C) { const int st = b / 1024, sb = b % 1024, swz = sb ^ (((sb >> 9) & 1) << 5); R = (st >> 1) * 16 + swz / 64; C = (st & 1) * 32 + (swz % 64) / 2; }
__host__ __device__ __forceinline__ int perm32(int rho) { const int n = rho >> 4, i = rho & 15; return 8 * (i >> 2) + 4 * n + (i & 3); }

struct Unit { int pm, pn; };
struct Gemm { const bf16_t* A; const bf16_t* Bt; int M, N, K; };

struct StaticOrder {
    int nM, nN, nwg, G, c;
    __host__ __device__ void init(int M, int N, int G_, int c_) { nM = M / BM; nN = N / BM; nwg = nM * nN; G = G_; c = c_; }
    __host__ __device__ bool next(int i, Unit& u) const {
        const long L = (long)i * G + c; if (L >= nwg) return false;
        int wgid = (int)L; { const int q = nwg / NXCD, r = nwg % NXCD, xcd = wgid % NXCD, off = wgid / NXCD; wgid = (xcd < r ? xcd * (q + 1) : r * (q + 1) + (xcd - r) * q) + off; }
        const int nig = WGM * nN, gid = wgid / nig, fm = gid * WGM, gsz = (nM - fm) < WGM ? (nM - fm) : WGM;
        u.pm = fm + ((wgid % nig) % gsz); u.pn = (wgid % nig) / gsz; return true;
    }
    __device__ __forceinline__ void a_ready(const Unit&) const {}
    __device__ __forceinline__ void done(const Unit&) const {}
};

__device__ __forceinline__ unsigned cvt_pk_bf16(float lo, float hi) { unsigned r; asm volatile("v_cvt_pk_bf16_f32 %0, %1, %2" : "=v"(r) : "v"(lo), "v"(hi)); return r; }
template <class Epi, class Sched, bool ALIGN_EPI = false, bool SP2 = false>
__device__ __forceinline__ void gemm_phase(PG8_LAS unsigned char* lds, const Gemm g, const Sched& S, const Epi& E) {
    const int tid = threadIdx.x, wid = __builtin_amdgcn_readfirstlane(tid >> 6), lane = tid & 63, wr = wid >> 2, wc = wid & 3, fr = lane & 15, fq = lane >> 4;
    const int K = g.K, nt = K / BK;
    unsigned voffA[2], voffB[2];
#pragma unroll
    for (int i = 0; i < 2; ++i) { int R, C; stage_rc(tid * 16 + i * 8192, R, C); const int Rb = Epi::PERM ? ((R & ~31) + perm32(R & 31)) : R;
        voffA[i] = (unsigned)(R * K + C) * 2u; voffB[i] = (unsigned)(Rb * K + C) * 2u; }
    const size_t kstep = (size_t)(BK * 2);
    const size_t hstep = (size_t)HALF * K * 2;
    const size_t tstep = 2 * hstep;
    const unsigned ldsw = (unsigned)wid * 1024u;
    const int aoff = lds_byte(wr * 64 + fr, fq * 8), boff = lds_byte(wc * 32 + fr, fq * 8);
#define PG8_SA(b, h) (((b) * 2 + (h)) * HTB)
#define PG8_SB(b, h) ((4 + (b) * 2 + (h)) * HTB)
#define PG8_STAGE(bufoff, gbase, voff) do { _Pragma("unroll") for (int _i = 0; _i < 2; ++_i) \
        __builtin_amdgcn_global_load_lds((const unsigned*)((const char*)(gbase) + (voff)[_i]), (PG8_LAS unsigned*)(lds + (bufoff) + ldsw + _i * 8192), 16, 0, 0); } while (0)
#define PG8_LDA(dst, b, h) do { _Pragma("unroll") for (int m = 0; m < 4; ++m) _Pragma("unroll") for (int k = 0; k < 2; ++k) dst[m][k] = *(const PG8_LAS bf16x8*)(lds + PG8_SA(b, h) + aoff + m * 2048 + k * 1024); } while (0)
#define PG8_LDB(dst, b, h) do { _Pragma("unroll") for (int n = 0; n < 2; ++n) _Pragma("unroll") for (int k = 0; k < 2; ++k) dst[n][k] = *(const PG8_LAS bf16x8*)(lds + PG8_SB(b, h) + boff + n * 2048 + k * 1024); } while (0)
#define PG8_MMA(ai, bj, At, Bt) do { __builtin_amdgcn_s_setprio(1); _Pragma("unroll") for (int m = 0; m < 4; ++m) _Pragma("unroll") for (int n = 0; n < 2; ++n) _Pragma("unroll") for (int k = 0; k < 2; ++k) \
        acc[ai][bj][m][n] = __builtin_amdgcn_mfma_f32_16x16x32_bf16(Bt[n][k], At[m][k], acc[ai][bj][m][n], 0, 0, 0); __builtin_amdgcn_s_setprio(0); } while (0)
#define PG8_WAIT_V(n) asm volatile("s_waitcnt vmcnt(" #n ")" ::: "memory")
#define PG8_WAIT_L(n) asm volatile("s_waitcnt lgkmcnt(" #n ")" ::: "memory")
#define PG8_BAR __builtin_amdgcn_s_barrier()
#define PG8_SCHED __builtin_amdgcn_sched_barrier(0)
    Unit cur, nxt; int ui = 0;
    if (!S.next(0, cur)) return;
    f32x4 acc[2][2][4][2];
#pragma unroll
    for (int a = 0; a < 2; ++a)
#pragma unroll
        for (int b = 0; b < 2; ++b)
#pragma unroll
            for (int m = 0; m < 4; ++m)
#pragma unroll
                for (int n = 0; n < 2; ++n) acc[a][b][m][n] = (f32x4){0.f, 0.f, 0.f, 0.f};
    bf16x8 At[4][2], B0[2][2], B1[2][2];
    const char* cA = (const char*)g.A + (size_t)cur.pm * tstep; const char* cB = (const char*)g.Bt + (size_t)cur.pn * tstep;
    S.a_ready(cur);
    if constexpr (SP2) {
        PG8_STAGE(PG8_SB(0, 0), cB, voffB); PG8_STAGE(PG8_SB(0, 1), cB + hstep, voffB); PG8_STAGE(PG8_SA(0, 0), cA, voffA); PG8_STAGE(PG8_SA(0, 1), cA + hstep, voffA);
        if (wr == 1) PG8_BAR;
        PG8_WAIT_V(2); PG8_BAR;
        PG8_STAGE(PG8_SB(1, 0), cB + kstep, voffB); PG8_STAGE(PG8_SA(1, 0), cA + kstep, voffA); PG8_STAGE(PG8_SB(1, 1), cB + hstep + kstep, voffB);
        PG8_WAIT_V(6); PG8_BAR;
    } else {
        PG8_STAGE(PG8_SB(0, 0), cB, voffB); PG8_STAGE(PG8_SA(0, 0), cA, voffA); PG8_STAGE(PG8_SB(0, 1), cB + hstep, voffB); PG8_STAGE(PG8_SA(0, 1), cA + hstep, voffA);
        if (wr == 1) PG8_BAR;
        PG8_WAIT_V(4); PG8_BAR;
        PG8_STAGE(PG8_SB(1, 0), cB + kstep, voffB); PG8_STAGE(PG8_SA(1, 0), cA + kstep, voffA); PG8_STAGE(PG8_SB(1, 1), cB + hstep + kstep, voffB);
        PG8_WAIT_V(6); PG8_BAR;
    }
    for (;;) {
        const bool has_next = S.next(ui + 1, nxt);
        const char* nA = has_next ? (const char*)g.A + (size_t)nxt.pm * tstep : cA; const char* nB = has_next ? (const char*)g.Bt + (size_t)nxt.pn * tstep : cB;
        for (int t = 0; t < nt; t += 2) {
            const bool last = (t == nt - 2);
            const char* a1 = cA + (size_t)(t + 1) * kstep;
            const char* a2 = last ? nA : cA + (size_t)(t + 2) * kstep; const char* b2 = last ? nB : cB + (size_t)(t + 2) * kstep;
            const char* a3 = a2 + kstep; const char* b3 = b2 + kstep;
            if (last && has_next) S.a_ready(nxt);
            if constexpr (SP2) {
            PG8_LDB(B0, 0, 0); PG8_LDB(B1, 0, 1); PG8_SCHED; PG8_LDA(At, 0, 0); PG8_STAGE(PG8_SA(1, 1), a1 + hstep, voffA);
            PG8_WAIT_V(8); PG8_WAIT_L(0); PG8_BAR; PG8_MMA(0, 0, At, B0); PG8_MMA(0, 1, At, B1); PG8_BAR; PG8_SCHED;
            PG8_LDA(At, 0, 1); PG8_STAGE(PG8_SB(0, 0), b2, voffB); PG8_STAGE(PG8_SB(0, 1), b2 + hstep, voffB); PG8_STAGE(PG8_SA(0, 0), a2, voffA);
            PG8_WAIT_V(8); PG8_WAIT_L(0); PG8_BAR; PG8_MMA(1, 0, At, B0); PG8_MMA(1, 1, At, B1); PG8_BAR; PG8_SCHED;
            PG8_LDB(B0, 1, 0); PG8_LDB(B1, 1, 1); PG8_SCHED; PG8_LDA(At, 1, 0); PG8_STAGE(PG8_SA(0, 1), a2 + hstep, voffA);
            PG8_WAIT_V(8); PG8_WAIT_L(0); PG8_BAR; PG8_MMA(0, 0, At, B0); PG8_MMA(0, 1, At, B1); PG8_BAR; PG8_SCHED;
            PG8_LDA(At, 1, 1); PG8_STAGE(PG8_SB(1, 0), b3, voffB); PG8_STAGE(PG8_SB(1, 1), b3 + hstep, voffB); PG8_STAGE(PG8_SA(1, 0), a3, voffA);
            PG8_WAIT_V(8); PG8_WAIT_L(0); PG8_BAR; PG8_MMA(1, 0, At, B0); PG8_MMA(1, 1, At, B1); PG8_BAR; PG8_SCHED;
            } else {
            PG8_LDB(B0, 0, 0); PG8_SCHED; PG8_LDA(At, 0, 0); PG8_STAGE(PG8_SA(1, 1), a1 + hstep, voffA);
            PG8_WAIT_L(8); PG8_BAR; PG8_WAIT_L(0); PG8_MMA(0, 0, At, B0); PG8_BAR; PG8_SCHED;
            PG8_LDB(B1, 0, 1); PG8_STAGE(PG8_SB(0, 0), b2, voffB);
            PG8_BAR; PG8_WAIT_L(0); PG8_MMA(0, 1, At, B1); PG8_BAR;
            PG8_LDA(At, 0, 1); PG8_STAGE(PG8_SA(0, 0), a2, voffA);
            PG8_BAR; PG8_WAIT_L(0); PG8_MMA(1, 0, At, B0); PG8_BAR; PG8_SCHED;
            PG8_STAGE(PG8_SB(0, 1), b2 + hstep, voffB);
            PG8_WAIT_V(6); PG8_BAR; PG8_MMA(1, 1, At, B1); PG8_BAR;
            PG8_LDB(B0, 1, 0); PG8_SCHED; PG8_LDA(At, 1, 0); PG8_STAGE(PG8_SA(0, 1), a2 + hstep, voffA);
            PG8_WAIT_L(8); PG8_BAR; PG8_WAIT_L(0); PG8_MMA(0, 0, At, B0); PG8_BAR; PG8_SCHED;
            PG8_LDB(B1, 1, 1); PG8_STAGE(PG8_SB(1, 0), b3, voffB);
            PG8_BAR; PG8_WAIT_L(0); PG8_MMA(0, 1, At, B1); PG8_BAR;
            PG8_LDA(At, 1, 1); PG8_STAGE(PG8_SA(1, 0), a3, voffA);
            PG8_BAR; PG8_WAIT_L(0); PG8_MMA(1, 0, At, B0); PG8_BAR; PG8_SCHED;
            PG8_STAGE(PG8_SB(1, 1), b3 + hstep, voffB);
            PG8_WAIT_V(6); PG8_BAR; PG8_MMA(1, 1, At, B1); PG8_BAR;
            }
        }
        if constexpr (ALIGN_EPI) { if (wr == 0) PG8_BAR; }
        if constexpr (!Epi::AFTER_DRAIN) { E(acc, cur, wr, wc, fr, fq); S.done(cur); }
        if (!has_next) break;
#pragma unroll
        for (int a = 0; a < 2; ++a)
#pragma unroll
            for (int b = 0; b < 2; ++b)
#pragma unroll
                for (int m = 0; m < 4; ++m)
#pragma unroll
                    for (int n = 0; n < 2; ++n) acc[a][b][m][n] = (f32x4){0.f, 0.f, 0.f, 0.f};
        cur = nxt; cA = nA; cB = nB; ++ui;
        if constexpr (ALIGN_EPI) { if (wr == 1) PG8_BAR; }
    }
    PG8_WAIT_V(0);
    if constexpr (!ALIGN_EPI) { if (wr == 0) PG8_BAR; }
    PG8_BAR;
    if constexpr (Epi::AFTER_DRAIN) { E.fused(acc, cur, wr, wc, fr, fq, lds, wid, lane); S.done(cur); }
#undef PG8_SA
#undef PG8_SB
#undef PG8_STAGE
#undef PG8_LDA
#undef PG8_LDB
#undef PG8_MMA
#undef PG8_WAIT_V
#undef PG8_WAIT_L
#undef PG8_BAR
#undef PG8_SCHED
}
}

#ifndef DUP
#define DUP 0
#endif
#define DI __device__ __forceinline__
#define LAS __attribute__((address_space(3)))
typedef unsigned short bf16_t;
typedef short bf16x8 __attribute__((ext_vector_type(8)));
typedef float f32x4 __attribute__((ext_vector_type(4)));
typedef float f32x16 __attribute__((ext_vector_type(16)));
typedef unsigned u32x4 __attribute__((ext_vector_type(4)));
typedef unsigned u32x2 __attribute__((ext_vector_type(2)));
typedef float f32x2_t __attribute__((ext_vector_type(2)));
typedef __bf16 bf16x2_t __attribute__((ext_vector_type(2)));

constexpr int D = 1024, NB = 8, SEQ = 4096, CTX = 256, FF = 4096;
constexpr int ML = NB * SEQ, MC = NB * CTX, MT = ML + MC;
constexpr size_t MiB = 1u << 20;
constexpr size_t WS_MOD = 0, WS_ZF = 1 * MiB, WS_RK = 9 * MiB, WS_LR = 14 * MiB, WS_W = 20 * MiB, WS_H2 = 56 * MiB, WS_BIG = 192 * MiB, WS_G = 430 * MiB;
constexpr size_t W_MIX = WS_W, W_O = WS_W + 14 * MiB, W_G2 = WS_W + 16 * MiB, W_1 = WS_W + 17 * MiB, W_2 = WS_W + 25 * MiB;
constexpr int LDS_BYTES = 147456;
constexpr size_t WS_BAR = 983040;
constexpr int NTHREADS = 512;

struct Args { const float* in[35]; float* out; unsigned char* ws; int lo, hi; };

DI float bf2f(bf16_t v) { return __uint_as_float(((unsigned)v) << 16); }
DI unsigned cvtpk(float lo, float hi) { f32x2_t v = {lo, hi}; bf16x2_t b = __builtin_convertvector(v, bf16x2_t); return __builtin_bit_cast(unsigned, b); }
DI bf16_t f2bf(float x) { return (bf16_t)(cvtpk(x, 0.f) & 0xffffu); }
DI float wave_sum(float v) {
#pragma unroll
    for (int o = 1; o < 64; o <<= 1) v += __shfl_xor(v, o);
    return v;
}
DI float sigmoidf_(float x) { return 1.f / (1.f + __expf(-x)); }
DI float softplusf_(float x) { return fmaxf(x, 0.f) + log1pf(__expf(-fabsf(x))); }
DI int crow(int i, int h) { return (i & 3) + 8 * (i >> 2) + 4 * h; }
#define MFMA32(a, b, c) __builtin_amdgcn_mfma_f32_32x32x16_bf16((a), (b), (c), 0, 0, 0)

DI void mma_tile(f32x16& acc, const bf16_t* A, int lda, const bf16_t* Bt, int ldb, int ksteps, int lane) {
    const int rho = lane & 31, h = lane >> 5;
    const bf16_t* ap = A + rho * lda + 8 * h; const bf16_t* bp = Bt + rho * ldb + 8 * h;
    for (int s = 0; s < ksteps; ++s) {
        bf16x8 av = *(const bf16x8*)(ap + 16 * s); bf16x8 bv = *(const bf16x8*)(bp + 16 * s);
        acc = MFMA32(av, bv, acc);
    }
}

template <class Inner> struct Epi {
    static constexpr bool PERM = true, AFTER_DRAIN = false;
    Inner in;
    DI void operator()(const pg8::f32x4 (&acc)[2][2][4][2], const pg8::Unit& u, int wr, int wc, int fr, int fq) const {
        const int row0 = u.pm * 256 + wr * 64 + fr, col0 = u.pn * 256 + wc * 32 + 8 * fq;
#pragma unroll
        for (int ai = 0; ai < 2; ++ai)
#pragma unroll
            for (int m = 0; m < 4; ++m) {
                const int row = row0 + ai * 128 + m * 16;
#pragma unroll
                for (int bj = 0; bj < 2; ++bj) in.store8(row, col0 + bj * 128, acc[ai][bj][m][0], acc[ai][bj][m][1]);
            }
    }
};
DI u32x4 pack8(f32x4 a, f32x4 b) { u32x4 w; w.x = cvtpk(a[0], a[1]); w.y = cvtpk(a[2], a[3]); w.z = cvtpk(b[0], b[1]); w.w = cvtpk(b[2], b[3]); return w; }

template <int ACT> struct InStore {
    bf16_t* O; int ldc;
    DI void store8(int row, int col, f32x4 a, f32x4 b) const {
        if (ACT == 1) {
#pragma unroll
            for (int j = 0; j < 4; ++j) { float x = fmaxf(a[j], 0.f); a[j] = x * x; float y = fmaxf(b[j], 0.f); b[j] = y * y; }
        }
        *(u32x4*)(O + (size_t)row * ldc + col) = pack8(a, b);
    }
};
struct InNaQkv {
    bf16_t* QK; bf16_t* VTL; bf16_t* VTC;
    DI void store8(int row, int col, f32x4 a, f32x4 b) const {
        if (col < 2048) {
            const float sc = col < 1024 ? 0.18033688011112042f : 1.f;
            *(u32x4*)(QK + (size_t)row * 2048 + col) = pack8(a * sc, b * sc);
        } else {
            const int c = col - 2048, hd = c >> 6, d0 = c & 63;
            bf16_t* p; size_t ld;
            if (row < ML) { const int b_ = row >> 12, t = row & 4095; p = VTL + ((size_t)((b_ * 16 + hd) * 64 + d0)) * 4096 + t; ld = 4096; }
            else { const int r2 = row - ML, b_ = r2 >> 8, t = r2 & 255; p = VTC + ((size_t)((b_ * 16 + hd) * 64 + d0)) * 256 + t; ld = 256; }
#pragma unroll
            for (int j = 0; j < 4; ++j) { p[(size_t)j * ld] = f2bf(a[j]); p[(size_t)(j + 4) * ld] = f2bf(b[j]); }
        }
    }
};
struct InResid {
    const float* sl; const float* sc; float* dl; float* dc; const float* gate;
    DI void store8(int row, int col, f32x4 a, f32x4 b) const {
        const float* s; float* d; int mi;
        if (row < ML) { s = sl + (size_t)row * 1024 + col; d = dl + (size_t)row * 1024 + col; mi = row >> 12; }
        else { s = sc + (size_t)(row - ML) * 1024 + col; d = dc + (size_t)(row - ML) * 1024 + col; mi = 8; }
        const float* g = gate + (size_t)mi * 6144 + col;
        const f32x4 g0 = *(const f32x4*)g, g1 = *(const f32x4*)(g + 4);
        const f32x4 x0 = *(const f32x4*)s, x1 = *(const f32x4*)(s + 4);
        *(f32x4*)d = x0 + g0 * a; *(f32x4*)(d + 4) = x1 + g1 * b;
    }
};
struct InGlaIn {
    bf16_t* P; float* LR;
    DI void store8(int row, int col, f32x4 a, f32x4 b) const {
        if (col < 3072) {
            const float sc = col < 512 ? 0.08838834764831845f : 1.f;
            *(u32x4*)(P + (size_t)row * 3072 + col) = pack8(a * sc, b * sc);
        } else if (col < 3104) {
            float* p = LR + (size_t)row * 32 + (col - 3072);
            *(f32x4*)p = a; *(f32x4*)(p + 4) = b;
        }
    }
};
struct InRwL1 {
    bf16_t* RKV; bf16_t* SG; bf16_t* TWAA;
    DI void store8(int row, int col, f32x4 a, f32x4 b) const {
        if (col < 3072) { *(u32x4*)(RKV + (size_t)row * 3072 + col) = pack8(a, b); }
        else if (col < 3328) {
#pragma unroll
            for (int j = 0; j < 4; ++j) { a[j] = sigmoidf_(a[j]); b[j] = sigmoidf_(b[j]); }
            *(u32x4*)(SG + (size_t)row * 256 + (col - 3072)) = pack8(a, b);
        } else {
            const int c = col - 3328;
            if (c < 128) {
#pragma unroll
                for (int j = 0; j < 4; ++j) { a[j] = tanhf(a[j]); b[j] = tanhf(b[j]); }
            }
            *(u32x4*)(TWAA + (size_t)row * 256 + c) = pack8(a, b);
        }
    }
};

template <class Inner> DI void run_gemm(LAS unsigned char* lds, const bf16_t* A, const bf16_t* Bt, int M, int N, int K, const Inner& in) {
    int Kr = K; asm volatile("" : "+s"(Kr));
    pg8::Gemm g{A, Bt, M, N, Kr}; pg8::StaticOrder S; S.init(M, N, (int)gridDim.x, (int)blockIdx.x);
    Epi<Inner> E{in};
#ifndef NO_GEMM
    pg8::gemm_phase<Epi<Inner>, pg8::StaticOrder, true, true>(lds, g, S, E);
#endif
    __syncthreads();
}

DI void conv_item(const float* W, int ldw, int Kv, int Nv, const float* mix, int mode, bf16_t* WT, int ldt, int row_off, int col_off, float* scr, int kb, int nb, int lane) {
    const int k0 = 64 * kb, n0 = 32 * nb;
#pragma unroll 8
    for (int i = 0; i < 32; ++i) {
        const int kk = 2 * i + (lane >> 5), k = k0 + kk, n = n0 + (lane & 31);
        float v = (k < Kv && n < Nv) ? W[(size_t)k * ldw + n] : 0.f;
        if (mode) { const float m = (k < Kv) ? mix[k] : 0.f; v *= (mode == 1) ? (1.f - m) : m; }
        scr[kk * 33 + (lane & 31)] = v;
    }
    __builtin_amdgcn_s_waitcnt(0xc07f); __builtin_amdgcn_wave_barrier();
    const int c = lane & 7;
#pragma unroll
    for (int j = 0; j < 4; ++j) {
        const int n = (lane >> 3) + 8 * j; const float* s = scr + (8 * c) * 33 + n;
        u32x4 o; o.x = cvtpk(s[0 * 33], s[1 * 33]); o.y = cvtpk(s[2 * 33], s[3 * 33]); o.z = cvtpk(s[4 * 33], s[5 * 33]); o.w = cvtpk(s[6 * 33], s[7 * 33]);
        *(u32x4*)(WT + (size_t)(row_off + n0 + n) * ldt + col_off + k0 + 8 * c) = o;
    }
    __builtin_amdgcn_s_waitcnt(0xc07f); __builtin_amdgcn_wave_barrier();
}
DI void conv_job(const float* W, int ldw, int Kv, int Nv, int Kp, int Np, const float* mix, int mode, bf16_t* WT, int ldt, int row_off, int col_off, float* scr, int gw, int ngw, int lane) {
    const int nkb = Kp / 64, nnb = Np / 32, nit = nkb * nnb;
    for (int it = gw; it < nit; it += ngw) conv_item(W, ldw, Kv, Nv, mix, mode, WT, ldt, row_off, col_off, scr, it / nnb, it % nnb, lane);
}

DI void norm_row(const float* xr, const f32x4 (&gs)[4], const f32x4 (&sh)[4], int lane, f32x4 (&out)[4]) {
    f32x4 v[4]; float s = 0.f;
#pragma unroll
    for (int j = 0; j < 4; ++j) { v[j] = *(const f32x4*)(xr + 4 * lane + 256 * j); s += (v[j].x * v[j].x + v[j].y * v[j].y) + (v[j].z * v[j].z + v[j].w * v[j].w); }
    s = wave_sum(s);
    const float rinv = rsqrtf(s * (1.f / 1024.f) + 1e-6f);
#pragma unroll
    for (int j = 0; j < 4; ++j) out[j] = v[j] * rinv * gs[j] + sh[j];
}
DI void store_row_bf16(bf16_t* o, const f32x4 (&v)[4], int lane) {
#pragma unroll
    for (int j = 0; j < 4; ++j) { u32x2 w; w.x = cvtpk(v[j].x, v[j].y); w.y = cvtpk(v[j].z, v[j].w); *(u32x2*)(o + 4 * lane + 256 * j) = w; }
}
DI void phase_prenorm(const float* xl, const float* xc, const float* g, const float* modl  , int shift_chunk, bf16_t* H, int ldh, bool with_hs, int Mrows, int gw, int ngw, int lane) {
#define XROW(r) ((r) < ML ? xl + (size_t)(r) * 1024 : xc + (size_t)((r) - ML) * 1024)
    if (!with_hs) {
        const int nstrips = Mrows / 4;
        for (int st = gw; st < nstrips; st += ngw) {
            const int row0 = 4 * st;
            const int mi = row0 < ML ? row0 >> 12 : 8;
            const float* mp = modl + (size_t)mi * 6144 + shift_chunk * 1024;
            f32x4 v[4][4]; float ss[4];
#pragma unroll
            for (int r = 0; r < 4; ++r) { const float* xr = XROW(row0 + r);
#pragma unroll
                for (int j = 0; j < 4; ++j) v[r][j] = *(const f32x4*)(xr + 4 * lane + 256 * j); }
            f32x4 gs[4], sh[4];
#pragma unroll
            for (int j = 0; j < 4; ++j) { const int c = 4 * lane + 256 * j; sh[j] = *(const f32x4*)(mp + c); const f32x4 sc = *(const f32x4*)(mp + 1024 + c); gs[j] = *(const f32x4*)(g + c) * (sc + 1.f); }
#pragma unroll
            for (int r = 0; r < 4; ++r) { float s = 0.f;
#pragma unroll
                for (int j = 0; j < 4; ++j) s += (v[r][j].x * v[r][j].x + v[r][j].y * v[r][j].y) + (v[r][j].z * v[r][j].z + v[r][j].w * v[r][j].w);
                ss[r] = s; }
#pragma unroll
            for (int o = 1; o < 64; o <<= 1) {
#pragma unroll
                for (int r = 0; r < 4; ++r) ss[r] += __shfl_xor(ss[r], o);
            }
#pragma unroll
            for (int r = 0; r < 4; ++r) { const float rinv = rsqrtf(ss[r] * (1.f / 1024.f) + 1e-6f); f32x4 o[4];
#pragma unroll
                for (int j = 0; j < 4; ++j) o[j] = v[r][j] * rinv * gs[j] + sh[j];
                store_row_bf16(H + (size_t)(row0 + r) * ldh, o, lane); }
        }
    } else {
        const int nstrips = Mrows / 8;
        for (int st = gw; st < nstrips; st += ngw) {
            const int row0 = 8 * st;
            int mi, seg0, seg1;
            if (row0 < ML) { mi = row0 >> 12; seg0 = row0 & ~4095; seg1 = seg0 + 4096; } else { mi = 8; seg0 = ML + ((row0 - ML) & ~255); seg1 = seg0 + 256; }
            const float* mp = modl + (size_t)mi * 6144 + shift_chunk * 1024;
            f32x4 gs[4], sh[4];
#pragma unroll
            for (int j = 0; j < 4; ++j) { const int c = 4 * lane + 256 * j; sh[j] = *(const f32x4*)(mp + c); const f32x4 sc = *(const f32x4*)(mp + 1024 + c); gs[j] = *(const f32x4*)(g + c) * (sc + 1.f); }
            f32x4 prev[4], cur[4], nxt[4];
            if (row0 > seg0) norm_row(XROW(row0 - 1), gs, sh, lane, prev); else { for (int j = 0; j < 4; ++j) prev[j] = (f32x4){0.f, 0.f, 0.f, 0.f}; }
            norm_row(XROW(row0), gs, sh, lane, cur);
            for (int r = row0; r < row0 + 8; ++r) {
                if (r + 1 < seg1) norm_row(XROW(r + 1), gs, sh, lane, nxt); else { for (int j = 0; j < 4; ++j) nxt[j] = (f32x4){0.f, 0.f, 0.f, 0.f}; }
                store_row_bf16(H + (size_t)r * ldh, cur, lane);
                f32x4 hs[4];
#pragma unroll
                for (int j = 0; j < 4; ++j) hs[j] = (prev[j] + nxt[j]) * 0.5f;
                store_row_bf16(H + (size_t)r * ldh + 1024, hs, lane);
#pragma unroll
                for (int j = 0; j < 4; ++j) { prev[j] = cur[j]; cur[j] = nxt[j]; }
            }
        }
    }
#undef XROW
}

DI void phase_mod(const Args& a, float* lds, int tid) {
    float* sc = lds;
    float* red = lds + 1024 * 12;
    const float* c = a.in[1]; const float* cctx = a.in[3]; const float* ada_w = a.in[4]; const float* ada_b = a.in[5];
    float* mod = (float*)(a.ws + WS_MOD);
    for (int idx = tid; idx < 9 * 1024; idx += NTHREADS) { const int j = idx >> 10, k = idx & 1023; const float v = j < 8 ? c[j * 1024 + k] : cctx[k]; sc[k * 12 + j] = v * sigmoidf_(v); }
    __syncthreads();
    for (int unit = blockIdx.x; unit < 768; unit += gridDim.x) {
        const int l = unit / 192, n0 = (unit % 192) * 32, col = tid & 31, ks = tid >> 5;
        const float* w = ada_w + ((size_t)l * 1024 + ks * 64) * 6144 + n0 + col;
        float acc[9];
#pragma unroll
        for (int j = 0; j < 9; ++j) acc[j] = 0.f;
#pragma unroll 32
        for (int kk = 0; kk < 64; ++kk) {
            const float wv = w[(size_t)kk * 6144]; const float* s = sc + (ks * 64 + kk) * 12;
            const f32x4 s0 = *(const f32x4*)s, s1 = *(const f32x4*)(s + 4); const float s8 = s[8];
            acc[0] += s0.x * wv; acc[1] += s0.y * wv; acc[2] += s0.z * wv; acc[3] += s0.w * wv;
            acc[4] += s1.x * wv; acc[5] += s1.y * wv; acc[6] += s1.z * wv; acc[7] += s1.w * wv; acc[8] += s8 * wv;
        }
#pragma unroll
        for (int j = 0; j < 9; ++j) red[(ks * 9 + j) * 32 + col] = acc[j];
        __syncthreads();
        if (tid < 288) {
            const int j = tid >> 5, cc = tid & 31; float s = ada_b[l * 6144 + n0 + cc];
#pragma unroll
            for (int k2 = 0; k2 < 16; ++k2) s += red[(k2 * 9 + j) * 32 + cc];
            mod[((size_t)(l * 9 + j)) * 6144 + n0 + cc] = s;
        }
        __syncthreads();
    }
}

DI void attn_unit(const bf16_t* QK, const bf16_t* VTL, const bf16_t* VTC, bf16_t* O, const float* tbl, int b, int hd, int r, int cq, int lane) {
    const int n = lane & 31, h = lane >> 5;
    const bool lat = r >= 0;
    const int qrow0 = lat ? b * 4096 + r * 64 : ML + b * 256 + cq * 64;
    const int pin = (n & 0x13) | ((n & 4) << 1) | ((n & 8) >> 1);
    bf16x8 bq[2][4];
#pragma unroll
    for (int qb = 0; qb < 2; ++qb)
#pragma unroll
        for (int s = 0; s < 4; ++s) bq[qb][s] = *(const bf16x8*)(QK + (size_t)(qrow0 + 32 * qb + n) * 2048 + hd * 64 + 32 * h + 8 * s);
    f32x16 o[2][2];
#pragma unroll
    for (int x = 0; x < 2; ++x)
#pragma unroll
        for (int y = 0; y < 2; ++y)
#pragma unroll
            for (int i = 0; i < 16; ++i) o[x][y][i] = 0.f;
    float mrun[2] = {-1e30f, -1e30f}, lrun[2] = {0.f, 0.f};
    const int r0 = lat ? min(max(r - 4, 0), 56) : 0;
    const int nblk = lat ? 24 : 8;
    const bf16_t* vtc = VTC + (size_t)((b * 16 + hd) * 64) * 256;
    const bf16_t* vtl = VTL + (size_t)((b * 16 + hd) * 64) * 4096;
    for (int blk = 0; blk < nblk; ++blk) {
        int krow0, ldv, kc0 = 0, ridx = 0; const bf16_t* vt;
        const bool lb_ = blk >= 8;
        if (!lb_) { krow0 = ML + b * 256 + blk * 32; vt = vtc + blk * 32; ldv = 256; }
        else { const int lb = blk - 8, kr = r0 + (lb >> 1); kc0 = (lb & 1) * 32; krow0 = b * 4096 + kr * 64 + kc0; vt = vtl + kr * 64 + kc0; ldv = 4096; ridx = kr - r + 7; }
        bf16x8 ka[4];
#pragma unroll
        for (int s = 0; s < 4; ++s) ka[s] = *(const bf16x8*)(QK + (size_t)(krow0 + pin) * 2048 + 1024 + hd * 64 + 32 * h + 8 * s);
        bf16x8 va[2][2];
#pragma unroll
        for (int db = 0; db < 2; ++db)
#pragma unroll
            for (int s2 = 0; s2 < 2; ++s2) va[db][s2] = *(const bf16x8*)(vt + (size_t)(32 * db + n) * ldv + 16 * s2 + 8 * h);
        f32x16 sa[2];
#pragma unroll
        for (int qb = 0; qb < 2; ++qb) {
#pragma unroll
            for (int i = 0; i < 16; ++i) sa[qb][i] = 0.f;
#pragma unroll
            for (int s = 0; s < 4; ++s) sa[qb] = MFMA32(ka[s], bq[qb][s], sa[qb]);
        }
        bf16x8 pb[2][2];
#pragma unroll
        for (int qb = 0; qb < 2; ++qb) {
            if (lb_) {
                const int qc = 32 * qb + n, cs = min(max(qc - 8, 0), 48);
                const float* bp = tbl + ridx * 128 + 48 + 15 + kc0 + 8 * h - qc;
                const int okb = kc0 + 8 * h - cs;
#pragma unroll
                for (int i = 0; i < 16; ++i) {
                    const int ko = (i & 7) + 16 * (i >> 3);
                    const bool ok = (unsigned)(okb + ko) < 16u;
                    const float bv = bp[ko];
                    sa[qb][i] = ok ? sa[qb][i] + bv : -1e30f;
                }
            }
            float bm = sa[qb][0];
#pragma unroll
            for (int i = 1; i < 16; ++i) bm = fmaxf(bm, sa[qb][i]);
            bm = fmaxf(bm, __shfl_xor(bm, 32));
            const float mnew = fmaxf(mrun[qb], bm);
            const float alpha = __builtin_amdgcn_exp2f(mrun[qb] - mnew);
            mrun[qb] = mnew;
            float ps = 0.f;
#pragma unroll
            for (int i = 0; i < 16; ++i) { const float p = __builtin_amdgcn_exp2f(sa[qb][i] - mnew); sa[qb][i] = p; ps += p; }
            lrun[qb] = lrun[qb] * alpha + ps;
            if (__builtin_amdgcn_ballot_w64(alpha != 1.f) != 0ull) {
#pragma unroll
                for (int db = 0; db < 2; ++db)
#pragma unroll
                    for (int i = 0; i < 16; ++i) o[db][qb][i] *= alpha;
            }
#pragma unroll
            for (int s2 = 0; s2 < 2; ++s2) {
                u32x4 w; w.x = cvtpk(sa[qb][8 * s2 + 0], sa[qb][8 * s2 + 1]); w.y = cvtpk(sa[qb][8 * s2 + 2], sa[qb][8 * s2 + 3]);
                w.z = cvtpk(sa[qb][8 * s2 + 4], sa[qb][8 * s2 + 5]); w.w = cvtpk(sa[qb][8 * s2 + 6], sa[qb][8 * s2 + 7]);
                pb[qb][s2] = __builtin_bit_cast(bf16x8, w);
            }
        }
#pragma unroll
        for (int db = 0; db < 2; ++db)
#pragma unroll
            for (int qb = 0; qb < 2; ++qb)
#pragma unroll
                for (int s2 = 0; s2 < 2; ++s2) o[db][qb] = MFMA32(va[db][s2], pb[qb][s2], o[db][qb]);
    }
#pragma unroll
    for (int qb = 0; qb < 2; ++qb) {
        const float lt = lrun[qb] + __shfl_xor(lrun[qb], 32);
        const float inv = 1.f / lt;
        bf16_t* op = O + (size_t)(qrow0 + 32 * qb + n) * 1024 + hd * 64;
#pragma unroll
        for (int db = 0; db < 2; ++db)
#pragma unroll
            for (int g = 0; g < 4; ++g) {
                u32x2 w; w.x = cvtpk(o[db][qb][4 * g] * inv, o[db][qb][4 * g + 1] * inv); w.y = cvtpk(o[db][qb][4 * g + 2] * inv, o[db][qb][4 * g + 3] * inv);
                *(u32x2*)(op + 32 * db + 8 * g + 4 * h) = w;
            }
    }
}

DI void gla_unit(const bf16_t* P, const float* LR, const float* wdec, const float* bdec, bf16_t* OUT  , unsigned char* lds, int unit, int tid) {
    const int lane = tid & 63, wid = __builtin_amdgcn_readfirstlane(tid >> 6);
    const int vs = unit & 3, dir = (unit >> 2) & 1, hd = (unit >> 3) & 3, b = unit >> 5;
    bf16_t* QE = (bf16_t*)lds;
    bf16_t* KE = QE + 64 * 136;
    bf16_t* ST = KE + 64 * 136;
    bf16_t* KDT = ST + 64 * 136;
    bf16_t* VT = KDT + 128 * 72;
    bf16_t* AM = VT + 64 * 72;
    float* Bc = (float*)(AM + 64 * 72);
    float* LRs = Bc + 64 * 132;
    float* GRP = LRs + 64 * 16;
    float* DEC = GRP + 4 * 128;
    const int dcol = tid & 127, lg = tid >> 7;
    float wd[16];
#pragma unroll
    for (int r = 0; r < 16; ++r) wd[r] = wdec[(dir * 16 + r) * 512 + hd * 128 + dcol];
    const float bd = bdec[dir * 512 + hd * 128 + dcol];
    const int col_q = hd * 128, col_k = 512 + hd * 128, col_v = 1024 + hd * 256 + vs * 64;
    f32x16 st;
#pragma unroll
    for (int i = 0; i < 16; ++i) st[i] = 0.f;
    const int svt = wid >> 2, sdt = wid & 3, rho = lane & 31, hh = lane >> 5;
    bf16_t* outp = OUT + (size_t)dir * MT * 1024;
    const int el = tid >> 3, eg = tid & 7;
    constexpr int NCHT = 68;
#define GROWQ(q, l) ((q) < 4 ? ML + b * 256 + (dir ? 255 - ((q) * 64 + (l)) : (q) * 64 + (l)) : b * 4096 + (dir ? 4095 - (((q) - 4) * 64 + (l)) : ((q) - 4) * 64 + (l)))
    u32x4 rq0, rq1, rk0, rk1, rv; f32x2_t rlr;
#define GLA_FETCH(q) do { const size_t ro_ = (size_t)GROWQ(q, el) * 3072; \
        rq0 = *(const u32x4*)(P + ro_ + col_q + 16 * eg); rq1 = *(const u32x4*)(P + ro_ + col_q + 16 * eg + 8); \
        rk0 = *(const u32x4*)(P + ro_ + col_k + 16 * eg); rk1 = *(const u32x4*)(P + ro_ + col_k + 16 * eg + 8); \
        rv = *(const u32x4*)(P + ro_ + col_v + 8 * eg); \
        { const int idx_ = tid * 2, l_ = idx_ >> 4, r_ = idx_ & 15; rlr = *(const f32x2_t*)(LR + (size_t)GROWQ(q, l_) * 32 + dir * 16 + r_); } } while (0)
    GLA_FETCH(0);
    for (int q = 0; q < NCHT; ++q) {
        const u32x4 cq0 = rq0, cq1 = rq1, ck0 = rk0, ck1 = rk1, cv = rv;
        { const int idx = tid * 2, l = idx >> 4, r = idx & 15; LRs[l * 16 + r] = rlr.x; LRs[l * 16 + r + 1] = rlr.y; }
        __syncthreads();
        if (q + 1 < NCHT) GLA_FETCH(q + 1);
        { float run = 0.f;
          for (int li = 0; li < 16; ++li) { const int l = 16 * lg + li; float z = bd;
              const f32x4 l0 = *(const f32x4*)(LRs + l * 16), l1 = *(const f32x4*)(LRs + l * 16 + 4), l2 = *(const f32x4*)(LRs + l * 16 + 8), l3 = *(const f32x4*)(LRs + l * 16 + 12);
              z += l0.x * wd[0] + l0.y * wd[1] + l0.z * wd[2] + l0.w * wd[3]; z += l1.x * wd[4] + l1.y * wd[5] + l1.z * wd[6] + l1.w * wd[7];
              z += l2.x * wd[8] + l2.y * wd[9] + l2.z * wd[10] + l2.w * wd[11]; z += l3.x * wd[12] + l3.y * wd[13] + l3.z * wd[14] + l3.w * wd[15];
              const float x = -z; const float sp = fmaxf(x, 0.f) + __logf(1.f + __expf(-fabsf(x)));
              run -= sp * (1.f / 16.f); Bc[l * 132 + dcol] = run; }
          GRP[lg * 128 + dcol] = run; }
        __syncthreads();
        {
          const int g_ = el >> 4;
          float bv[16], bl[16];
#pragma unroll
          for (int e4 = 0; e4 < 4; ++e4) {
              const f32x4 t = *(const f32x4*)(Bc + el * 132 + 16 * eg + 4 * e4);
              f32x4 off = (f32x4){0.f, 0.f, 0.f, 0.f}, tot = (f32x4){0.f, 0.f, 0.f, 0.f};
#pragma unroll
              for (int g2 = 0; g2 < 4; ++g2) { const f32x4 gq = *(const f32x4*)(GRP + g2 * 128 + 16 * eg + 4 * e4); tot += gq; if (g2 < g_) off += gq; }
#pragma unroll
              for (int j = 0; j < 4; ++j) { bv[4 * e4 + j] = t[j] + off[j]; bl[4 * e4 + j] = tot[j]; }
          }
          if (el == 0) {
#pragma unroll
              for (int e = 0; e < 16; ++e) DEC[16 * eg + e] = __expf(bl[e]);
          }
          unsigned qw[8] = {cq0.x, cq0.y, cq0.z, cq0.w, cq1.x, cq1.y, cq1.z, cq1.w}, kw[8] = {ck0.x, ck0.y, ck0.z, ck0.w, ck1.x, ck1.y, ck1.z, ck1.w};
          unsigned qo[8], ko[8];
#pragma unroll
          for (int e2 = 0; e2 < 8; ++e2) {
              const float q0 = __uint_as_float(qw[e2] << 16), q1 = __uint_as_float(qw[e2] & 0xffff0000u), k0 = __uint_as_float(kw[e2] << 16), k1 = __uint_as_float(kw[e2] & 0xffff0000u);
              const float b0 = bv[2 * e2], b1 = bv[2 * e2 + 1];
              const float e0 = __expf(b0), e1 = __expf(b1);
              qo[e2] = cvtpk(q0 * e0, q1 * e1);
              ko[e2] = cvtpk(k0 * __builtin_amdgcn_rcpf(e0), k1 * __builtin_amdgcn_rcpf(e1));
              KDT[(16 * eg + 2 * e2) * 72 + el] = f2bf(k0 * __expf(bl[2 * e2] - b0)); KDT[(16 * eg + 2 * e2 + 1) * 72 + el] = f2bf(k1 * __expf(bl[2 * e2 + 1] - b1));
          }
          *(u32x4*)(QE + el * 136 + 16 * eg) = (u32x4){qo[0], qo[1], qo[2], qo[3]}; *(u32x4*)(QE + el * 136 + 16 * eg + 8) = (u32x4){qo[4], qo[5], qo[6], qo[7]};
          *(u32x4*)(KE + el * 136 + 16 * eg) = (u32x4){ko[0], ko[1], ko[2], ko[3]}; *(u32x4*)(KE + el * 136 + 16 * eg + 8) = (u32x4){ko[4], ko[5], ko[6], ko[7]};
          { const unsigned vw[4] = {cv.x, cv.y, cv.z, cv.w};
#pragma unroll
            for (int e2 = 0; e2 < 4; ++e2) { VT[(8 * eg + 2 * e2) * 72 + el] = (bf16_t)(vw[e2] & 0xffffu); VT[(8 * eg + 2 * e2 + 1) * 72 + el] = (bf16_t)(vw[e2] >> 16); } }
#pragma unroll
          for (int i = 0; i < 16; ++i) ST[(32 * svt + crow(i, hh)) * 136 + 32 * sdt + rho] = f2bf(st[i]);
        }
        __syncthreads();
        if (wid < 4) { const int lt = wid >> 1, mt = wid & 1; f32x16 acc;
#pragma unroll
            for (int i = 0; i < 16; ++i) acc[i] = 0.f;
            mma_tile(acc, QE + 32 * lt * 136, 136, KE + 32 * mt * 136, 136, 8, lane);
#pragma unroll
            for (int i = 0; i < 16; ++i) { const int l = 32 * lt + crow(i, hh), m = 32 * mt + rho; AM[l * 72 + m] = f2bf(m <= l ? acc[i] : 0.f); } }
        __syncthreads();
        if (wid < 4) { const int lt = wid >> 1, vt2 = wid & 1; f32x16 acc;
#pragma unroll
            for (int i = 0; i < 16; ++i) acc[i] = 0.f;
            mma_tile(acc, AM + 32 * lt * 72, 72, VT + 32 * vt2 * 72, 72, 4, lane);
            mma_tile(acc, QE + 32 * lt * 136, 136, ST + 32 * vt2 * 136, 136, 8, lane);
#pragma unroll
            for (int i = 0; i < 16; ++i) { const int l = 32 * lt + crow(i, hh); outp[(size_t)GROWQ(q, l) * 1024 + hd * 256 + vs * 64 + 32 * vt2 + rho] = f2bf(acc[i]); } }
        { const float dc = DEC[32 * sdt + rho];
#pragma unroll
          for (int i = 0; i < 16; ++i) st[i] *= dc;
          mma_tile(st, VT + 32 * svt * 72, 72, KDT + 32 * sdt * 72, 72, 4, lane); }
        __syncthreads();
    }
#undef GROWQ
#undef GLA_FETCH
}
struct GlaFinRow { bf16x8 a0, a1, b0, b1, g0, g1; };
DI void gla_fin_load(GlaFinRow& R, const bf16_t* OF, const bf16_t* OB, const bf16_t* P, int row, int c0) {
    R.a0 = *(const bf16x8*)(OF + (size_t)row * 1024 + c0); R.a1 = *(const bf16x8*)(OF + (size_t)row * 1024 + c0 + 8);
    R.b0 = *(const bf16x8*)(OB + (size_t)row * 1024 + c0); R.b1 = *(const bf16x8*)(OB + (size_t)row * 1024 + c0 + 8);
    R.g0 = *(const bf16x8*)(P + (size_t)row * 3072 + 2048 + c0); R.g1 = *(const bf16x8*)(P + (size_t)row * 3072 + 2048 + c0 + 8);
}
DI void gla_fin_store(const GlaFinRow& R, bf16_t* OF, const float* ng, int row, int c0) {
    float o[16]; float ss = 0.f;
#pragma unroll
    for (int e = 0; e < 8; ++e) { o[e] = bf2f((bf16_t)R.a0[e]) + bf2f((bf16_t)R.b0[e]); o[8 + e] = bf2f((bf16_t)R.a1[e]) + bf2f((bf16_t)R.b1[e]); }
#pragma unroll
    for (int e = 0; e < 16; ++e) ss += o[e] * o[e];
    ss += __shfl_xor(ss, 1); ss += __shfl_xor(ss, 2); ss += __shfl_xor(ss, 4); ss += __shfl_xor(ss, 8);
    const float rinv = rsqrtf(ss * (1.f / 256.f) + 1e-6f);
    float y[16];
#pragma unroll
    for (int e = 0; e < 16; ++e) { const float gt = bf2f((bf16_t)(e < 8 ? R.g0[e] : R.g1[e - 8])); y[e] = o[e] * rinv * ng[(c0 + e) & 255] * (gt * sigmoidf_(gt)); }
    u32x4 w0, w1; w0.x = cvtpk(y[0], y[1]); w0.y = cvtpk(y[2], y[3]); w0.z = cvtpk(y[4], y[5]); w0.w = cvtpk(y[6], y[7]);
    w1.x = cvtpk(y[8], y[9]); w1.y = cvtpk(y[10], y[11]); w1.z = cvtpk(y[12], y[13]); w1.w = cvtpk(y[14], y[15]);
    *(u32x4*)(OF + (size_t)row * 1024 + c0) = w0; *(u32x4*)(OF + (size_t)row * 1024 + c0 + 8) = w1;
}
DI void gla_finish(bf16_t* OF, const bf16_t* OB, const bf16_t* P, const float* ng, int Mrows, int gw, int ngw, int lane) {
    const int c0 = 16 * lane;
    for (int row = gw; row < Mrows; row += 2 * ngw) {
        const int rowB = row + ngw < Mrows ? row + ngw : row;
        GlaFinRow A, B;
        gla_fin_load(A, OF, OB, P, row, c0); gla_fin_load(B, OF, OB, P, rowB, c0);
        gla_fin_store(A, OF, ng, row, c0);
        if (rowB != row) gla_fin_store(B, OF, ng, rowB, c0);
    }
}

typedef unsigned u32x2_t __attribute__((ext_vector_type(2)));
DI float red_rows(float x) {
    unsigned u = __float_as_uint(x);
    u32x2_t r = __builtin_amdgcn_permlane16_swap(u, u, false, false);
    const float y = __uint_as_float(r.x) + __uint_as_float(r.y);
    unsigned v = __float_as_uint(y);
    u32x2_t q = __builtin_amdgcn_permlane32_swap(v, v, false, false);
    return __uint_as_float(q.x) + __uint_as_float(q.y);
}
DI int rw_row(int q, int l, int dir, int b) {
    int T, base, n;
    if (q < 8) { T = 256; base = ML + b * 256; n = q; } else { T = 4096; base = b * 4096; n = q - 8; }
    const int t = n * 32 + l;
    return base + (dir ? T - 1 - t : t);
}
#define DPPB(n) " row_newbcast:" #n " row_mask:0xf bank_mask:0xf\n\t"
#define RW_UPD(n, sreg) "v_mul_f32_dpp " sreg ", %17, " sreg DPPB(n) "v_fmac_f32_dpp " sreg ", %18, %21" DPPB(n) "v_fmac_f32_dpp " sreg ", %19, %22" DPPB(n)
DI void rwkv_unit(const Args& a, const bf16_t* RKV, const bf16_t* TWAA, bf16_t* Y  , float* RK  , unsigned char* lds, int unit, int tid) {
    const int lane = tid & 63, wid = __builtin_amdgcn_readfirstlane(tid >> 6);
    const int dir = unit & 1, hd = (unit >> 1) & 15, b = unit >> 5;
    float* SA = (float*)lds;
    float* YC = SA + 6 * 4096;
    bf16_t* W2T = (bf16_t*)(YC + 4096);
    bf16_t* A2T = W2T + 64 * 72;
    constexpr int NCH = 136;
    {
        const float* w2 = a.in[23] + (size_t)dir * 64 * 1024; const float* a2 = a.in[26] + (size_t)dir * 64 * 1024;
        for (int e = 0; e < 8; ++e) { const int idx = tid + 512 * e, j = idx >> 6, c = idx & 63; W2T[c * 72 + j] = f2bf(w2[(size_t)j * 1024 + hd * 64 + c]); A2T[c * 72 + j] = f2bf(a2[(size_t)j * 1024 + hd * 64 + c]); }
    }
    __syncthreads();
    bf16_t* yout = Y + (size_t)dir * MT * 1024; float* rkout = RK + (size_t)dir * MT * 16;
    if (wid >= 4) {
        const int pw = wid - 4, rho = lane & 31, h = lane >> 5, ptid = tid - 256;
        float cw0[2], ca0[2], ckk[2], cka[2], crk[2];
#pragma unroll
        for (int ct = 0; ct < 2; ++ct) { const int c = hd * 64 + 32 * ct + rho; cw0[ct] = a.in[21][dir * 1024 + c]; ca0[ct] = a.in[24][dir * 1024 + c]; ckk[ct] = a.in[29][c]; cka[ct] = a.in[30][c]; crk[ct] = a.in[31][c]; }
        for (int p = 0; p <= NCH + 1; ++p) {
            if (p < NCH) {
                const int buf = p & 1;
                const int rowA = rw_row(p, 8 * pw + (rho & 7), dir, b);
                const bf16_t* ta = TWAA + (size_t)rowA * 256 + dir * 64 + 8 * h;
                f32x16 zw0, zw1, za0, za1;
#pragma unroll
                for (int i = 0; i < 16; ++i) { zw0[i] = 0.f; zw1[i] = 0.f; za0[i] = 0.f; za1[i] = 0.f; }
#pragma unroll
                for (int s = 0; s < 4; ++s) {
                    const bf16x8 atw = *(const bf16x8*)(ta + 16 * s), aaa = *(const bf16x8*)(ta + 128 + 16 * s);
                    const bf16x8 bw0 = *(const bf16x8*)(W2T + rho * 72 + 16 * s + 8 * h), bw1 = *(const bf16x8*)(W2T + (32 + rho) * 72 + 16 * s + 8 * h);
                    const bf16x8 ba0 = *(const bf16x8*)(A2T + rho * 72 + 16 * s + 8 * h), ba1 = *(const bf16x8*)(A2T + (32 + rho) * 72 + 16 * s + 8 * h);
                    zw0 = MFMA32(atw, bw0, zw0); zw1 = MFMA32(atw, bw1, zw1); za0 = MFMA32(aaa, ba0, za0); za1 = MFMA32(aaa, ba1, za1);
                }
#pragma unroll
                for (int i = 0; i < 4; ++i) {
                    const int tok = 8 * pw + i + 4 * h; const int row = rw_row(p, tok, dir, b);
                    const bf16_t* pr = RKV + (size_t)row * 3072 + hd * 64 + rho;
                    float rv[2], kv[2], vv[2], av[2], kkv[2], kd[2]; float ss = 0.f, rk = 0.f;
#pragma unroll
                    for (int ct = 0; ct < 2; ++ct) {
                        rv[ct] = bf2f(pr[32 * ct]); kv[ct] = bf2f(pr[1024 + 32 * ct]); vv[ct] = bf2f(pr[2048 + 32 * ct]);
                        const float zav = ct ? za1[i] : za0[i];
                        av[ct] = 1.f / (1.f + __expf(-(ca0[ct] + zav)));
                        kkv[ct] = kv[ct] * ckk[ct]; ss += kkv[ct] * kkv[ct];
                        kd[ct] = kv[ct] * (1.f + (av[ct] - 1.f) * cka[ct]); rk += rv[ct] * kd[ct] * crk[ct];
                    }
#pragma unroll
                    for (int o = 1; o < 32; o <<= 1) { ss += __shfl_xor(ss, o); rk += __shfl_xor(rk, o); }
                    const float kinv = rsqrtf(fmaxf(ss, 1e-24f));
                    if (rho == 0) rkout[(size_t)row * 16 + hd] = rk;
#pragma unroll
                    for (int ct = 0; ct < 2; ++ct) {
                        const float zwv = ct ? zw1[i] : zw0[i];
                        const float x = -(cw0[ct] + zwv);
                        const float sp = fmaxf(x, 0.f) + __logf(1.f + __expf(-fabsf(x)));
                        const float dec = __expf(-__expf(-sp - 0.5f));
                        const float kn = kkv[ct] * kinv;
                        float* o = SA + buf * 2048 + tok * 64 + 32 * ct + rho;
                        o[0 * 4096] = dec; o[1 * 4096] = kd[ct]; o[2 * 4096] = kn * av[ct]; o[3 * 4096] = -kn; o[4 * 4096] = rv[ct]; o[5 * 4096] = vv[ct];
                    }
                }
            }
            if (p >= 2) {
                const int tok = ptid >> 3, i0 = (ptid & 7) * 8; const int row = rw_row(p - 2, tok, dir, b);
                const float* y = YC + (p & 1) * 2048 + tok * 64 + i0;
                const f32x4 y0 = *(const f32x4*)y, y1 = *(const f32x4*)(y + 4);
                *(u32x4*)(yout + (size_t)row * 1024 + hd * 64 + i0) = pack8(y0, y1);
            }
            __syncthreads();
        }
    } else {
        __builtin_amdgcn_s_setprio(3);
        const int rl = lane & 15, cg = lane >> 4, myrow = 16 * wid + rl;
        float s0 = 0.f, s1 = 0.f, s2 = 0.f, s3 = 0.f, s4 = 0.f, s5 = 0.f, s6 = 0.f, s7 = 0.f, s8 = 0.f, s9 = 0.f, s10 = 0.f, s11 = 0.f, s12 = 0.f, s13 = 0.f, s14 = 0.f, s15 = 0.f;
        for (int p = 0; p <= NCH + 1; ++p) {
            if (p >= 1 && p <= NCH) {
                const int buf = (p - 1) & 1;
                const float* base = SA + buf * 2048;
                float* yc = YC + buf * 2048 + myrow;
                float w_c = base[lane], kd_c = base[4096 + lane], bb_c = base[2 * 4096 + lane], nk_c = base[3 * 4096 + lane], r_c = base[4 * 4096 + lane], v_c = base[5 * 4096 + myrow];
                for (int t = 0; t < 32; ++t) {
                    const int tn = (t + 1) & 31;
                    const float w_n = base[tn * 64 + lane], kd_n = base[4096 + tn * 64 + lane], bb_n = base[2 * 4096 + tn * 64 + lane], nk_n = base[3 * 4096 + tn * 64 + lane], r_n = base[4 * 4096 + tn * 64 + lane], v_n = base[5 * 4096 + tn * 64 + myrow];
                    float sap;
                    asm volatile("s_nop 1\n\t"
                        "v_mul_f32_dpp %0, %1, %2" DPPB(0) "v_fmac_f32_dpp %0, %1, %3" DPPB(1) "v_fmac_f32_dpp %0, %1, %4" DPPB(2) "v_fmac_f32_dpp %0, %1, %5" DPPB(3)
                        "v_fmac_f32_dpp %0, %1, %6" DPPB(4) "v_fmac_f32_dpp %0, %1, %7" DPPB(5) "v_fmac_f32_dpp %0, %1, %8" DPPB(6) "v_fmac_f32_dpp %0, %1, %9" DPPB(7)
                        "v_fmac_f32_dpp %0, %1, %10" DPPB(8) "v_fmac_f32_dpp %0, %1, %11" DPPB(9) "v_fmac_f32_dpp %0, %1, %12" DPPB(10) "v_fmac_f32_dpp %0, %1, %13" DPPB(11)
                        "v_fmac_f32_dpp %0, %1, %14" DPPB(12) "v_fmac_f32_dpp %0, %1, %15" DPPB(13) "v_fmac_f32_dpp %0, %1, %16" DPPB(14) "v_fmac_f32_dpp %0, %1, %17" DPPB(15)
                        "s_nop 1"
                        : "=&v"(sap)
                        : "v"(nk_c), "v"(s0), "v"(s1), "v"(s2), "v"(s3), "v"(s4), "v"(s5), "v"(s6), "v"(s7), "v"(s8), "v"(s9), "v"(s10), "v"(s11), "v"(s12), "v"(s13), "v"(s14), "v"(s15));
                    const float sa = red_rows(sap);
                    float yp;
                    asm volatile("s_nop 1\n\t"
                        RW_UPD(0, "%0") RW_UPD(1, "%1") RW_UPD(2, "%2") RW_UPD(3, "%3") RW_UPD(4, "%4") RW_UPD(5, "%5") RW_UPD(6, "%6") RW_UPD(7, "%7")
                        RW_UPD(8, "%8") RW_UPD(9, "%9") RW_UPD(10, "%10") RW_UPD(11, "%11") RW_UPD(12, "%12") RW_UPD(13, "%13") RW_UPD(14, "%14") RW_UPD(15, "%15")
                        "v_mul_f32_dpp %16, %20, %0" DPPB(0) "v_fmac_f32_dpp %16, %20, %1" DPPB(1) "v_fmac_f32_dpp %16, %20, %2" DPPB(2) "v_fmac_f32_dpp %16, %20, %3" DPPB(3)
                        "v_fmac_f32_dpp %16, %20, %4" DPPB(4) "v_fmac_f32_dpp %16, %20, %5" DPPB(5) "v_fmac_f32_dpp %16, %20, %6" DPPB(6) "v_fmac_f32_dpp %16, %20, %7" DPPB(7)
                        "v_fmac_f32_dpp %16, %20, %8" DPPB(8) "v_fmac_f32_dpp %16, %20, %9" DPPB(9) "v_fmac_f32_dpp %16, %20, %10" DPPB(10) "v_fmac_f32_dpp %16, %20, %11" DPPB(11)
                        "v_fmac_f32_dpp %16, %20, %12" DPPB(12) "v_fmac_f32_dpp %16, %20, %13" DPPB(13) "v_fmac_f32_dpp %16, %20, %14" DPPB(14) "v_fmac_f32_dpp %16, %20, %15" DPPB(15)
                        "s_nop 1"
                        : "+v"(s0), "+v"(s1), "+v"(s2), "+v"(s3), "+v"(s4), "+v"(s5), "+v"(s6), "+v"(s7), "+v"(s8), "+v"(s9), "+v"(s10), "+v"(s11), "+v"(s12), "+v"(s13), "+v"(s14), "+v"(s15), "=&v"(yp)
                        : "v"(w_c), "v"(bb_c), "v"(kd_c), "v"(r_c), "v"(sa), "v"(v_c));
                    const float y = red_rows(yp);
                    if (cg == 0) yc[t * 64] = y;
                    w_c = w_n; kd_c = kd_n; bb_c = bb_n; nk_c = nk_n; r_c = r_n; v_c = v_n;
                }
            }
            __syncthreads();
        }
        __builtin_amdgcn_s_setprio(0);
    }
    __syncthreads();
}
struct RwFinRow { bf16x8 a0, a1, b0, b1, v0, v1, g0, g1; float rk; };
DI void rw_fin_load(RwFinRow& R, const bf16_t* YF, const bf16_t* YB, const bf16_t* RKV, const bf16_t* G, const float* RK, int row, int c0, int hd) {
    R.a0 = *(const bf16x8*)(YF + (size_t)row * 1024 + c0); R.a1 = *(const bf16x8*)(YF + (size_t)row * 1024 + c0 + 8);
    R.b0 = *(const bf16x8*)(YB + (size_t)row * 1024 + c0); R.b1 = *(const bf16x8*)(YB + (size_t)row * 1024 + c0 + 8);
    R.v0 = *(const bf16x8*)(RKV + (size_t)row * 3072 + 2048 + c0); R.v1 = *(const bf16x8*)(RKV + (size_t)row * 3072 + 2048 + c0 + 8);
    R.g0 = *(const bf16x8*)(G + (size_t)row * 1024 + c0); R.g1 = *(const bf16x8*)(G + (size_t)row * 1024 + c0 + 8);
    R.rk = RK[(size_t)row * 16 + hd] + RK[(size_t)MT * 16 + (size_t)row * 16 + hd];
}
DI void rw_fin_store(const RwFinRow& R, bf16_t* YF, const float* lng, const float* lnb, int row, int c0) {
    float y[16]; float sm = 0.f;
#pragma unroll
    for (int e = 0; e < 8; ++e) { y[e] = bf2f((bf16_t)R.a0[e]) + bf2f((bf16_t)R.b0[e]); y[8 + e] = bf2f((bf16_t)R.a1[e]) + bf2f((bf16_t)R.b1[e]); }
#pragma unroll
    for (int e = 0; e < 16; ++e) sm += y[e];
    sm += __shfl_xor(sm, 1); sm += __shfl_xor(sm, 2);
    const float mu = sm * (1.f / 64.f);
    float sv = 0.f;
#pragma unroll
    for (int e = 0; e < 16; ++e) { y[e] -= mu; sv += y[e] * y[e]; }
    sv += __shfl_xor(sv, 1); sv += __shfl_xor(sv, 2);
    const float rinv = rsqrtf(sv * (1.f / 64.f) + 64e-5f);
    float o[16];
#pragma unroll
    for (int e = 0; e < 16; ++e) { const float vv = bf2f((bf16_t)(e < 8 ? R.v0[e] : R.v1[e - 8])), gg = bf2f((bf16_t)(e < 8 ? R.g0[e] : R.g1[e - 8]));
        o[e] = (y[e] * rinv * lng[c0 + e] + lnb[c0 + e] + R.rk * vv) * gg; }
    u32x4 w0, w1; w0.x = cvtpk(o[0], o[1]); w0.y = cvtpk(o[2], o[3]); w0.z = cvtpk(o[4], o[5]); w0.w = cvtpk(o[6], o[7]);
    w1.x = cvtpk(o[8], o[9]); w1.y = cvtpk(o[10], o[11]); w1.z = cvtpk(o[12], o[13]); w1.w = cvtpk(o[14], o[15]);
    *(u32x4*)(YF + (size_t)row * 1024 + c0) = w0; *(u32x4*)(YF + (size_t)row * 1024 + c0 + 8) = w1;
}
DI void rwkv_finish(bf16_t* YF, const bf16_t* YB, const bf16_t* RKV, const bf16_t* G, const float* RK, const float* lng, const float* lnb, int Mrows, int gw, int ngw, int lane) {
    const int c0 = 16 * lane, hd = lane >> 2;
    for (int row = gw; row < Mrows; row += 2 * ngw) {
        const int rowB = row + ngw < Mrows ? row + ngw : row;
        RwFinRow A, B;
        rw_fin_load(A, YF, YB, RKV, G, RK, row, c0, hd); rw_fin_load(B, YF, YB, RKV, G, RK, rowB, c0, hd);
        rw_fin_store(A, YF, lng, lnb, row, c0);
        if (rowB != row) rw_fin_store(B, YF, lng, lnb, rowB, c0);
    }
}

#define XB_TMO      128
#define XB_XCNT(j)  (256  + 64 * (j))
#define XB_XSUB(j)  (1280 + 64 * (j))
#define XB_XGEN(j)  (2304 + 64 * (j))
#define XB_TOP      3328
#define XB_TOPGEN   3392
#define XCD_BAR_WORDS 3456
#define XB_SPIN_CAP (1u << 18)

__device__ __forceinline__ unsigned xb_ld(unsigned* p)              { return __hip_atomic_load(p, __ATOMIC_RELAXED, __HIP_MEMORY_SCOPE_AGENT); }
__device__ __forceinline__ unsigned xb_add(unsigned* p, unsigned v) { return __hip_atomic_fetch_add(p, v, __ATOMIC_RELAXED, __HIP_MEMORY_SCOPE_AGENT); }
__device__ __forceinline__ unsigned xb_xcc_id() { return (unsigned)__builtin_amdgcn_s_getreg((3 << 11) | 20) & 0xFu; }
#define XB_SPIN(cond, bar) do { unsigned _sp = 0; while (cond) { __builtin_amdgcn_s_sleep(1); \
    if ((++_sp & 255u) == 0u) { if (xb_ld(&(bar)[XB_TMO])) break; if (_sp > XB_SPIN_CAP) { atomicAdd(&(bar)[XB_TMO], 1u); break; } } } } while (0)

struct XcdBarrier {
    unsigned* bar; unsigned x;
    volatile LAS unsigned* st;
};

__device__ __forceinline__ XcdBarrier xcd_barrier_post(unsigned* bar, volatile LAS unsigned* st) {
    XcdBarrier b; b.bar = bar; b.x = xb_xcc_id(); b.st = st;
    if (threadIdx.x == 0) (void)xb_add(&bar[XB_XCNT(b.x)], 1u);
    return b;
}
__device__ __forceinline__ void xcd_barrier_complete(unsigned* bar, unsigned x, unsigned& nloc, unsigned& nx) {
    const unsigned G = gridDim.x * gridDim.y * gridDim.z;
    unsigned sum, cnt, mine, sp = 0u;
    for (;;) {
        sum = 0u; cnt = 0u; mine = 0u;
#pragma unroll
        for (unsigned j = 0; j < 16; ++j) { const unsigned c = xb_ld(&bar[XB_XCNT(j)]); sum += c; cnt += (c > 0u) ? 1u : 0u; mine = (j == x) ? c : mine; }
        if (sum == G) break;
        __builtin_amdgcn_s_sleep(1);
        if ((++sp & 255u) == 0u) { if (xb_ld(&bar[XB_TMO])) break; if (sp > XB_SPIN_CAP) { atomicAdd(&bar[XB_TMO], 1u); break; } }
    }
    nloc = mine > 0u ? mine : 1u; nx = cnt > 0u ? cnt : 1u;
}

__device__ __forceinline__ void xcd_barrier(const XcdBarrier& b) {
    asm volatile("s_waitcnt vmcnt(0)" ::: "memory");
    __syncthreads();
    if (threadIdx.x == 0) {
        unsigned* bar = b.bar;
        __builtin_amdgcn_s_waitcnt(0);
        unsigned nloc = b.st[0], nx = b.st[1];
        if (nloc == 0u) { xcd_barrier_complete(bar, b.x, nloc, nx); b.st[0] = nloc; b.st[1] = nx; }
        const unsigned old = xb_add(&bar[XB_XSUB(b.x)], 1u);
        const unsigned gen = old / nloc;
        if (old + 1u == (gen + 1u) * nloc) {
            __builtin_amdgcn_fence(__ATOMIC_RELEASE, "agent");
            asm volatile("s_waitcnt vmcnt(0)" ::: "memory");
            const unsigned og = xb_add(&bar[XB_TOP], 1u);
            const unsigned tg = og / nx;
            if (og + 1u == (tg + 1u) * nx) xb_add(&bar[XB_TOPGEN], 1u);
            else XB_SPIN(xb_ld(&bar[XB_TOPGEN]) == tg, bar);
            __builtin_amdgcn_fence(__ATOMIC_ACQUIRE, "agent");
            xb_add(&bar[XB_XGEN(b.x)], 1u);
            asm volatile("s_waitcnt vmcnt(0)" ::: "memory");
        } else {
            XB_SPIN(xb_ld(&bar[XB_XGEN(b.x)]) == gen, bar);
            __builtin_amdgcn_fence(__ATOMIC_ACQUIRE, "agent");
            asm volatile("s_waitcnt vmcnt(0)" ::: "memory");
        }
    }
    __syncthreads();
}

#define WSP(T, off) ((T*)(a.ws + (off)))
#define PHASE(k) if (lo <= (k) && (k) < hi)
#define SEAM(k) do { if ((k) + 1 < hi) xcd_barrier(xbar); } while (0)
template <int L> DI void run_layer(const Args& a, unsigned char* lds, const XcdBarrier& xbar, int lo, int hi) {
    constexpr int kind = L % 3, jj = L / 3, P0 = 1 + 8 * L;
    constexpr bool need_ctx = L < 3;
    constexpr int Mact = need_ctx ? MT : ML;
    const int tid = threadIdx.x, lane = tid & 63, wid = __builtin_amdgcn_readfirstlane(tid >> 6);
    const int gw = blockIdx.x * 8 + wid, ngw = gridDim.x * 8;
    LAS unsigned char* ldsl = (LAS unsigned char*)lds;
    PHASE(P0 + 0) {
        float* scr = (float*)(lds + wid * 8704);
        for (int rep = 0; rep < ((DUP & 16) ? 2 : 1); ++rep) {
        const float* modl = WSP(float, WS_MOD) + (size_t)L * 9 * 6144;
        phase_prenorm(L == 0 ? a.in[0] : a.out, L == 0 ? a.in[2] : WSP(float, WS_ZF), a.in[6] + L * 1024, modl, 0, WSP(bf16_t, WS_H2), kind == 2 ? 2048 : 1024, kind == 2, MT, gw, ngw, lane);
        bf16_t* Wmix = WSP(bf16_t, W_MIX); bf16_t* Wo = WSP(bf16_t, W_O);
        conv_job(a.in[8] + (size_t)L * 1024 * 4096, 4096, 1024, 4096, 1024, 4096, nullptr, 0, WSP(bf16_t, W_1), 1024, 0, 0, scr, gw, ngw, lane);
        conv_job(a.in[9] + (size_t)L * 4096 * 1024, 1024, 4096, 1024, 4096, 1024, nullptr, 0, WSP(bf16_t, W_2), 4096, 0, 0, scr, gw, ngw, lane);
        if (kind == 0) {
            conv_job(a.in[11] + (size_t)jj * 1024 * 3072, 3072, 1024, 3072, 1024, 3072, nullptr, 0, Wmix, 1024, 0, 0, scr, gw, ngw, lane);
            conv_job(a.in[12] + (size_t)jj * 1024 * 1024, 1024, 1024, 1024, 1024, 1024, nullptr, 0, Wo, 1024, 0, 0, scr, gw, ngw, lane);
        } else if (kind == 1) {
            conv_job(a.in[14], 3104, 1024, 3104, 1024, 3328, nullptr, 0, Wmix, 1024, 0, 0, scr, gw, ngw, lane);
            conv_job(a.in[18], 1024, 1024, 1024, 1024, 1024, nullptr, 0, Wo, 1024, 0, 0, scr, gw, ngw, lane);
        } else {
            const float* mix = a.in[19];
            for (int md = 1; md <= 2; ++md) {
                const int co = (md - 1) * 1024;
                for (int q = 0; q < 3; ++q) conv_job(a.in[20] + (size_t)q * 1024 * 1024, 1024, 1024, 1024, 1024, 1024, mix + (q == 0 ? 0 : q + 1) * 1024, md, Wmix, 2048, q * 1024, co, scr, gw, ngw, lane);
                conv_job(a.in[27], 160, 1024, 160, 1024, 256, mix + 5 * 1024, md, Wmix, 2048, 3072, co, scr, gw, ngw, lane);
                for (int q = 0; q < 2; ++q) conv_job(a.in[22] + (size_t)q * 1024 * 64, 64, 1024, 64, 1024, 64, mix + 1 * 1024, md, Wmix, 2048, 3328 + 64 * q, co, scr, gw, ngw, lane);
                for (int q = 0; q < 2; ++q) conv_job(a.in[25] + (size_t)q * 1024 * 64, 64, 1024, 64, 1024, 64, mix + 4 * 1024, md, Wmix, 2048, 3456 + 64 * q, co, scr, gw, ngw, lane);
            }
            conv_job(a.in[28], 1024, 160, 1024, 256, 1024, nullptr, 0, WSP(bf16_t, W_G2), 256, 0, 0, scr, gw, ngw, lane);
            conv_job(a.in[34], 1024, 1024, 1024, 1024, 1024, nullptr, 0, Wo, 1024, 0, 0, scr, gw, ngw, lane);
        }
        }
        SEAM(P0 + 0);
    }
    PHASE(P0 + 1) {
        bf16_t* BIG = WSP(bf16_t, WS_BIG);
        for (int rep = 0; rep < ((DUP & 8) ? 2 : 1); ++rep) {
        if (kind == 0) run_gemm(ldsl, WSP(bf16_t, WS_H2), WSP(bf16_t, W_MIX), MT, 3072, 1024, InNaQkv{BIG, BIG + (size_t)MT * 2048, BIG + (size_t)MT * 2048 + (size_t)ML * 1024});
        else if (kind == 1) run_gemm(ldsl, WSP(bf16_t, WS_H2), WSP(bf16_t, W_MIX), MT, 3328, 1024, InGlaIn{BIG, WSP(float, WS_LR)});
        else run_gemm(ldsl, WSP(bf16_t, WS_H2), WSP(bf16_t, W_MIX), MT, 3584, 2048, InRwL1{BIG, BIG + (size_t)MT * 3072, BIG + (size_t)MT * 3328});
        }
        SEAM(P0 + 1);
    }
    PHASE(P0 + 2) {
        bf16_t* BIG = WSP(bf16_t, WS_BIG); bf16_t* H2 = WSP(bf16_t, WS_H2);
        if (kind == 0) {
            const bf16_t* VTL = BIG + (size_t)MT * 2048; const bf16_t* VTC = VTL + (size_t)ML * 1024;
            const float* rpb = a.in[13] + (size_t)jj * 16 * 15 * 31;
            const int nu = 8192 + (need_ctx ? 512 : 0);
#ifndef NO_ATTN
            float* tbl = (float*)(lds + wid * 7680);
            int tbl_hd = -1;
            for (int rep = 0; rep < ((DUP & 1) ? 2 : 1); ++rep)
            for (int u = gw; u < nu; u += ngw) {
                if (u < 8192) {
                    const int hd_ = (u >> 6) & 15;
                    if (hd_ != tbl_hd) {
                        for (int e = lane; e < 465; e += 64) { const int rr = e / 31, cc = e - rr * 31; tbl[rr * 128 + 48 + cc] = rpb[hd_ * 465 + e] * 1.4426950408889634f; }
                        tbl_hd = hd_;
                    }
                    attn_unit(BIG, VTL, VTC, H2, tbl, u >> 10, hd_, u & 63, 0, lane);
                }
                else { const int v = u - 8192; attn_unit(BIG, VTL, VTC, H2, tbl, v >> 6, (v >> 2) & 15, -1, v & 3, lane); }
            }
#endif
        } else if (kind == 1) {
#ifndef NO_GLA
            for (int rep = 0; rep < ((DUP & 2) ? 2 : 1); ++rep)
            for (int u = blockIdx.x; u < 256; u += gridDim.x) gla_unit(BIG, WSP(float, WS_LR), a.in[15], a.in[16], H2, lds, u, tid);
#endif
        } else {
#ifndef NO_RWKV
            for (int rep = 0; rep < ((DUP & 4) ? 2 : 1); ++rep)
            for (int u = blockIdx.x; u < 256; u += gridDim.x) rwkv_unit(a, BIG, BIG + (size_t)MT * 3328, H2, WSP(float, WS_RK), lds, u, tid);
#endif
            run_gemm(ldsl, BIG + (size_t)MT * 3072, WSP(bf16_t, W_G2), MT, 1024, 256, InStore<0>{WSP(bf16_t, WS_G), 1024});
        }
        SEAM(P0 + 2);
    }
    if (kind != 0) {
        PHASE(P0 + 3) {
            bf16_t* H2 = WSP(bf16_t, WS_H2);
            if (kind == 1) gla_finish(H2, H2 + (size_t)MT * 1024, WSP(bf16_t, WS_BIG), a.in[17], Mact, gw, ngw, lane);
            else rwkv_finish(H2, H2 + (size_t)MT * 1024, WSP(bf16_t, WS_BIG), WSP(bf16_t, WS_G), WSP(float, WS_RK), a.in[32], a.in[33], Mact, gw, ngw, lane);
            SEAM(P0 + 3);
        }
    }
    PHASE(P0 + 4) {
        if (DUP & 32) run_gemm(ldsl, WSP(bf16_t, WS_H2), WSP(bf16_t, W_O), Mact, 1024, 1024, InResid{L == 0 ? a.in[0] : a.out, L == 0 ? a.in[2] : WSP(float, WS_ZF), WSP(float, WS_BIG), WSP(float, WS_BIG) + (size_t)ML * 1024, WSP(float, WS_MOD) + (size_t)L * 9 * 6144 + 2 * 1024});
        run_gemm(ldsl, WSP(bf16_t, WS_H2), WSP(bf16_t, W_O), Mact, 1024, 1024, InResid{L == 0 ? a.in[0] : a.out, L == 0 ? a.in[2] : WSP(float, WS_ZF), a.out, WSP(float, WS_ZF), WSP(float, WS_MOD) + (size_t)L * 9 * 6144 + 2 * 1024});
        SEAM(P0 + 4);
    }
    PHASE(P0 + 5) {
        for (int rep = 0; rep < ((DUP & 16) ? 2 : 1); ++rep)
        phase_prenorm(a.out, WSP(float, WS_ZF), a.in[7] + L * 1024, WSP(float, WS_MOD) + (size_t)L * 9 * 6144, 3, WSP(bf16_t, WS_H2), 1024, false, Mact, gw, ngw, lane);
        SEAM(P0 + 5);
    }
    PHASE(P0 + 6) {
        for (int rep = 0; rep < ((DUP & 8) ? 2 : 1); ++rep)
        run_gemm(ldsl, WSP(bf16_t, WS_H2), WSP(bf16_t, W_1), Mact, 4096, 1024, InStore<1>{WSP(bf16_t, WS_BIG), 4096});
        SEAM(P0 + 6);
    }
    PHASE(P0 + 7) {
        if (DUP & 32) run_gemm(ldsl, WSP(bf16_t, WS_BIG), WSP(bf16_t, W_2), Mact, 1024, 4096, InResid{a.out, WSP(float, WS_ZF), WSP(float, WS_H2), WSP(float, WS_H2) + (size_t)ML * 1024, WSP(float, WS_MOD) + (size_t)L * 9 * 6144 + 5 * 1024});
        run_gemm(ldsl, WSP(bf16_t, WS_BIG), WSP(bf16_t, W_2), Mact, 1024, 4096, InResid{a.out, WSP(float, WS_ZF), a.out, WSP(float, WS_ZF), WSP(float, WS_MOD) + (size_t)L * 9 * 6144 + 5 * 1024});
        SEAM(P0 + 7);
    }
}
__global__ void __launch_bounds__(NTHREADS, 2) mega(Args a) {
    extern __shared__ __attribute__((aligned(16))) unsigned char lds[];
    cg::grid_group grid = cg::this_grid();
    const int lo = a.lo, hi = a.hi;
    volatile LAS unsigned* xst = (volatile LAS unsigned*)((LAS unsigned char*)lds + (LDS_BYTES - 64));
    if (threadIdx.x < 2) xst[threadIdx.x] = 0u;
    __syncthreads();
    const XcdBarrier xbar = xcd_barrier_post((unsigned*)(a.ws + WS_BAR), xst);
    PHASE(0) { phase_mod(a, (float*)lds, threadIdx.x); if (1 < hi) grid.sync(); }
    run_layer<0>(a, lds, xbar, lo, hi);
    run_layer<1>(a, lds, xbar, lo, hi);
    run_layer<2>(a, lds, xbar, lo, hi);
    run_layer<3>(a, lds, xbar, lo, hi);
    PHASE(33) {
        const int tid = threadIdx.x, lane = tid & 63, wid = tid >> 6;
        const int gw = blockIdx.x * 8 + wid, ngw = gridDim.x * 8;
        const float* fg = a.in[10];
        for (int st = gw; st < ML / 4; st += ngw) {
            f32x4 v[4][4]; float ss[4];
#pragma unroll
            for (int r = 0; r < 4; ++r) { const float* xr = a.out + (size_t)(4 * st + r) * 1024;
#pragma unroll
                for (int j = 0; j < 4; ++j) v[r][j] = *(const f32x4*)(xr + 4 * lane + 256 * j); }
#pragma unroll
            for (int r = 0; r < 4; ++r) { float s = 0.f;
#pragma unroll
                for (int j = 0; j < 4; ++j) s += (v[r][j].x * v[r][j].x + v[r][j].y * v[r][j].y) + (v[r][j].z * v[r][j].z + v[r][j].w * v[r][j].w);
                ss[r] = s; }
#pragma unroll
            for (int o = 1; o < 64; o <<= 1) {
#pragma unroll
                for (int r = 0; r < 4; ++r) ss[r] += __shfl_xor(ss[r], o);
            }
#pragma unroll
            for (int r = 0; r < 4; ++r) { const float rinv = rsqrtf(ss[r] * (1.f / 1024.f) + 1e-6f); float* xr = a.out + (size_t)(4 * st + r) * 1024;
#pragma unroll
                for (int j = 0; j < 4; ++j) *(f32x4*)(xr + 4 * lane + 256 * j) = v[r][j] * rinv * *(const f32x4*)(fg + 4 * lane + 256 * j); }
        }
    }
}

#ifndef GM
#define GM 0xffff
#endif
#ifndef MULTI_LAUNCH
#define MULTI_LAUNCH 0
#endif
extern "C" void kernel_launch(void* const* d_in, const int* in_sizes, int n_in, void* d_out, int out_size, void* d_ws, size_t ws_size, hipStream_t stream) {
    static int grid_blocks = 0;
    if (!grid_blocks) {
        int dev = 0, cus = 0, per_cu = 0;
        hipGetDevice(&dev);
        hipDeviceGetAttribute(&cus, hipDeviceAttributeMultiprocessorCount, dev);
        hipFuncSetAttribute((const void*)mega, hipFuncAttributeMaxDynamicSharedMemorySize, LDS_BYTES);
        hipOccupancyMaxActiveBlocksPerMultiprocessor(&per_cu, (const void*)mega, NTHREADS, LDS_BYTES);
        if (per_cu < 1) per_cu = 1;
        grid_blocks = cus * per_cu;
    }
    (void)hipMemsetAsync((char*)d_ws + WS_BAR, 0, XCD_BAR_WORDS * 4, stream);
    Args a{};
    for (int i = 0; i < 35; ++i) a.in[i] = (const float*)d_in[i];
    a.out = (float*)d_out; a.ws = (unsigned char*)d_ws;
#if MULTI_LAUNCH
    for (int p = 0; p < 34; ++p) { a.lo = p; a.hi = p + 1; hipLaunchKernelGGL(mega, dim3(grid_blocks), dim3(NTHREADS), LDS_BYTES, stream, a); }
#else
    a.lo = 0; a.hi = 34;
    void* args[] = {&a};
    hipError_t e = hipLaunchCooperativeKernel((const void*)mega, dim3(grid_blocks), dim3(NTHREADS), args, LDS_BYTES, stream);
    if (e != hipSuccess) fprintf(stderr, "cooperative launch failed: %s (grid %d)\n", hipGetErrorString(e), grid_blocks);
#endif
}
```

```cpp
#include <hip/hip_runtime.h>
#include <hip/hip_cooperative_groups.h>
#include <cstdio>
#include <cstdint>
namespace cg = cooperative_groups;

namespace pg8 {
#define PG8_LAS __attribute__((address_space(3)))
typedef unsigned short bf16_t;
typedef short bf16x8 __attribute__((ext_vector_type(8)));
typedef float f32x4 __attribute__((ext_vector_type(4)));
typedef unsigned u32x4 __attribute__((ext_vector_type(4)));
constexpr int BM = 256, BK = 64, HALF = 128, HTB = HALF * BK * 2  , STAGE_BYTES = 8 * HTB, NXCD = 8, WGM = 8;

__host__ __device__ __forceinline__ int lds_byte(int r, int c) { const int st = (r >> 4) * 2 + (c >> 5), rr = r & 15, cc = c & 31, ob = rr * 64 + cc * 2; return st * 1024 + (ob ^ (((ob >> 9) & 1) << 5)); }
__host__ __device__ __forceinline__ void stage_rc(int b, int& R, int& C) { const int st = b / 1024, sb = b % 1024, swz = sb ^ (((sb >> 9) & 1) << 5); R = (st >> 1) * 16 + swz / 64; C = (st & 1) * 32 + (swz % 64) / 2; }
__host__ __device__ __forceinline__ int perm32(int rho) { const int n = rho >> 4, i = rho & 15; return 8 * (i >> 2) + 4 * n + (i & 3); }

struct Unit { int pm, pn; };
struct Gemm { const bf16_t* A; const bf16_t* Bt; int M, N, K; };

struct StaticOrder {
    int nM, nN, nwg, G, c;
    __host__ __device__ void init(int M, int N, int G_, int c_) { nM = M / BM; nN = N / BM; nwg = nM * nN; G = G_; c = c_; }
    __host__ __device__ bool next(int i, Unit& u) const {
        const long L = (long)i * G + c; if (L >= nwg) return false;
        int wgid = (int)L; { const int q = nwg / NXCD, r = nwg % NXCD, xcd = wgid % NXCD, off = wgid / NXCD; wgid = (xcd < r ? xcd * (q + 1) : r * (q + 1) + (xcd - r) * q) + off; }
        const int nig = WGM * nN, gid = wgid / nig, fm = gid * WGM, gsz = (nM - fm) < WGM ? (nM - fm) : WGM;
        u.pm = fm + ((wgid % nig) % gsz); u.pn = (wgid % nig) / gsz; return true;
    }
    __device__ __forceinline__ void a_ready(const Unit&) const {}
    __device__ __forceinline__ void done(const Unit&) const {}
};

__device__ __forceinline__ unsigned cvt_pk_bf16(float lo, float hi) { unsigned r; asm volatile("v_cvt_pk_bf16_f32 %0, %1, %2" : "=v"(r) : "v"(lo), "v"(hi)); return r; }
template <class Epi, class Sched, bool ALIGN_EPI = false, bool SP2 = false>
__device__ __forceinline__ void gemm_phase(PG8_LAS unsigned char* lds, const Gemm g, const Sched& S, const Epi& E) {
    const int tid = threadIdx.x, wid = __builtin_amdgcn_readfirstlane(tid >> 6), lane = tid & 63, wr = wid >> 2, wc = wid & 3, fr = lane & 15, fq = lane >> 4;
    const int K = g.K, nt = K / BK;
    unsigned voffA[2], voffB[2];
#pragma unroll
    for (int i = 0; i < 2; ++i) { int R, C; stage_rc(tid * 16 + i * 8192, R, C); const int Rb = Epi::PERM ? ((R & ~31) + perm32(R & 31)) : R;
        voffA[i] = (unsigned)(R * K + C) * 2u; voffB[i] = (unsigned)(Rb * K + C) * 2u; }
    const size_t kstep = (size_t)(BK * 2);
    const size_t hstep = (size_t)HALF * K * 2;
    const size_t tstep = 2 * hstep;
    const unsigned ldsw = (unsigned)wid * 1024u;
    const int aoff = lds_byte(wr * 64 + fr, fq * 8), boff = lds_byte(wc * 32 + fr, fq * 8);
#define PG8_SA(b, h) (((b) * 2 + (h)) * HTB)
#define PG8_SB(b, h) ((4 + (b) * 2 + (h)) * HTB)
#define PG8_STAGE(bufoff, gbase, voff) do { _Pragma("unroll") for (int _i = 0; _i < 2; ++_i) \
        __builtin_amdgcn_global_load_lds((const unsigned*)((const char*)(gbase) + (voff)[_i]), (PG8_LAS unsigned*)(lds + (bufoff) + ldsw + _i * 8192), 16, 0, 0); } while (0)
#define PG8_LDA(dst, b, h) do { _Pragma("unroll") for (int m = 0; m < 4; ++m) _Pragma("unroll") for (int k = 0; k < 2; ++k) dst[m][k] = *(const PG8_LAS bf16x8*)(lds + PG8_SA(b, h) + aoff + m * 2048 + k * 1024); } while (0)
#define PG8_LDB(dst, b, h) do { _Pragma("unroll") for (int n = 0; n < 2; ++n) _Pragma("unroll") for (int k = 0; k < 2; ++k) dst[n][k] = *(const PG8_LAS bf16x8*)(lds + PG8_SB(b, h) + boff + n * 2048 + k * 1024); } while (0)
#define PG8_MMA(ai, bj, At, Bt) do { __builtin_amdgcn_s_setprio(1); _Pragma("unroll") for (int m = 0; m < 4; ++m) _Pragma("unroll") for (int n = 0; n < 2; ++n) _Pragma("unroll") for (int k = 0; k < 2; ++k) \
        acc[ai][bj][m][n] = __builtin_amdgcn_mfma_f32_16x16x32_bf16(Bt[n][k], At[m][k], acc[ai][bj][m][n], 0, 0, 0); __builtin_amdgcn_s_setprio(0); } while (0)
#define PG8_WAIT_V(n) asm volatile("s_waitcnt vmcnt(" #n ")" ::: "memory")
#define PG8_WAIT_L(n) asm volatile("s_waitcnt lgkmcnt(" #n ")" ::: "memory")
#define PG8_BAR __builtin_amdgcn_s_barrier()
#define PG8_SCHED __builtin_amdgcn_sched_barrier(0)
    Unit cur, nxt; int ui = 0;
    if (!S.next(0, cur)) return;
    f32x4 acc[2][2][4][2];
#pragma unroll
    for (int a = 0; a < 2; ++a)
#pragma unroll
        for (int b = 0; b < 2; ++b)
#pragma unroll
            for (int m = 0; m < 4; ++m)
#pragma unroll
                for (int n = 0; n < 2; ++n) acc[a][b][m][n] = (f32x4){0.f, 0.f, 0.f, 0.f};
    bf16x8 At[4][2], B0[2][2], B1[2][2];
    const char* cA = (const char*)g.A + (size_t)cur.pm * tstep; const char* cB = (const char*)g.Bt + (size_t)cur.pn * tstep;
    S.a_ready(cur);
    if constexpr (SP2) {
        PG8_STAGE(PG8_SB(0, 0), cB, voffB); PG8_STAGE(PG8_SB(0, 1), cB + hstep, voffB); PG8_STAGE(PG8_SA(0, 0), cA, voffA); PG8_STAGE(PG8_SA(0, 1), cA + hstep, voffA);
        if (wr == 1) PG8_BAR;
        PG8_WAIT_V(2); PG8_BAR;
        PG8_STAGE(PG8_SB(1, 0), cB + kstep, voffB); PG8_STAGE(PG8_SA(1, 0), cA + kstep, voffA); PG8_STAGE(PG8_SB(1, 1), cB + hstep + kstep, voffB);
        PG8_WAIT_V(6); PG8_BAR;
    } else {
        PG8_STAGE(PG8_SB(0, 0), cB, voffB); PG8_STAGE(PG8_SA(0, 0), cA, voffA); PG8_STAGE(PG8_SB(0, 1), cB + hstep, voffB); PG8_STAGE(PG8_SA(0, 1), cA + hstep, voffA);
        if (wr == 1) PG8_BAR;
        PG8_WAIT_V(4); PG8_BAR;
        PG8_STAGE(PG8_SB(1, 0), cB + kstep, voffB); PG8_STAGE(PG8_SA(1, 0), cA + kstep, voffA); PG8_STAGE(PG8_SB(1, 1), cB + hstep + kstep, voffB);
        PG8_WAIT_V(6); PG8_BAR;
    }
    for (;;) {
        const bool has_next = S.next(ui + 1, nxt);
        const char* nA = has_next ? (const char*)g.A + (size_t)nxt.pm * tstep : cA; const char* nB = has_next ? (const char*)g.Bt + (size_t)nxt.pn * tstep : cB;
        for (int t = 0; t < nt; t += 2) {
            const bool last = (t == nt - 2);
            const char* a1 = cA + (size_t)(t + 1) * kstep;
            const char* a2 = last ? nA : cA + (size_t)(t + 2) * kstep; const char* b2 = last ? nB : cB + (size_t)(t + 2) * kstep;
            const char* a3 = a2 + kstep; const char* b3 = b2 + kstep;
            if (last && has_next) S.a_ready(nxt);
            if constexpr (SP2) {
            PG8_LDB(B0, 0, 0); PG8_LDB(B1, 0, 1); PG8_SCHED; PG8_LDA(At, 0, 0); PG8_STAGE(PG8_SA(1, 1), a1 + hstep, voffA);
            PG8_WAIT_V(8); PG8_WAIT_L(0); PG8_BAR; PG8_MMA(0, 0, At, B0); PG8_MMA(0, 1, At, B1); PG8_BAR; PG8_SCHED;
            PG8_LDA(At, 0, 1); PG8_STAGE(PG8_SB(0, 0), b2, voffB); PG8_STAGE(PG8_SB(0, 1), b2 + hstep, voffB); PG8_STAGE(PG8_SA(0, 0), a2, voffA);
            PG8_WAIT_V(8); PG8_WAIT_L(0); PG8_BAR; PG8_MMA(1, 0, At, B0); PG8_MMA(1, 1, At, B1); PG8_BAR; PG8_SCHED;
            PG8_LDB(B0, 1, 0); PG8_LDB(B1, 1, 1); PG8_SCHED; PG8_LDA(At, 1, 0); PG8_STAGE(PG8_SA(0, 1), a2 + hstep, voffA);
            PG8_WAIT_V(8); PG8_WAIT_L(0); PG8_BAR; PG8_MMA(0, 0, At, B0); PG8_MMA(0, 1, At, B1); PG8_BAR; PG8_SCHED;
            PG8_LDA(At, 1, 1); PG8_STAGE(PG8_SB(1, 0), b3, voffB); PG8_STAGE(PG8_SB(1, 1), b3 + hstep, voffB); PG8_STAGE(PG8_SA(1, 0), a3, voffA);
            PG8_WAIT_V(8); PG8_WAIT_L(0); PG8_BAR; PG8_MMA(1, 0, At, B0); PG8_MMA(1, 1, At, B1); PG8_BAR; PG8_SCHED;
            } else {
            PG8_LDB(B0, 0, 0); PG8_SCHED; PG8_LDA(At, 0, 0); PG8_STAGE(PG8_SA(1, 1), a1 + hstep, voffA);
            PG8_WAIT_L(8); PG8_BAR; PG8_WAIT_L(0); PG8_MMA(0, 0, At, B0); PG8_BAR; PG8_SCHED;
            PG8_LDB(B1, 0, 1); PG8_STAGE(PG8_SB(0, 0), b2, voffB);
            PG8_BAR; PG8_WAIT_L(0); PG8_MMA(0, 1, At, B1); PG8_BAR;
            PG8_LDA(At, 0, 1); PG8_STAGE(PG8_SA(0, 0), a2, voffA);
            PG8_BAR; PG8_WAIT_L(0); PG8_MMA(1, 0, At, B0); PG8_BAR; PG8_SCHED;
            PG8_STAGE(PG8_SB(0, 1), b2 + hstep, voffB);
            PG8_WAIT_V(6); PG8_BAR; PG8_MMA(1, 1, At, B1); PG8_BAR;
            PG8_LDB(B0, 1, 0); PG8_SCHED; PG8_LDA(At, 1, 0); PG8_STAGE(PG8_SA(0, 1), a2 + hstep, voffA);
            PG8_WAIT_L(8); PG8_BAR; PG8_WAIT_L(0); PG8_MMA(0, 0, At, B0); PG8_BAR; PG8_SCHED;
            PG8_LDB(B1, 1, 1); PG8_STAGE(PG8_SB(1, 0), b3, voffB);
            PG8_BAR; PG8_WAIT_L(0); PG8_MMA(0, 1, At, B1); PG8_BAR;
            PG8_LDA(At, 1, 1); PG8_STAGE(PG8_SA(1, 0), a3, voffA);
            PG8_BAR; PG8_WAIT_L(0); PG8_MMA(1, 0, At, B0); PG8_BAR; PG8_SCHED;
            PG8_STAGE(PG8_SB(1, 1), b3 + hstep, voffB);
            PG8_WAIT_V(6); PG8_BAR; PG8_MMA(1, 1, At, B1); PG8_BAR;
            }
        }
        if constexpr (ALIGN_EPI) { if (wr == 0) PG8_BAR; }
        if constexpr (!Epi::AFTER_DRAIN) { E(acc, cur, wr, wc, fr, fq); S.done(cur); }
        if (!has_next) break;
#pragma unroll
        for (int a = 0; a < 2; ++a)
#pragma unroll
            for (int b = 0; b < 2; ++b)
#pragma unroll
                for (int m = 0; m < 4; ++m)
#pragma unroll
                    for (int n = 0; n < 2; ++n) acc[a][b][m][n] = (f32x4){0.f, 0.f, 0.f, 0.f};
        cur = nxt; cA = nA; cB = nB; ++ui;
        if constexpr (ALIGN_EPI) { if (wr == 1) PG8_BAR; }
    }
    PG8_WAIT_V(0);
    if constexpr (!ALIGN_EPI) { if (wr == 0) PG8_BAR; }
    PG8_BAR;
    if constexpr (Epi::AFTER_DRAIN) { E.fused(acc, cur, wr, wc, fr, fq, lds, wid, lane); S.done(cur); }
#undef PG8_SA
#undef PG8_SB
#undef PG8_STAGE
#undef PG8_LDA
#undef PG8_LDB
#undef PG8_MMA
#undef PG8_WAIT_V
#undef PG8_WAIT_L
#undef PG8_BAR
#undef PG8_SCHED
}
}

#ifndef DUP
#define DUP 0
#endif
#define DI __device__ __forceinline__
#define LAS __attribute__((address_space(3)))
typedef unsigned short bf16_t;
typedef short bf16x8 __attribute__((ext_vector_type(8)));
typedef float f32x4 __attribute__((ext_vector_type(4)));
typedef float f32x16 __attribute__((ext_vector_type(16)));
typedef unsigned u32x4 __attribute__((ext_vector_type(4)));
typedef unsigned u32x2 __attribute__((ext_vector_type(2)));
typedef float f32x2_t __attribute__((ext_vector_type(2)));
typedef __bf16 bf16x2_t __attribute__((ext_vector_type(2)));

constexpr int D = 1024, NB = 8, SEQ = 4096, CTX = 256, FF = 4096;
constexpr int ML = NB * SEQ, MC = NB * CTX, MT = ML + MC;
constexpr size_t MiB = 1u << 20;
constexpr size_t WS_MOD = 0, WS_ZF = 1 * MiB, WS_RK = 9 * MiB, WS_LR = 14 * MiB, WS_W = 20 * MiB, WS_H2 = 56 * MiB, WS_BIG = 192 * MiB, WS_G = 430 * MiB;
constexpr size_t W_MIX = WS_W, W_O = WS_W + 14 * MiB, W_G2 = WS_W + 16 * MiB, W_1 = WS_W + 17 * MiB, W_2 = WS_W + 25 * MiB;
constexpr int LDS_BYTES = 147456;
constexpr size_t WS_BAR = 983040;
constexpr int NTHREADS = 512;

struct Args { const float* in[35]; float* out; unsigned char* ws; int lo, hi; };

DI float bf2f(bf16_t v) { return __uint_as_float(((unsigned)v) << 16); }
DI unsigned cvtpk(float lo, float hi) { f32x2_t v = {lo, hi}; bf16x2_t b = __builtin_convertvector(v, bf16x2_t); return __builtin_bit_cast(unsigned, b); }
DI bf16_t f2bf(float x) { return (bf16_t)(cvtpk(x, 0.f) & 0xffffu); }
DI float wave_sum(float v) {
#pragma unroll
    for (int o = 1; o < 64; o <<= 1) v += __shfl_xor(v, o);
    return v;
}
DI float sigmoidf_(float x) { return 1.f / (1.f + __expf(-x)); }
DI float softplusf_(float x) { return fmaxf(x, 0.f) + log1pf(__expf(-fabsf(x))); }
DI int crow(int i, int h) { return (i & 3) + 8 * (i >> 2) + 4 * h; }
#define MFMA32(a, b, c) __builtin_amdgcn_mfma_f32_32x32x16_bf16((a), (b), (c), 0, 0, 0)

DI void mma_tile(f32x16& acc, const bf16_t* A, int lda, const bf16_t* Bt, int ldb, int ksteps, int lane) {
    const int rho = lane & 31, h = lane >> 5;
    const bf16_t* ap = A + rho * lda + 8 * h; const bf16_t* bp = Bt + rho * ldb + 8 * h;
    for (int s = 0; s < ksteps; ++s) {
        bf16x8 av = *(const bf16x8*)(ap + 16 * s); bf16x8 bv = *(const bf16x8*)(bp + 16 * s);
        acc = MFMA32(av, bv, acc);
    }
}

template <class Inner> struct Epi {
    static constexpr bool PERM = true, AFTER_DRAIN = false;
    Inner in;
    DI void operator()(const pg8::f32x4 (&acc)[2][2][4][2], const pg8::Unit& u, int wr, int wc, int fr, int fq) const {
        const int row0 = u.pm * 256 + wr * 64 + fr, col0 = u.pn * 256 + wc * 32 + 8 * fq;
#pragma unroll
        for (int ai = 0; ai < 2; ++ai)
#pragma unroll
            for (int m = 0; m < 4; ++m) {
                const int row = row0 + ai * 128 + m * 16;
#pragma unroll
                for (int bj = 0; bj < 2; ++bj) in.store8(row, col0 + bj * 128, acc[ai][bj][m][0], acc[ai][bj][m][1]);
            }
    }
};
DI u32x4 pack8(f32x4 a, f32x4 b) { u32x4 w; w.x = cvtpk(a[0], a[1]); w.y = cvtpk(a[2], a[3]); w.z = cvtpk(b[0], b[1]); w.w = cvtpk(b[2], b[3]); return w; }

template <int ACT> struct InStore {
    bf16_t* O; int ldc;
    DI void store8(int row, int col, f32x4 a, f32x4 b) const {
        if (ACT == 1) {
#pragma unroll
            for (int j = 0; j < 4; ++j) { float x = fmaxf(a[j], 0.f); a[j] = x * x; float y = fmaxf(b[j], 0.f); b[j] = y * y; }
        }
        *(u32x4*)(O + (size_t)row * ldc + col) = pack8(a, b);
    }
};
struct InNaQkv {
    bf16_t* QK; bf16_t* VTL; bf16_t* VTC;
    DI void store8(int row, int col, f32x4 a, f32x4 b) const {
        if (col < 2048) {
            const float sc = col < 1024 ? 0.18033688011112042f : 1.f;
            *(u32x4*)(QK + (size_t)row * 2048 + col) = pack8(a * sc, b * sc);
        } else {
            const int c = col - 2048, hd = c >> 6, d0 = c & 63;
            bf16_t* p; size_t ld;
            if (row < ML) { const int b_ = row >> 12, t = row & 4095; p = VTL + ((size_t)((b_ * 16 + hd) * 64 + d0)) * 4096 + t; ld = 4096; }
            else { const int r2 = row - ML, b_ = r2 >> 8, t = r2 & 255; p = VTC + ((size_t)((b_ * 16 + hd) * 64 + d0)) * 256 + t; ld = 256; }
#pragma unroll
            for (int j = 0; j < 4; ++j) { p[(size_t)j * ld] = f2bf(a[j]); p[(size_t)(j + 4) * ld] = f2bf(b[j]); }
        }
    }
};
struct InResid {
    const float* sl; const float* sc; float* dl; float* dc; const float* gate;
    DI void store8(int row, int col, f32x4 a, f32x4 b) const {
        const float* s; float* d; int mi;
        if (row < ML) { s = sl + (size_t)row * 1024 + col; d = dl + (size_t)row * 1024 + col; mi = row >> 12; }
        else { s = sc + (size_t)(row - ML) * 1024 + col; d = dc + (size_t)(row - ML) * 1024 + col; mi = 8; }
        const float* g = gate + (size_t)mi * 6144 + col;
        const f32x4 g0 = *(const f32x4*)g, g1 = *(const f32x4*)(g + 4);
        const f32x4 x0 = *(const f32x4*)s, x1 = *(const f32x4*)(s + 4);
        *(f32x4*)d = x0 + g0 * a; *(f32x4*)(d + 4) = x1 + g1 * b;
    }
};
struct InGlaIn {
    bf16_t* P; float* LR;
    DI void store8(int row, int col, f32x4 a, f32x4 b) const {
        if (col < 3072) {
            const float sc = col < 512 ? 0.08838834764831845f : 1.f;
            *(u32x4*)(P + (size_t)row * 3072 + col) = pack8(a * sc, b * sc);
        } else if (col < 3104) {
            float* p = LR + (size_t)row * 32 + (col - 3072);
            *(f32x4*)p = a; *(f32x4*)(p + 4) = b;
        }
    }
};
struct InRwL1 {
    bf16_t* RKV; bf16_t* SG; bf16_t* TWAA;
    DI void store8(int row, int col, f32x4 a, f32x4 b) const {
        if (col < 3072) { *(u32x4*)(RKV + (size_t)row * 3072 + col) = pack8(a, b); }
        else if (col < 3328) {
#pragma unroll
            for (int j = 0; j < 4; ++j) { a[j] = sigmoidf_(a[j]); b[j] = sigmoidf_(b[j]); }
            *(u32x4*)(SG + (size_t)row * 256 + (col - 3072)) = pack8(a, b);
        } else {
            const int c = col - 3328;
            if (c < 128) {
#pragma unroll
                for (int j = 0; j < 4; ++j) { a[j] = tanhf(a[j]); b[j] = tanhf(b[j]); }
            }
            *(u32x4*)(TWAA + (size_t)row * 256 + c) = pack8(a, b);
        }
    }
};

template <class Inner> DI void run_gemm(LAS unsigned char* lds, const bf16_t* A, const bf16_t* Bt, int M, int N, int K, const Inner& in) {
    int Kr = K; asm volatile("" : "+s"(Kr));
    pg8::Gemm g{A, Bt, M, N, Kr}; pg8::StaticOrder S; S.init(M, N, (int)gridDim.x, (int)blockIdx.x);
    Epi<Inner> E{in};
#ifndef NO_GEMM
    pg8::gemm_phase<Epi<Inner>, pg8::StaticOrder, true, true>(lds, g, S, E);
#endif
    __syncthreads();
}

DI void conv_item(const float* W, int ldw, int Kv, int Nv, const float* mix, int mode, bf16_t* WT, int ldt, int row_off, int col_off, float* scr, int kb, int nb, int lane) {
    const int k0 = 64 * kb, n0 = 32 * nb;
#pragma unroll 8
    for (int i = 0; i < 32; ++i) {
        const int kk = 2 * i + (lane >> 5), k = k0 + kk, n = n0 + (lane & 31);
        float v = (k < Kv && n < Nv) ? W[(size_t)k * ldw + n] : 0.f;
        if (mode) { const float m = (k < Kv) ? mix[k] : 0.f; v *= (mode == 1) ? (1.f - m) : m; }
        scr[kk * 33 + (lane & 31)] = v;
    }
    __builtin_amdgcn_s_waitcnt(0xc07f); __builtin_amdgcn_wave_barrier();
    const int c = lane & 7;
#pragma unroll
    for (int j = 0; j < 4; ++j) {
        const int n = (lane >> 3) + 8 * j; const float* s = scr + (8 * c) * 33 + n;
        u32x4 o; o.x = cvtpk(s[0 * 33], s[1 * 33]); o.y = cvtpk(s[2 * 33], s[3 * 33]); o.z = cvtpk(s[4 * 33], s[5 * 33]); o.w = cvtpk(s[6 * 33], s[7 * 33]);
        *(u32x4*)(WT + (size_t)(row_off + n0 + n) * ldt + col_off + k0 + 8 * c) = o;
    }
    __builtin_amdgcn_s_waitcnt(0xc07f); __builtin_amdgcn_wave_barrier();
}
DI void conv_job(const float* W, int ldw, int Kv, int Nv, int Kp, int Np, const float* mix, int mode, bf16_t* WT, int ldt, int row_off, int col_off, float* scr, int gw, int ngw, int lane) {
    const int nkb = Kp / 64, nnb = Np / 32, nit = nkb * nnb;
    for (int it = gw; it < nit; it += ngw) conv_item(W, ldw, Kv, Nv, mix, mode, WT, ldt, row_off, col_off, scr, it / nnb, it % nnb, lane);
}

DI void norm_row(const float* xr, const f32x4 (&gs)[4], const f32x4 (&sh)[4], int lane, f32x4 (&out)[4]) {
    f32x4 v[4]; float s = 0.f;
#pragma unroll
    for (int j = 0; j < 4; ++j) { v[j] = *(const f32x4*)(xr + 4 * lane + 256 * j); s += (v[j].x * v[j].x + v[j].y * v[j].y) + (v[j].z * v[j].z + v[j].w * v[j].w); }
    s = wave_sum(s);
    const float rinv = rsqrtf(s * (1.f / 1024.f) + 1e-6f);
#pragma unroll
    for (int j = 0; j < 4; ++j) out[j] = v[j] * rinv * gs[j] + sh[j];
}
DI void store_row_bf16(bf16_t* o, const f32x4 (&v)[4], int lane) {
#pragma unroll
    for (int j = 0; j < 4; ++j) { u32x2 w; w.x = cvtpk(v[j].x, v[j].y); w.y = cvtpk(v[j].z, v[j].w); *(u32x2*)(o + 4 * lane + 256 * j) = w; }
}
DI void phase_prenorm(const float* xl, const float* xc, const float* g, const float* modl  , int shift_chunk, bf16_t* H, int ldh, bool with_hs, int Mrows, int gw, int ngw, int lane) {
#define XROW(r) ((r) < ML ? xl + (size_t)(r) * 1024 : xc + (size_t)((r) - ML) * 1024)
    if (!with_hs) {
        const int nstrips = Mrows / 4;
        for (int st = gw; st < nstrips; st += ngw) {
            const int row0 = 4 * st;
            const int mi = row0 < ML ? row0 >> 12 : 8;
            const float* mp = modl + (size_t)mi * 6144 + shift_chunk * 1024;
            f32x4 v[4][4]; float ss[4];
#pragma unroll
            for (int r = 0; r < 4; ++r) { const float* xr = XROW(row0 + r);
#pragma unroll
                for (int j = 0; j < 4; ++j) v[r][j] = *(const f32x4*)(xr + 4 * lane + 256 * j); }
            f32x4 gs[4], sh[4];
#pragma unroll
            for (int j = 0; j < 4; ++j) { const int c = 4 * lane + 256 * j; sh[j] = *(const f32x4*)(mp + c); const f32x4 sc = *(const f32x4*)(mp + 1024 + c); gs[j] = *(const f32x4*)(g + c) * (sc + 1.f); }
#pragma unroll
            for (int r = 0; r < 4; ++r) { float s = 0.f;
#pragma unroll
                for (int j = 0; j < 4; ++j) s += (v[r][j].x * v[r][j].x + v[r][j].y * v[r][j].y) + (v[r][j].z * v[r][j].z + v[r][j].w * v[r][j].w);
                ss[r] = s; }
#pragma unroll
            for (int o = 1; o < 64; o <<= 1) {
#pragma unroll
                for (int r = 0; r < 4; ++r) ss[r] += __shfl_xor(ss[r], o);
            }
#pragma unroll
            for (int r = 0; r < 4; ++r) { const float rinv = rsqrtf(ss[r] * (1.f / 1024.f) + 1e-6f); f32x4 o[4];
#pragma unroll
                for (int j = 0; j < 4; ++j) o[j] = v[r][j] * rinv * gs[j] + sh[j];
                store_row_bf16(H + (size_t)(row0 + r) * ldh, o, lane); }
        }
    } else {
        const int nstrips = Mrows / 8;
        for (int st = gw; st < nstrips; st += ngw) {
            const int row0 = 8 * st;
            int mi, seg0, seg1;
            if (row0 < ML) { mi = row0 >> 12; seg0 = row0 & ~4095; seg1 = seg0 + 4096; } else { mi = 8; seg0 = ML + ((row0 - ML) & ~255); seg1 = seg0 + 256; }
            const float* mp = modl + (size_t)mi * 6144 + shift_chunk * 1024;
            f32x4 gs[4], sh[4];
#pragma unroll
            for (int j = 0; j < 4; ++j) { const int c = 4 * lane + 256 * j; sh[j] = *(const f32x4*)(mp + c); const f32x4 sc = *(const f32x4*)(mp + 1024 + c); gs[j] = *(const f32x4*)(g + c) * (sc + 1.f); }
            f32x4 prev[4], cur[4], nxt[4];
            if (row0 > seg0) norm_row(XROW(row0 - 1), gs, sh, lane, prev); else { for (int j = 0; j < 4; ++j) prev[j] = (f32x4){0.f, 0.f, 0.f, 0.f}; }
            norm_row(XROW(row0), gs, sh, lane, cur);
            for (int r = row0; r < row0 + 8; ++r) {
                if (r + 1 < seg1) norm_row(XROW(r + 1), gs, sh, lane, nxt); else { for (int j = 0; j < 4; ++j) nxt[j] = (f32x4){0.f, 0.f, 0.f, 0.f}; }
                store_row_bf16(H + (size_t)r * ldh, cur, lane);
                f32x4 hs[4];
#pragma unroll
                for (int j = 0; j < 4; ++j) hs[j] = (prev[j] + nxt[j]) * 0.5f;
                store_row_bf16(H + (size_t)r * ldh + 1024, hs, lane);
#pragma unroll
                for (int j = 0; j < 4; ++j) { prev[j] = cur[j]; cur[j] = nxt[j]; }
            }
        }
    }
#undef XROW
}

DI void phase_mod(const Args& a, float* lds, int tid) {
    float* sc = lds;
    float* red = lds + 1024 * 12;
    const float* c = a.in[1]; const float* cctx = a.in[3]; const float* ada_w = a.in[4]; const float* ada_b = a.in[5];
    float* mod = (float*)(a.ws + WS_MOD);
    for (int idx = tid; idx < 9 * 1024; idx += NTHREADS) { const int j = idx >> 10, k = idx & 1023; const float v = j < 8 ? c[j * 1024 + k] : cctx[k]; sc[k * 12 + j] = v * sigmoidf_(v); }
    __syncthreads();
    for (int unit = blockIdx.x; unit < 768; unit += gridDim.x) {
        const int l = unit / 192, n0 = (unit % 192) * 32, col = tid & 31, ks = tid >> 5;
        const float* w = ada_w + ((size_t)l * 1024 + ks * 64) * 6144 + n0 + col;
        float acc[9];
#pragma unroll
        for (int j = 0; j < 9; ++j) acc[j] = 0.f;
#pragma unroll 32
        for (int kk = 0; kk < 64; ++kk) {
            const float wv = w[(size_t)kk * 6144]; const float* s = sc + (ks * 64 + kk) * 12;
            const f32x4 s0 = *(const f32x4*)s, s1 = *(const f32x4*)(s + 4); const float s8 = s[8];
            acc[0] += s0.x * wv; acc[1] += s0.y * wv; acc[2] += s0.z * wv; acc[3] += s0.w * wv;
            acc[4] += s1.x * wv; acc[5] += s1.y * wv; acc[6] += s1.z * wv; acc[7] += s1.w * wv; acc[8] += s8 * wv;
        }
#pragma unroll
        for (int j = 0; j < 9; ++j) red[(ks * 9 + j) * 32 + col] = acc[j];
        __syncthreads();
        if (tid < 288) {
            const int j = tid >> 5, cc = tid & 31; float s = ada_b[l * 6144 + n0 + cc];
#pragma unroll
            for (int k2 = 0; k2 < 16; ++k2) s += red[(k2 * 9 + j) * 32 + cc];
            mod[((size_t)(l * 9 + j)) * 6144 + n0 + cc] = s;
        }
        __syncthreads();
    }
}

DI void attn_unit(const bf16_t* QK, const bf16_t* VTL, const bf16_t* VTC, bf16_t* O, const float* tbl, int b, int hd, int r, int cq, int lane) {
    const int n = lane & 31, h = lane >> 5;
    const bool lat = r >= 0;
    const int qrow0 = lat ? b * 4096 + r * 64 : ML + b * 256 + cq * 64;
    const int pin = (n & 0x13) | ((n & 4) << 1) | ((n & 8) >> 1);
    bf16x8 bq[2][4];
#pragma unroll
    for (int qb = 0; qb < 2; ++qb)
#pragma unroll
        for (int s = 0; s < 4; ++s) bq[qb][s] = *(const bf16x8*)(QK + (size_t)(qrow0 + 32 * qb + n) * 2048 + hd * 64 + 32 * h + 8 * s);
    f32x16 o[2][2];
#pragma unroll
    for (int x = 0; x < 2; ++x)
#pragma unroll
        for (int y = 0; y < 2; ++y)
#pragma unroll
            for (int i = 0; i < 16; ++i) o[x][y][i] = 0.f;
    float mrun[2] = {-1e30f, -1e30f}, lrun[2] = {0.f, 0.f};
    const int r0 = lat ? min(max(r - 4, 0), 56) : 0;
    const int nblk = lat ? 24 : 8;
    const bf16_t* vtc = VTC + (size_t)((b * 16 + hd) * 64) * 256;
    const bf16_t* vtl = VTL + (size_t)((b * 16 + hd) * 64) * 4096;
    for (int blk = 0; blk < nblk; ++blk) {
        int krow0, ldv, kc0 = 0, ridx = 0; const bf16_t* vt;
        const bool lb_ = blk >= 8;
        if (!lb_) { krow0 = ML + b * 256 + blk * 32; vt = vtc + blk * 32; ldv = 256; }
        else { const int lb = blk - 8, kr = r0 + (lb >> 1); kc0 = (lb & 1) * 32; krow0 = b * 4096 + kr * 64 + kc0; vt = vtl + kr * 64 + kc0; ldv = 4096; ridx = kr - r + 7; }
        bf16x8 ka[4];
#pragma unroll
        for (int s = 0; s < 4; ++s) ka[s] = *(const bf16x8*)(QK + (size_t)(krow0 + pin) * 2048 + 1024 + hd * 64 + 32 * h + 8 * s);
        bf16x8 va[2][2];
#pragma unroll
        for (int db = 0; db < 2; ++db)
#pragma unroll
            for (int s2 = 0; s2 < 2; ++s2) va[db][s2] = *(const bf16x8*)(vt + (size_t)(32 * db + n) * ldv + 16 * s2 + 8 * h);
        f32x16 sa[2];
#pragma unroll
        for (int qb = 0; qb < 2; ++qb) {
#pragma unroll
            for (int i = 0; i < 16; ++i) sa[qb][i] = 0.f;
#pragma unroll
            for (int s = 0; s < 4; ++s) sa[qb] = MFMA32(ka[s], bq[qb][s], sa[qb]);
        }
        bf16x8 pb[2][2];
#pragma unroll
        for (int qb = 0; qb < 2; ++qb) {
            if (lb_) {
                const int qc = 32 * qb + n, cs = min(max(qc - 8, 0), 48);
                const float* bp = tbl + ridx * 128 + 48 + 15 + kc0 + 8 * h - qc;
                const int okb = kc0 + 8 * h - cs;
#pragma unroll
                for (int i = 0; i < 16; ++i) {
                    const int ko = (i & 7) + 16 * (i >> 3);
                    const bool ok = (unsigned)(okb + ko) < 16u;
                    const float bv = bp[ko];
                    sa[qb][i] = ok ? sa[qb][i] + bv : -1e30f;
                }
            }
            float bm = sa[qb][0];
#pragma unroll
            for (int i = 1; i < 16; ++i) bm = fmaxf(bm, sa[qb][i]);
            bm = fmaxf(bm, __shfl_xor(bm, 32));
            const float mnew = fmaxf(mrun[qb], bm);
            const float alpha = __builtin_amdgcn_exp2f(mrun[qb] - mnew);
            mrun[qb] = mnew;
            float ps = 0.f;
#pragma unroll
            for (int i = 0; i < 16; ++i) { const float p = __builtin_amdgcn_exp2f(sa[qb][i] - mnew); sa[qb][i] = p; ps += p; }
            lrun[qb] = lrun[qb] * alpha + ps;
            if (__builtin_amdgcn_ballot_w64(alpha != 1.f) != 0ull) {
#pragma unroll
                for (int db = 0; db < 2; ++db)
#pragma unroll
                    for (int i = 0; i < 16; ++i) o[db][qb][i] *= alpha;
            }
#pragma unroll
            for (int s2 = 0; s2 < 2; ++s2) {
                u32x4 w; w.x = cvtpk(sa[qb][8 * s2 + 0], sa[qb][8 * s2 + 1]); w.y = cvtpk(sa[qb][8 * s2 + 2], sa[qb][8 * s2 + 3]);
                w.z = cvtpk(sa[qb][8 * s2 + 4], sa[qb][8 * s2 + 5]); w.w = cvtpk(sa[qb][8 * s2 + 6], sa[qb][8 * s2 + 7]);
                pb[qb][s2] = __builtin_bit_cast(bf16x8, w);
            }
        }
#pragma unroll
        for (int db = 0; db < 2; ++db)
#pragma unroll
            for (int qb = 0; qb < 2; ++qb)
#pragma unroll
                for (int s2 = 0; s2 < 2; ++s2) o[db][qb] = MFMA32(va[db][s2], pb[qb][s2], o[db][qb]);
    }
#pragma unroll
    for (int qb = 0; qb < 2; ++qb) {
        const float lt = lrun[qb] + __shfl_xor(lrun[qb], 32);
        const float inv = 1.f / lt;
        bf16_t* op = O + (size_t)(qrow0 + 32 * qb + n) * 1024 + hd * 64;
#pragma unroll
        for (int db = 0; db < 2; ++db)
#pragma unroll
            for (int g = 0; g < 4; ++g) {
                u32x2 w; w.x = cvtpk(o[db][qb][4 * g] * inv, o[db][qb][4 * g + 1] * inv); w.y = cvtpk(o[db][qb][4 * g + 2] * inv, o[db][qb][4 * g + 3] * inv);
                *(u32x2*)(op + 32 * db + 8 * g + 4 * h) = w;
            }
    }
}

DI void gla_gates(const float* LR, const float* wdec, const float* bdec, bf16_t* G, float* lds, int tid) {
    constexpr int RB = 64;
    float* lrs = lds;
    for (int bt = blockIdx.x; bt < MT / RB; bt += gridDim.x) {
        const int row0 = bt * RB;
        __syncthreads();
        for (int e = tid; e < RB * 32 / 4; e += NTHREADS) *(f32x4*)(lrs + 4 * e) = *(const f32x4*)(LR + (size_t)row0 * 32 + 4 * e);
        __syncthreads();
#pragma unroll 1
        for (int dir = 0; dir < 2; ++dir) {
            float wd[16];
#pragma unroll
            for (int r = 0; r < 16; ++r) wd[r] = wdec[(dir * 16 + r) * 512 + tid];
            const float bd = bdec[dir * 512 + tid];
            bf16_t* gp = G + ((size_t)dir * MT + row0) * 512 + tid;
#pragma unroll 4
            for (int rr = 0; rr < RB; ++rr) {
                const float* lp = lrs + rr * 32 + dir * 16;
                const f32x4 l0 = *(const f32x4*)lp, l1 = *(const f32x4*)(lp + 4), l2 = *(const f32x4*)(lp + 8), l3 = *(const f32x4*)(lp + 12);
                float z = bd;
                z += l0.x * wd[0] + l0.y * wd[1] + l0.z * wd[2] + l0.w * wd[3]; z += l1.x * wd[4] + l1.y * wd[5] + l1.z * wd[6] + l1.w * wd[7];
                z += l2.x * wd[8] + l2.y * wd[9] + l2.z * wd[10] + l2.w * wd[11]; z += l3.x * wd[12] + l3.y * wd[13] + l3.z * wd[14] + l3.w * wd[15];
                const float x = -z; const float sp = fmaxf(x, 0.f) + __logf(1.f + __expf(-fabsf(x)));
                gp[(size_t)rr * 512] = f2bf(sp * (-1.f / 16.f));
            }
        }
    }
    __syncthreads();
}
DI void gla_unit(const bf16_t* P, const bf16_t* G  , bf16_t* OUT  , unsigned char* lds, int unit, int tid) {
    const int lane = tid & 63, wid = __builtin_amdgcn_readfirstlane(tid >> 6);
    const int vs = unit & 3, dir = (unit >> 2) & 1, hd = (unit >> 3) & 3, b = unit >> 5;
    bf16_t* QE = (bf16_t*)lds;
    bf16_t* KE = QE + 64 * 136;
    bf16_t* ST = KE + 64 * 136;
    bf16_t* KDT = ST + 64 * 136;
    bf16_t* VT = KDT + 128 * 72;
    bf16_t* AM = VT + 64 * 72;
    float* Bc = (float*)(AM + 64 * 72);
    float* LRs = Bc + 64 * 132;
    float* GRP = LRs + 64 * 16;
    float* DEC = GRP + 4 * 128;
    const int dcol = tid & 127, lg = tid >> 7;
    const int col_q = hd * 128, col_k = 512 + hd * 128, col_v = 1024 + hd * 256 + vs * 64;
    f32x16 st;
#pragma unroll
    for (int i = 0; i < 16; ++i) st[i] = 0.f;
    const int svt = wid >> 2, sdt = wid & 3, rho = lane & 31, hh = lane >> 5;
    bf16_t* outp = OUT + (size_t)dir * MT * 1024;
    const int el = tid >> 3, eg = tid & 7;
    constexpr int NCHT = 68;
#define GROWQ(q, l) ((q) < 4 ? ML + b * 256 + (dir ? 255 - ((q) * 64 + (l)) : (q) * 64 + (l)) : b * 4096 + (dir ? 4095 - (((q) - 4) * 64 + (l)) : ((q) - 4) * 64 + (l)))
    u32x4 rq0, rq1, rk0, rk1, rv; bf16_t rg[16];
    const bf16_t* Gd = G + (size_t)dir * MT * 512;
#define GLA_FETCH(q) do { const size_t ro_ = (size_t)GROWQ(q, el) * 3072; \
        rq0 = *(const u32x4*)(P + ro_ + col_q + 16 * eg); rq1 = *(const u32x4*)(P + ro_ + col_q + 16 * eg + 8); \
        rk0 = *(const u32x4*)(P + ro_ + col_k + 16 * eg); rk1 = *(const u32x4*)(P + ro_ + col_k + 16 * eg + 8); \
        rv = *(const u32x4*)(P + ro_ + col_v + 8 * eg); \
        _Pragma("unroll") for (int li_ = 0; li_ < 16; ++li_) rg[li_] = Gd[(size_t)GROWQ(q, 16 * lg + li_) * 512 + hd * 128 + dcol]; } while (0)
    GLA_FETCH(0);
    for (int q = 0; q < NCHT; ++q) {
        const u32x4 cq0 = rq0, cq1 = rq1, ck0 = rk0, ck1 = rk1, cv = rv;
        { float run = 0.f;
#pragma unroll
          for (int li = 0; li < 16; ++li) { run += bf2f(rg[li]); Bc[(16 * lg + li) * 132 + dcol] = run; }
          GRP[lg * 128 + dcol] = run; }
        __syncthreads();
        if (q + 1 < NCHT) GLA_FETCH(q + 1);
        {
          const int g_ = el >> 4;
          float bv[16], bl[16];
#pragma unroll
          for (int e4 = 0; e4 < 4; ++e4) {
              const f32x4 t = *(const f32x4*)(Bc + el * 132 + 16 * eg + 4 * e4);
              f32x4 off = (f32x4){0.f, 0.f, 0.f, 0.f}, tot = (f32x4){0.f, 0.f, 0.f, 0.f};
#pragma unroll
              for (int g2 = 0; g2 < 4; ++g2) { const f32x4 gq = *(const f32x4*)(GRP + g2 * 128 + 16 * eg + 4 * e4); tot += gq; if (g2 < g_) off += gq; }
#pragma unroll
              for (int j = 0; j < 4; ++j) { bv[4 * e4 + j] = t[j] + off[j]; bl[4 * e4 + j] = tot[j]; }
          }
          if (el == 0) {
#pragma unroll
              for (int e = 0; e < 16; ++e) DEC[16 * eg + e] = __expf(bl[e]);
          }
          unsigned qw[8] = {cq0.x, cq0.y, cq0.z, cq0.w, cq1.x, cq1.y, cq1.z, cq1.w}, kw[8] = {ck0.x, ck0.y, ck0.z, ck0.w, ck1.x, ck1.y, ck1.z, ck1.w};
          unsigned qo[8], ko[8];
#pragma unroll
          for (int e2 = 0; e2 < 8; ++e2) {
              const float q0 = __uint_as_float(qw[e2] << 16), q1 = __uint_as_float(qw[e2] & 0xffff0000u), k0 = __uint_as_float(kw[e2] << 16), k1 = __uint_as_float(kw[e2] & 0xffff0000u);
              const float b0 = bv[2 * e2], b1 = bv[2 * e2 + 1];
              const float e0 = __expf(b0), e1 = __expf(b1);
              qo[e2] = cvtpk(q0 * e0, q1 * e1);
              ko[e2] = cvtpk(k0 * __builtin_amdgcn_rcpf(e0), k1 * __builtin_amdgcn_rcpf(e1));
              KDT[(16 * eg + 2 * e2) * 72 + el] = f2bf(k0 * __expf(bl[2 * e2] - b0)); KDT[(16 * eg + 2 * e2 + 1) * 72 + el] = f2bf(k1 * __expf(bl[2 * e2 + 1] - b1));
          }
          *(u32x4*)(QE + el * 136 + 16 * eg) = (u32x4){qo[0], qo[1], qo[2], qo[3]}; *(u32x4*)(QE + el * 136 + 16 * eg + 8) = (u32x4){qo[4], qo[5], qo[6], qo[7]};
          *(u32x4*)(KE + el * 136 + 16 * eg) = (u32x4){ko[0], ko[1], ko[2], ko[3]}; *(u32x4*)(KE + el * 136 + 16 * eg + 8) = (u32x4){ko[4], ko[5], ko[6], ko[7]};
          { const unsigned vw[4] = {cv.x, cv.y, cv.z, cv.w};
#pragma unroll
            for (int e2 = 0; e2 < 4; ++e2) { VT[(8 * eg + 2 * e2) * 72 + el] = (bf16_t)(vw[e2] & 0xffffu); VT[(8 * eg + 2 * e2 + 1) * 72 + el] = (bf16_t)(vw[e2] >> 16); } }
#pragma unroll
          for (int i = 0; i < 16; ++i) ST[(32 * svt + crow(i, hh)) * 136 + 32 * sdt + rho] = f2bf(st[i]);
        }
        __syncthreads();
        if (wid < 4) { const int lt = wid >> 1, mt = wid & 1; f32x16 acc;
#pragma unroll
            for (int i = 0; i < 16; ++i) acc[i] = 0.f;
            mma_tile(acc, QE + 32 * lt * 136, 136, KE + 32 * mt * 136, 136, 8, lane);
#pragma unroll
            for (int i = 0; i < 16; ++i) { const int l = 32 * lt + crow(i, hh), m = 32 * mt + rho; AM[l * 72 + m] = f2bf(m <= l ? acc[i] : 0.f); } }
        __syncthreads();
        if (wid < 4) { const int lt = wid >> 1, vt2 = wid & 1; f32x16 acc;
#pragma unroll
            for (int i = 0; i < 16; ++i) acc[i] = 0.f;
            mma_tile(acc, AM + 32 * lt * 72, 72, VT + 32 * vt2 * 72, 72, 4, lane);
            mma_tile(acc, QE + 32 * lt * 136, 136, ST + 32 * vt2 * 136, 136, 8, lane);
#pragma unroll
            for (int i = 0; i < 16; ++i) { const int l = 32 * lt + crow(i, hh); outp[(size_t)GROWQ(q, l) * 1024 + hd * 256 + vs * 64 + 32 * vt2 + rho] = f2bf(acc[i]); } }
        { const float dc = DEC[32 * sdt + rho];
#pragma unroll
          for (int i = 0; i < 16; ++i) st[i] *= dc;
          mma_tile(st, VT + 32 * svt * 72, 72, KDT + 32 * sdt * 72, 72, 4, lane); }
        __syncthreads();
    }
#undef GROWQ
#undef GLA_FETCH
}
struct GlaFinRow { bf16x8 a0, a1, b0, b1, g0, g1; };
DI void gla_fin_load(GlaFinRow& R, const bf16_t* OF, const bf16_t* OB, const bf16_t* P, int row, int c0) {
    R.a0 = *(const bf16x8*)(OF + (size_t)row * 1024 + c0); R.a1 = *(const bf16x8*)(OF + (size_t)row * 1024 + c0 + 8);
    R.b0 = *(const bf16x8*)(OB + (size_t)row * 1024 + c0); R.b1 = *(const bf16x8*)(OB + (size_t)row * 1024 + c0 + 8);
    R.g0 = *(const bf16x8*)(P + (size_t)row * 3072 + 2048 + c0); R.g1 = *(const bf16x8*)(P + (size_t)row * 3072 + 2048 + c0 + 8);
}
DI void gla_fin_store(const GlaFinRow& R, bf16_t* OF, const float* ng, int row, int c0) {
    float o[16]; float ss = 0.f;
#pragma unroll
    for (int e = 0; e < 8; ++e) { o[e] = bf2f((bf16_t)R.a0[e]) + bf2f((bf16_t)R.b0[e]); o[8 + e] = bf2f((bf16_t)R.a1[e]) + bf2f((bf16_t)R.b1[e]); }
#pragma unroll
    for (int e = 0; e < 16; ++e) ss += o[e] * o[e];
    ss += __shfl_xor(ss, 1); ss += __shfl_xor(ss, 2); ss += __shfl_xor(ss, 4); ss += __shfl_xor(ss, 8);
    const float rinv = rsqrtf(ss * (1.f / 256.f) + 1e-6f);
    float y[16];
#pragma unroll
    for (int e = 0; e < 16; ++e) { const float gt = bf2f((bf16_t)(e < 8 ? R.g0[e] : R.g1[e - 8])); y[e] = o[e] * rinv * ng[(c0 + e) & 255] * (gt * sigmoidf_(gt)); }
    u32x4 w0, w1; w0.x = cvtpk(y[0], y[1]); w0.y = cvtpk(y[2], y[3]); w0.z = cvtpk(y[4], y[5]); w0.w = cvtpk(y[6], y[7]);
    w1.x = cvtpk(y[8], y[9]); w1.y = cvtpk(y[10], y[11]); w1.z = cvtpk(y[12], y[13]); w1.w = cvtpk(y[14], y[15]);
    *(u32x4*)(OF + (size_t)row * 1024 + c0) = w0; *(u32x4*)(OF + (size_t)row * 1024 + c0 + 8) = w1;
}
DI void gla_finish(bf16_t* OF, const bf16_t* OB, const bf16_t* P, const float* ng, int Mrows, int gw, int ngw, int lane) {
    const int c0 = 16 * lane;
    for (int row = gw; row < Mrows; row += 2 * ngw) {
        const int rowB = row + ngw < Mrows ? row + ngw : row;
        GlaFinRow A, B;
        gla_fin_load(A, OF, OB, P, row, c0); gla_fin_load(B, OF, OB, P, rowB, c0);
        gla_fin_store(A, OF, ng, row, c0);
        if (rowB != row) gla_fin_store(B, OF, ng, rowB, c0);
    }
}

typedef unsigned u32x2_t __attribute__((ext_vector_type(2)));
DI float red_rows(float x) {
    unsigned u = __float_as_uint(x);
    u32x2_t r = __builtin_amdgcn_permlane16_swap(u, u, false, false);
    const float y = __uint_as_float(r.x) + __uint_as_float(r.y);
    unsigned v = __float_as_uint(y);
    u32x2_t q = __builtin_amdgcn_permlane32_swap(v, v, false, false);
    return __uint_as_float(q.x) + __uint_as_float(q.y);
}
DI int rw_row(int q, int l, int dir, int b) {
    int T, base, n;
    if (q < 8) { T = 256; base = ML + b * 256; n = q; } else { T = 4096; base = b * 4096; n = q - 8; }
    const int t = n * 32 + l;
    return base + (dir ? T - 1 - t : t);
}
#define DPPB(n) " row_newbcast:" #n " row_mask:0xf bank_mask:0xf\n\t"
#define RW_UPD(n, sreg) "v_mul_f32_dpp " sreg ", %17, " sreg DPPB(n) "v_fmac_f32_dpp " sreg ", %18, %21" DPPB(n) "v_fmac_f32_dpp " sreg ", %19, %22" DPPB(n)
DI void rwkv_unit(const Args& a, const bf16_t* RKV, const bf16_t* TWAA, bf16_t* Y  , float* RK  , unsigned char* lds, int unit, int tid) {
    const int lane = tid & 63, wid = __builtin_amdgcn_readfirstlane(tid >> 6);
    const int dir = unit & 1, hd = (unit >> 1) & 15, b = unit >> 5;
    float* SA = (float*)lds;
    float* YC = SA + 6 * 4096;
    bf16_t* W2T = (bf16_t*)(YC + 4096);
    bf16_t* A2T = W2T + 64 * 72;
    constexpr int NCH = 136;
    {
        const float* w2 = a.in[23] + (size_t)dir * 64 * 1024; const float* a2 = a.in[26] + (size_t)dir * 64 * 1024;
        for (int e = 0; e < 8; ++e) { const int idx = tid + 512 * e, j = idx >> 6, c = idx & 63; W2T[c * 72 + j] = f2bf(w2[(size_t)j * 1024 + hd * 64 + c]); A2T[c * 72 + j] = f2bf(a2[(size_t)j * 1024 + hd * 64 + c]); }
    }
    __syncthreads();
    bf16_t* yout = Y + (size_t)dir * MT * 1024; float* rkout = RK + (size_t)dir * MT * 16;
    if (wid >= 4) {
        const int pw = wid - 4, rho = lane & 31, h = lane >> 5, ptid = tid - 256;
        float cw0[2], ca0[2], ckk[2], cka[2], crk[2];
#pragma unroll
        for (int ct = 0; ct < 2; ++ct) { const int c = hd * 64 + 32 * ct + rho; cw0[ct] = a.in[21][dir * 1024 + c]; ca0[ct] = a.in[24][dir * 1024 + c]; ckk[ct] = a.in[29][c]; cka[ct] = a.in[30][c]; crk[ct] = a.in[31][c]; }
        for (int p = 0; p <= NCH + 1; ++p) {
            if (p < NCH) {
                const int buf = p & 1;
                const int rowA = rw_row(p, 8 * pw + (rho & 7), dir, b);
                const bf16_t* ta = TWAA + (size_t)rowA * 256 + dir * 64 + 8 * h;
                f32x16 zw0, zw1, za0, za1;
#pragma unroll
                for (int i = 0; i < 16; ++i) { zw0[i] = 0.f; zw1[i] = 0.f; za0[i] = 0.f; za1[i] = 0.f; }
#pragma unroll
                for (int s = 0; s < 4; ++s) {
                    const bf16x8 atw = *(const bf16x8*)(ta + 16 * s), aaa = *(const bf16x8*)(ta + 128 + 16 * s);
                    const bf16x8 bw0 = *(const bf16x8*)(W2T + rho * 72 + 16 * s + 8 * h), bw1 = *(const bf16x8*)(W2T + (32 + rho) * 72 + 16 * s + 8 * h);
                    const bf16x8 ba0 = *(const bf16x8*)(A2T + rho * 72 + 16 * s + 8 * h), ba1 = *(const bf16x8*)(A2T + (32 + rho) * 72 + 16 * s + 8 * h);
                    zw0 = MFMA32(atw, bw0, zw0); zw1 = MFMA32(atw, bw1, zw1); za0 = MFMA32(aaa, ba0, za0); za1 = MFMA32(aaa, ba1, za1);
                }
#pragma unroll
                for (int i = 0; i < 4; ++i) {
                    const int tok = 8 * pw + i + 4 * h; const int row = rw_row(p, tok, dir, b);
                    const bf16_t* pr = RKV + (size_t)row * 3072 + hd * 64 + rho;
                    float rv[2], kv[2], vv[2], av[2], kkv[2], kd[2]; float ss = 0.f, rk = 0.f;
#pragma unroll
                    for (int ct = 0; ct < 2; ++ct) {
                        rv[ct] = bf2f(pr[32 * ct]); kv[ct] = bf2f(pr[1024 + 32 * ct]); vv[ct] = bf2f(pr[2048 + 32 * ct]);
                        const float zav = ct ? za1[i] : za0[i];
                        av[ct] = 1.f / (1.f + __expf(-(ca0[ct] + zav)));
                        kkv[ct] = kv[ct] * ckk[ct]; ss += kkv[ct] * kkv[ct];
                        kd[ct] = kv[ct] * (1.f + (av[ct] - 1.f) * cka[ct]); rk += rv[ct] * kd[ct] * crk[ct];
                    }
#pragma unroll
                    for (int o = 1; o < 32; o <<= 1) { ss += __shfl_xor(ss, o); rk += __shfl_xor(rk, o); }
                    const float kinv = rsqrtf(fmaxf(ss, 1e-24f));
                    if (rho == 0) rkout[(size_t)row * 16 + hd] = rk;
#pragma unroll
                    for (int ct = 0; ct < 2; ++ct) {
                        const float zwv = ct ? zw1[i] : zw0[i];
                        const float x = -(cw0[ct] + zwv);
                        const float sp = fmaxf(x, 0.f) + __logf(1.f + __expf(-fabsf(x)));
                        const float dec = __expf(-__expf(-sp - 0.5f));
                        const float kn = kkv[ct] * kinv;
                        float* o = SA + buf * 2048 + tok * 64 + 32 * ct + rho;
                        o[0 * 4096] = dec; o[1 * 4096] = kd[ct]; o[2 * 4096] = kn * av[ct]; o[3 * 4096] = -kn; o[4 * 4096] = rv[ct]; o[5 * 4096] = vv[ct];
                    }
                }
            }
            if (p >= 2) {
                const int tok = ptid >> 3, i0 = (ptid & 7) * 8; const int row = rw_row(p - 2, tok, dir, b);
                const float* y = YC + (p & 1) * 2048 + tok * 64 + i0;
                const f32x4 y0 = *(const f32x4*)y, y1 = *(const f32x4*)(y + 4);
                *(u32x4*)(yout + (size_t)row * 1024 + hd * 64 + i0) = pack8(y0, y1);
            }
            __syncthreads();
        }
    } else {
        __builtin_amdgcn_s_setprio(3);
        const int rl = lane & 15, cg = lane >> 4, myrow = 16 * wid + rl;
        float s0 = 0.f, s1 = 0.f, s2 = 0.f, s3 = 0.f, s4 = 0.f, s5 = 0.f, s6 = 0.f, s7 = 0.f, s8 = 0.f, s9 = 0.f, s10 = 0.f, s11 = 0.f, s12 = 0.f, s13 = 0.f, s14 = 0.f, s15 = 0.f;
        for (int p = 0; p <= NCH + 1; ++p) {
            if (p >= 1 && p <= NCH) {
                const int buf = (p - 1) & 1;
                const float* base = SA + buf * 2048;
                float* yc = YC + buf * 2048 + myrow;
                float w_c = base[lane], kd_c = base[4096 + lane], bb_c = base[2 * 4096 + lane], nk_c = base[3 * 4096 + lane], r_c = base[4 * 4096 + lane], v_c = base[5 * 4096 + myrow];
                for (int t = 0; t < 32; ++t) {
                    const int tn = (t + 1) & 31;
                    const float w_n = base[tn * 64 + lane], kd_n = base[4096 + tn * 64 + lane], bb_n = base[2 * 4096 + tn * 64 + lane], nk_n = base[3 * 4096 + tn * 64 + lane], r_n = base[4 * 4096 + tn * 64 + lane], v_n = base[5 * 4096 + tn * 64 + myrow];
                    float sap;
                    asm volatile("s_nop 1\n\t"
                        "v_mul_f32_dpp %0, %1, %2" DPPB(0) "v_fmac_f32_dpp %0, %1, %3" DPPB(1) "v_fmac_f32_dpp %0, %1, %4" DPPB(2) "v_fmac_f32_dpp %0, %1, %5" DPPB(3)
                        "v_fmac_f32_dpp %0, %1, %6" DPPB(4) "v_fmac_f32_dpp %0, %1, %7" DPPB(5) "v_fmac_f32_dpp %0, %1, %8" DPPB(6) "v_fmac_f32_dpp %0, %1, %9" DPPB(7)
                        "v_fmac_f32_dpp %0, %1, %10" DPPB(8) "v_fmac_f32_dpp %0, %1, %11" DPPB(9) "v_fmac_f32_dpp %0, %1, %12" DPPB(10) "v_fmac_f32_dpp %0, %1, %13" DPPB(11)
                        "v_fmac_f32_dpp %0, %1, %14" DPPB(12) "v_fmac_f32_dpp %0, %1, %15" DPPB(13) "v_fmac_f32_dpp %0, %1, %16" DPPB(14) "v_fmac_f32_dpp %0, %1, %17" DPPB(15)
                        "s_nop 1"
                        : "=&v"(sap)
                        : "v"(nk_c), "v"(s0), "v"(s1), "v"(s2), "v"(s3), "v"(s4), "v"(s5), "v"(s6), "v"(s7), "v"(s8), "v"(s9), "v"(s10), "v"(s11), "v"(s12), "v"(s13), "v"(s14), "v"(s15));
                    const float sa = red_rows(sap);
                    float yp;
                    asm volatile("s_nop 1\n\t"
                        RW_UPD(0, "%0") RW_UPD(1, "%1") RW_UPD(2, "%2") RW_UPD(3, "%3") RW_UPD(4, "%4") RW_UPD(5, "%5") RW_UPD(6, "%6") RW_UPD(7, "%7")
                        RW_UPD(8, "%8") RW_UPD(9, "%9") RW_UPD(10, "%10") RW_UPD(11, "%11") RW_UPD(12, "%12") RW_UPD(13, "%13") RW_UPD(14, "%14") RW_UPD(15, "%15")
                        "v_mul_f32_dpp %16, %20, %0" DPPB(0) "v_fmac_f32_dpp %16, %20, %1" DPPB(1) "v_fmac_f32_dpp %16, %20, %2" DPPB(2) "v_fmac_f32_dpp %16, %20, %3" DPPB(3)
                        "v_fmac_f32_dpp %16, %20, %4" DPPB(4) "v_fmac_f32_dpp %16, %20, %5" DPPB(5) "v_fmac_f32_dpp %16, %20, %6" DPPB(6) "v_fmac_f32_dpp %16, %20, %7" DPPB(7)
                        "v_fmac_f32_dpp %16, %20, %8" DPPB(8) "v_fmac_f32_dpp %16, %20, %9" DPPB(9) "v_fmac_f32_dpp %16, %20, %10" DPPB(10) "v_fmac_f32_dpp %16, %20, %11" DPPB(11)
                        "v_fmac_f32_dpp %16, %20, %12" DPPB(12) "v_fmac_f32_dpp %16, %20, %13" DPPB(13) "v_fmac_f32_dpp %16, %20, %14" DPPB(14) "v_fmac_f32_dpp %16, %20, %15" DPPB(15)
                        "s_nop 1"
                        : "+v"(s0), "+v"(s1), "+v"(s2), "+v"(s3), "+v"(s4), "+v"(s5), "+v"(s6), "+v"(s7), "+v"(s8), "+v"(s9), "+v"(s10), "+v"(s11), "+v"(s12), "+v"(s13), "+v"(s14), "+v"(s15), "=&v"(yp)
                        : "v"(w_c), "v"(bb_c), "v"(kd_c), "v"(r_c), "v"(sa), "v"(v_c));
                    const float y = red_rows(yp);
                    if (cg == 0) yc[t * 64] = y;
                    w_c = w_n; kd_c = kd_n; bb_c = bb_n; nk_c = nk_n; r_c = r_n; v_c = v_n;
                }
            }
            __syncthreads();
        }
        __builtin_amdgcn_s_setprio(0);
    }
    __syncthreads();
}
struct RwFinRow { bf16x8 a0, a1, b0, b1, v0, v1, g0, g1; float rk; };
DI void rw_fin_load(RwFinRow& R, const bf16_t* YF, const bf16_t* YB, const bf16_t* RKV, const bf16_t* G, const float* RK, int row, int c0, int hd) {
    R.a0 = *(const bf16x8*)(YF + (size_t)row * 1024 + c0); R.a1 = *(const bf16x8*)(YF + (size_t)row * 1024 + c0 + 8);
    R.b0 = *(const bf16x8*)(YB + (size_t)row * 1024 + c0); R.b1 = *(const bf16x8*)(YB + (size_t)row * 1024 + c0 + 8);
    R.v0 = *(const bf16x8*)(RKV + (size_t)row * 3072 + 2048 + c0); R.v1 = *(const bf16x8*)(RKV + (size_t)row * 3072 + 2048 + c0 + 8);
    R.g0 = *(const bf16x8*)(G + (size_t)row * 1024 + c0); R.g1 = *(const bf16x8*)(G + (size_t)row * 1024 + c0 + 8);
    R.rk = RK[(size_t)row * 16 + hd] + RK[(size_t)MT * 16 + (size_t)row * 16 + hd];
}
DI void rw_fin_store(const RwFinRow& R, bf16_t* YF, const float* lng, const float* lnb, int row, int c0) {
    float y[16]; float sm = 0.f;
#pragma unroll
    for (int e = 0; e < 8; ++e) { y[e] = bf2f((bf16_t)R.a0[e]) + bf2f((bf16_t)R.b0[e]); y[8 + e] = bf2f((bf16_t)R.a1[e]) + bf2f((bf16_t)R.b1[e]); }
#pragma unroll
    for (int e = 0; e < 16; ++e) sm += y[e];
    sm += __shfl_xor(sm, 1); sm += __shfl_xor(sm, 2);
    const float mu = sm * (1.f / 64.f);
    float sv = 0.f;
#pragma unroll
    for (int e = 0; e < 16; ++e) { y[e] -= mu; sv += y[e] * y[e]; }
    sv += __shfl_xor(sv, 1); sv += __shfl_xor(sv, 2);
    const float rinv = rsqrtf(sv * (1.f / 64.f) + 64e-5f);
    float o[16];
#pragma unroll
    for (int e = 0; e < 16; ++e) { const float vv = bf2f((bf16_t)(e < 8 ? R.v0[e] : R.v1[e - 8])), gg = bf2f((bf16_t)(e < 8 ? R.g0[e] : R.g1[e - 8]));
        o[e] = (y[e] * rinv * lng[c0 + e] + lnb[c0 + e] + R.rk * vv) * gg; }
    u32x4 w0, w1; w0.x = cvtpk(o[0], o[1]); w0.y = cvtpk(o[2], o[3]); w0.z = cvtpk(o[4], o[5]); w0.w = cvtpk(o[6], o[7]);
    w1.x = cvtpk(o[8], o[9]); w1.y = cvtpk(o[10], o[11]); w1.z = cvtpk(o[12], o[13]); w1.w = cvtpk(o[14], o[15]);
    *(u32x4*)(YF + (size_t)row * 1024 + c0) = w0; *(u32x4*)(YF + (size_t)row * 1024 + c0 + 8) = w1;
}
DI void rwkv_finish(bf16_t* YF, const bf16_t* YB, const bf16_t* RKV, const bf16_t* G, const float* RK, const float* lng, const float* lnb, int Mrows, int gw, int ngw, int lane) {
    const int c0 = 16 * lane, hd = lane >> 2;
    for (int row = gw; row < Mrows; row += 2 * ngw) {
        const int rowB = row + ngw < Mrows ? row + ngw : row;
        RwFinRow A, B;
        rw_fin_load(A, YF, YB, RKV, G, RK, row, c0, hd); rw_fin_load(B, YF, YB, RKV, G, RK, rowB, c0, hd);
        rw_fin_store(A, YF, lng, lnb, row, c0);
        if (rowB != row) rw_fin_store(B, YF, lng, lnb, rowB, c0);
    }
}

#define XB_TMO      128
#define XB_XCNT(j)  (256  + 64 * (j))
#define XB_XSUB(j)  (1280 + 64 * (j))
#define XB_XGEN(j)  (2304 + 64 * (j))
#define XB_TOP      3328
#define XB_TOPGEN   3392
#define XCD_BAR_WORDS 3456
#define XB_SPIN_CAP (1u << 18)

__device__ __forceinline__ unsigned xb_ld(unsigned* p)              { return __hip_atomic_load(p, __ATOMIC_RELAXED, __HIP_MEMORY_SCOPE_AGENT); }
__device__ __forceinline__ unsigned xb_add(unsigned* p, unsigned v) { return __hip_atomic_fetch_add(p, v, __ATOMIC_RELAXED, __HIP_MEMORY_SCOPE_AGENT); }
__device__ __forceinline__ unsigned xb_xcc_id() { return (unsigned)__builtin_amdgcn_s_getreg((3 << 11) | 20) & 0xFu; }
#define XB_SPIN(cond, bar) do { unsigned _sp = 0; while (cond) { __builtin_amdgcn_s_sleep(1); \
    if ((++_sp & 255u) == 0u) { if (xb_ld(&(bar)[XB_TMO])) break; if (_sp > XB_SPIN_CAP) { atomicAdd(&(bar)[XB_TMO], 1u); break; } } } } while (0)

struct XcdBarrier {
    unsigned* bar; unsigned x;
    volatile LAS unsigned* st;
};

__device__ __forceinline__ XcdBarrier xcd_barrier_post(unsigned* bar, volatile LAS unsigned* st) {
    XcdBarrier b; b.bar = bar; b.x = xb_xcc_id(); b.st = st;
    if (threadIdx.x == 0) (void)xb_add(&bar[XB_XCNT(b.x)], 1u);
    return b;
}
__device__ __forceinline__ void xcd_barrier_complete(unsigned* bar, unsigned x, unsigned& nloc, unsigned& nx) {
    const unsigned G = gridDim.x * gridDim.y * gridDim.z;
    unsigned sum, cnt, mine, sp = 0u;
    for (;;) {
        sum = 0u; cnt = 0u; mine = 0u;
#pragma unroll
        for (unsigned j = 0; j < 16; ++j) { const unsigned c = xb_ld(&bar[XB_XCNT(j)]); sum += c; cnt += (c > 0u) ? 1u : 0u; mine = (j == x) ? c : mine; }
        if (sum == G) break;
        __builtin_amdgcn_s_sleep(1);
        if ((++sp & 255u) == 0u) { if (xb_ld(&bar[XB_TMO])) break; if (sp > XB_SPIN_CAP) { atomicAdd(&bar[XB_TMO], 1u); break; } }
    }
    nloc = mine > 0u ? mine : 1u; nx = cnt > 0u ? cnt : 1u;
}

__device__ __forceinline__ void xcd_barrier(const XcdBarrier& b) {
    asm volatile("s_waitcnt vmcnt(0)" ::: "memory");
    __syncthreads();
    if (threadIdx.x == 0) {
        unsigned* bar = b.bar;
        __builtin_amdgcn_s_waitcnt(0);
        unsigned nloc = b.st[0], nx = b.st[1];
        if (nloc == 0u) { xcd_barrier_complete(bar, b.x, nloc, nx); b.st[0] = nloc; b.st[1] = nx; }
        const unsigned old = xb_add(&bar[XB_XSUB(b.x)], 1u);
        const unsigned gen = old / nloc;
        if (old + 1u == (gen + 1u) * nloc) {
            __builtin_amdgcn_fence(__ATOMIC_RELEASE, "agent");
            asm volatile("s_waitcnt vmcnt(0)" ::: "memory");
            const unsigned og = xb_add(&bar[XB_TOP], 1u);
            const unsigned tg = og / nx;
            if (og + 1u == (tg + 1u) * nx) xb_add(&bar[XB_TOPGEN], 1u);
            else XB_SPIN(xb_ld(&bar[XB_TOPGEN]) == tg, bar);
            __builtin_amdgcn_fence(__ATOMIC_ACQUIRE, "agent");
            xb_add(&bar[XB_XGEN(b.x)], 1u);
            asm volatile("s_waitcnt vmcnt(0)" ::: "memory");
        } else {
            XB_SPIN(xb_ld(&bar[XB_XGEN(b.x)]) == gen, bar);
            __builtin_amdgcn_fence(__ATOMIC_ACQUIRE, "agent");
            asm volatile("s_waitcnt vmcnt(0)" ::: "memory");
        }
    }
    __syncthreads();
}

#define WSP(T, off) ((T*)(a.ws + (off)))
#define PHASE(k) if (lo <= (k) && (k) < hi)
#define SEAM(k) do { if ((k) + 1 < hi) xcd_barrier(xbar); } while (0)
template <int L> DI void run_layer(const Args& a, unsigned char* lds, const XcdBarrier& xbar, int lo, int hi) {
    constexpr int kind = L % 3, jj = L / 3, P0 = 1 + 8 * L;
    constexpr bool need_ctx = L < 3;
    constexpr int Mact = need_ctx ? MT : ML;
    const int tid = threadIdx.x, lane = tid & 63, wid = __builtin_amdgcn_readfirstlane(tid >> 6);
    const int gw = blockIdx.x * 8 + wid, ngw = gridDim.x * 8;
    LAS unsigned char* ldsl = (LAS unsigned char*)lds;
    PHASE(P0 + 0) {
        float* scr = (float*)(lds + wid * 8704);
        for (int rep = 0; rep < ((DUP & 16) ? 2 : 1); ++rep) {
        const float* modl = WSP(float, WS_MOD) + (size_t)L * 9 * 6144;
        phase_prenorm(L == 0 ? a.in[0] : a.out, L == 0 ? a.in[2] : WSP(float, WS_ZF), a.in[6] + L * 1024, modl, 0, WSP(bf16_t, WS_H2), kind == 2 ? 2048 : 1024, kind == 2, MT, gw, ngw, lane);
        bf16_t* Wmix = WSP(bf16_t, W_MIX); bf16_t* Wo = WSP(bf16_t, W_O);
        conv_job(a.in[8] + (size_t)L * 1024 * 4096, 4096, 1024, 4096, 1024, 4096, nullptr, 0, WSP(bf16_t, W_1), 1024, 0, 0, scr, gw, ngw, lane);
        conv_job(a.in[9] + (size_t)L * 4096 * 1024, 1024, 4096, 1024, 4096, 1024, nullptr, 0, WSP(bf16_t, W_2), 4096, 0, 0, scr, gw, ngw, lane);
        if (kind == 0) {
            conv_job(a.in[11] + (size_t)jj * 1024 * 3072, 3072, 1024, 3072, 1024, 3072, nullptr, 0, Wmix, 1024, 0, 0, scr, gw, ngw, lane);
            conv_job(a.in[12] + (size_t)jj * 1024 * 1024, 1024, 1024, 1024, 1024, 1024, nullptr, 0, Wo, 1024, 0, 0, scr, gw, ngw, lane);
        } else if (kind == 1) {
            conv_job(a.in[14], 3104, 1024, 3104, 1024, 3328, nullptr, 0, Wmix, 1024, 0, 0, scr, gw, ngw, lane);
            conv_job(a.in[18], 1024, 1024, 1024, 1024, 1024, nullptr, 0, Wo, 1024, 0, 0, scr, gw, ngw, lane);
        } else {
            const float* mix = a.in[19];
            for (int md = 1; md <= 2; ++md) {
                const int co = (md - 1) * 1024;
                for (int q = 0; q < 3; ++q) conv_job(a.in[20] + (size_t)q * 1024 * 1024, 1024, 1024, 1024, 1024, 1024, mix + (q == 0 ? 0 : q + 1) * 1024, md, Wmix, 2048, q * 1024, co, scr, gw, ngw, lane);
                conv_job(a.in[27], 160, 1024, 160, 1024, 256, mix + 5 * 1024, md, Wmix, 2048, 3072, co, scr, gw, ngw, lane);
                for (int q = 0; q < 2; ++q) conv_job(a.in[22] + (size_t)q * 1024 * 64, 64, 1024, 64, 1024, 64, mix + 1 * 1024, md, Wmix, 2048, 3328 + 64 * q, co, scr, gw, ngw, lane);
                for (int q = 0; q < 2; ++q) conv_job(a.in[25] + (size_t)q * 1024 * 64, 64, 1024, 64, 1024, 64, mix + 4 * 1024, md, Wmix, 2048, 3456 + 64 * q, co, scr, gw, ngw, lane);
            }
            conv_job(a.in[28], 1024, 160, 1024, 256, 1024, nullptr, 0, WSP(bf16_t, W_G2), 256, 0, 0, scr, gw, ngw, lane);
            conv_job(a.in[34], 1024, 1024, 1024, 1024, 1024, nullptr, 0, Wo, 1024, 0, 0, scr, gw, ngw, lane);
        }
        }
        SEAM(P0 + 0);
    }
    PHASE(P0 + 1) {
        bf16_t* BIG = WSP(bf16_t, WS_BIG);
        for (int rep = 0; rep < ((DUP & 8) ? 2 : 1); ++rep) {
        if (kind == 0) run_gemm(ldsl, WSP(bf16_t, WS_H2), WSP(bf16_t, W_MIX), MT, 3072, 1024, InNaQkv{BIG, BIG + (size_t)MT * 2048, BIG + (size_t)MT * 2048 + (size_t)ML * 1024});
        else if (kind == 1) run_gemm(ldsl, WSP(bf16_t, WS_H2), WSP(bf16_t, W_MIX), MT, 3328, 1024, InGlaIn{BIG, WSP(float, WS_LR)});
        else run_gemm(ldsl, WSP(bf16_t, WS_H2), WSP(bf16_t, W_MIX), MT, 3584, 2048, InRwL1{BIG, BIG + (size_t)MT * 3072, BIG + (size_t)MT * 3328});
        }
        SEAM(P0 + 1);
    }
    PHASE(P0 + 2) {
        bf16_t* BIG = WSP(bf16_t, WS_BIG); bf16_t* H2 = WSP(bf16_t, WS_H2);
        if (kind == 0) {
            const bf16_t* VTL = BIG + (size_t)MT * 2048; const bf16_t* VTC = VTL + (size_t)ML * 1024;
            const float* rpb = a.in[13] + (size_t)jj * 16 * 15 * 31;
            const int nu = 8192 + (need_ctx ? 512 : 0);
#ifndef NO_ATTN
            float* tbl = (float*)(lds + wid * 7680);
            int tbl_hd = -1;
            for (int rep = 0; rep < ((DUP & 1) ? 2 : 1); ++rep)
            for (int u = gw; u < nu; u += ngw) {
                if (u < 8192) {
                    const int hd_ = (u >> 6) & 15;
                    if (hd_ != tbl_hd) {
                        for (int e = lane; e < 465; e += 64) { const int rr = e / 31, cc = e - rr * 31; tbl[rr * 128 + 48 + cc] = rpb[hd_ * 465 + e] * 1.4426950408889634f; }
                        tbl_hd = hd_;
                    }
                    attn_unit(BIG, VTL, VTC, H2, tbl, u >> 10, hd_, u & 63, 0, lane);
                }
                else { const int v = u - 8192; attn_unit(BIG, VTL, VTC, H2, tbl, v >> 6, (v >> 2) & 15, -1, v & 3, lane); }
            }
#endif
        } else if (kind == 1) {
#ifndef NO_GLA
            for (int rep = 0; rep < ((DUP & 2) ? 2 : 1); ++rep)
            gla_gates(WSP(float, WS_LR), a.in[15], a.in[16], BIG + (size_t)MT * 3072, (float*)lds, tid);
            xcd_barrier(xbar);
            for (int u = blockIdx.x; u < 256; u += gridDim.x) gla_unit(BIG, BIG + (size_t)MT * 3072, H2, lds, u, tid);
#endif
        } else {
#ifndef NO_RWKV
            for (int rep = 0; rep < ((DUP & 4) ? 2 : 1); ++rep)
            for (int u = blockIdx.x; u < 256; u += gridDim.x) rwkv_unit(a, BIG, BIG + (size_t)MT * 3328, H2, WSP(float, WS_RK), lds, u, tid);
#endif
            run_gemm(ldsl, BIG + (size_t)MT * 3072, WSP(bf16_t, W_G2), MT, 1024, 256, InStore<0>{WSP(bf16_t, WS_G), 1024});
        }
        SEAM(P0 + 2);
    }
    if (kind != 0) {
        PHASE(P0 + 3) {
            bf16_t* H2 = WSP(bf16_t, WS_H2);
            if (kind == 1) gla_finish(H2, H2 + (size_t)MT * 1024, WSP(bf16_t, WS_BIG), a.in[17], Mact, gw, ngw, lane);
            else rwkv_finish(H2, H2 + (size_t)MT * 1024, WSP(bf16_t, WS_BIG), WSP(bf16_t, WS_G), WSP(float, WS_RK), a.in[32], a.in[33], Mact, gw, ngw, lane);
            SEAM(P0 + 3);
        }
    }
    PHASE(P0 + 4) {
        if (DUP & 32) run_gemm(ldsl, WSP(bf16_t, WS_H2), WSP(bf16_t, W_O), Mact, 1024, 1024, InResid{L == 0 ? a.in[0] : a.out, L == 0 ? a.in[2] : WSP(float, WS_ZF), WSP(float, WS_BIG), WSP(float, WS_BIG) + (size_t)ML * 1024, WSP(float, WS_MOD) + (size_t)L * 9 * 6144 + 2 * 1024});
        run_gemm(ldsl, WSP(bf16_t, WS_H2), WSP(bf16_t, W_O), Mact, 1024, 1024, InResid{L == 0 ? a.in[0] : a.out, L == 0 ? a.in[2] : WSP(float, WS_ZF), a.out, WSP(float, WS_ZF), WSP(float, WS_MOD) + (size_t)L * 9 * 6144 + 2 * 1024});
        SEAM(P0 + 4);
    }
    PHASE(P0 + 5) {
        for (int rep = 0; rep < ((DUP & 16) ? 2 : 1); ++rep)
        phase_prenorm(a.out, WSP(float, WS_ZF), a.in[7] + L * 1024, WSP(float, WS_MOD) + (size_t)L * 9 * 6144, 3, WSP(bf16_t, WS_H2), 1024, false, Mact, gw, ngw, lane);
        SEAM(P0 + 5);
    }
    PHASE(P0 + 6) {
        for (int rep = 0; rep < ((DUP & 8) ? 2 : 1); ++rep)
        run_gemm(ldsl, WSP(bf16_t, WS_H2), WSP(bf16_t, W_1), Mact, 4096, 1024, InStore<1>{WSP(bf16_t, WS_BIG), 4096});
        SEAM(P0 + 6);
    }
    PHASE(P0 + 7) {
        if (DUP & 32) run_gemm(ldsl, WSP(bf16_t, WS_BIG), WSP(bf16_t, W_2), Mact, 1024, 4096, InResid{a.out, WSP(float, WS_ZF), WSP(float, WS_H2), WSP(float, WS_H2) + (size_t)ML * 1024, WSP(float, WS_MOD) + (size_t)L * 9 * 6144 + 5 * 1024});
        run_gemm(ldsl, WSP(bf16_t, WS_BIG), WSP(bf16_t, W_2), Mact, 1024, 4096, InResid{a.out, WSP(float, WS_ZF), a.out, WSP(float, WS_ZF), WSP(float, WS_MOD) + (size_t)L * 9 * 6144 + 5 * 1024});
        SEAM(P0 + 7);
    }
}
__global__ void __launch_bounds__(NTHREADS, 2) mega(Args a) {
    extern __shared__ __attribute__((aligned(16))) unsigned char lds[];
    cg::grid_group grid = cg::this_grid();
    const int lo = a.lo, hi = a.hi;
    volatile LAS unsigned* xst = (volatile LAS unsigned*)((LAS unsigned char*)lds + (LDS_BYTES - 64));
    if (threadIdx.x < 2) xst[threadIdx.x] = 0u;
    __syncthreads();
    const XcdBarrier xbar = xcd_barrier_post((unsigned*)(a.ws + WS_BAR), xst);
    PHASE(0) { phase_mod(a, (float*)lds, threadIdx.x); if (1 < hi) grid.sync(); }
    run_layer<0>(a, lds, xbar, lo, hi);
    run_layer<1>(a, lds, xbar, lo, hi);
    run_layer<2>(a, lds, xbar, lo, hi);
    run_layer<3>(a, lds, xbar, lo, hi);
    PHASE(33) {
        const int tid = threadIdx.x, lane = tid & 63, wid = tid >> 6;
        const int gw = blockIdx.x * 8 + wid, ngw = gridDim.x * 8;
        const float* fg = a.in[10];
        for (int st = gw; st < ML / 4; st += ngw) {
            f32x4 v[4][4]; float ss[4];
#pragma unroll
            for (int r = 0; r < 4; ++r) { const float* xr = a.out + (size_t)(4 * st + r) * 1024;
#pragma unroll
                for (int j = 0; j < 4; ++j) v[r][j] = *(const f32x4*)(xr + 4 * lane + 256 * j); }
#pragma unroll
            for (int r = 0; r < 4; ++r) { float s = 0.f;
#pragma unroll
                for (int j = 0; j < 4; ++j) s += (v[r][j].x * v[r][j].x + v[r][j].y * v[r][j].y) + (v[r][j].z * v[r][j].z + v[r][j].w * v[r][j].w);
                ss[r] = s; }
#pragma unroll
            for (int o = 1; o < 64; o <<= 1) {
#pragma unroll
                for (int r = 0; r < 4; ++r) ss[r] += __shfl_xor(ss[r], o);
            }
#pragma unroll
            for (int r = 0; r < 4; ++r) { const float rinv = rsqrtf(ss[r] * (1.f / 1024.f) + 1e-6f); float* xr = a.out + (size_t)(4 * st + r) * 1024;
#pragma unroll
                for (int j = 0; j < 4; ++j) *(f32x4*)(xr + 4 * lane + 256 * j) = v[r][j] * rinv * *(const f32x4*)(fg + 4 * lane + 256 * j); }
        }
    }
}

#ifndef GM
#define GM 0xffff
#endif
#ifndef MULTI_LAUNCH
#define MULTI_LAUNCH 0
#endif
extern "C" void kernel_launch(void* const* d_in, const int* in_sizes, int n_in, void* d_out, int out_size, void* d_ws, size_t ws_size, hipStream_t stream) {
    static int grid_blocks = 0;
    if (!grid_blocks) {
        int dev = 0, cus = 0, per_cu = 0;
        hipGetDevice(&dev);
        hipDeviceGetAttribute(&cus, hipDeviceAttributeMultiprocessorCount, dev);
        hipFuncSetAttribute((const void*)mega, hipFuncAttributeMaxDynamicSharedMemorySize, LDS_BYTES);
        hipOccupancyMaxActiveBlocksPerMultiprocessor(&per_cu, (const void*)mega, NTHREADS, LDS_BYTES);
        if (per_cu < 1) per_cu = 1;
        grid_blocks = cus * per_cu;
    }
    (void)hipMemsetAsync((char*)d_ws + WS_BAR, 0, XCD_BAR_WORDS * 4, stream);
    Args a{};
    for (int i = 0; i < 35; ++i) a.in[i] = (const float*)d_in[i];
    a.out = (float*)d_out; a.ws = (unsigned char*)d_ws;
#if MULTI_LAUNCH
    for (int p = 0; p < 34; ++p) { a.lo = p; a.hi = p + 1; hipLaunchKernelGGL(mega, dim3(grid_blocks), dim3(NTHREADS), LDS_BYTES, stream, a); }
#else
    a.lo = 0; a.hi = 34;
    void* args[] = {&a};
    hipError_t e = hipLaunchCooperativeKernel((const void*)mega, dim3(grid_blocks), dim3(NTHREADS), args, LDS_BYTES, stream);
    if (e != hipSuccess) fprintf(stderr, "cooperative launch failed: %s (grid %d)\n", hipGetErrorString(e), grid_blocks);
#endif
}
```

```cpp
#include <hip/hip_runtime.h>
#include <hip/hip_cooperative_groups.h>
#include <cstdio>
#include <cstdint>
namespace cg = cooperative_groups;

namespace pg8 {
#define PG8_LAS __attribute__((address_space(3)))
typedef unsigned short bf16_t;
typedef short bf16x8 __attribute__((ext_vector_type(8)));
typedef float f32x4 __attribute__((ext_vector_type(4)));
typedef unsigned u32x4 __attribute__((ext_vector_type(4)));
constexpr int BM = 256, BK = 64, HALF = 128, HTB = HALF * BK * 2  , STAGE_BYTES = 8 * HTB, NXCD = 8, WGM = 8;

__host__ __device__ __forceinline__ int lds_byte(int r, int c) { const int st = (r >> 4) * 2 + (c >> 5), rr = r & 15, cc = c & 31, ob = rr * 64 + cc * 2; return st * 1024 + (ob ^ (((ob >> 9) & 1) << 5)); }
__host__ __device__ __forceinline__ void stage_rc(int b, int& R, int& C) { const int st = b / 1024, sb = b % 1024, swz = sb ^ (((sb >> 9) & 1) << 5); R = (st >> 1) * 16 + swz / 64; C = (st & 1) * 32 + (swz % 64) / 2; }
__host__ __device__ __forceinline__ int perm32(int rho) { const int n = rho >> 4, i = rho & 15; return 8 * (i >> 2) + 4 * n + (i & 3); }

struct Unit { int pm, pn; };
struct Gemm { const bf16_t* A; const bf16_t* Bt; int M, N, K; };

struct StaticOrder {
    int nM, nN, nwg, G, c;
    __host__ __device__ void init(int M, int N, int G_, int c_) { nM = M / BM; nN = N / BM; nwg = nM * nN; G = G_; c = c_; }
    __host__ __device__ bool next(int i, Unit& u) const {
        const long L = (long)i * G + c; if (L >= nwg) return false;
        int wgid = (int)L; { const int q = nwg / NXCD, r = nwg % NXCD, xcd = wgid % NXCD, off = wgid / NXCD; wgid = (xcd < r ? xcd * (q + 1) : r * (q + 1) + (xcd - r) * q) + off; }
        const int nig = WGM * nN, gid = wgid / nig, fm = gid * WGM, gsz = (nM - fm) < WGM ? (nM - fm) : WGM;
        u.pm = fm + ((wgid % nig) % gsz); u.pn = (wgid % nig) / gsz; return true;
    }
    __device__ __forceinline__ void a_ready(const Unit&) const {}
    __device__ __forceinline__ void done(const Unit&) const {}
};

__device__ __forceinline__ unsigned cvt_pk_bf16(float lo, float hi) { unsigned r; asm volatile("v_cvt_pk_bf16_f32 %0, %1, %2" : "=v"(r) : "v"(lo), "v"(hi)); return r; }
template <class Epi, class Sched, bool ALIGN_EPI = false, bool SP2 = false>
__device__ __forceinline__ void gemm_phase(PG8_LAS unsigned char* lds, const Gemm g, const Sched& S, const Epi& E) {
    const int tid = threadIdx.x, wid = __builtin_amdgcn_readfirstlane(tid >> 6), lane = tid & 63, wr = wid >> 2, wc = wid & 3, fr = lane & 15, fq = lane >> 4;
    const int K = g.K, nt = K / BK;
    unsigned voffA[2], voffB[2];
#pragma unroll
    for (int i = 0; i < 2; ++i) { int R, C; stage_rc(tid * 16 + i * 8192, R, C); const int Rb = Epi::PERM ? ((R & ~31) + perm32(R & 31)) : R;
        voffA[i] = (unsigned)(R * K + C) * 2u; voffB[i] = (unsigned)(Rb * K + C) * 2u; }
    const size_t kstep = (size_t)(BK * 2);
    const size_t hstep = (size_t)HALF * K * 2;
    const size_t tstep = 2 * hstep;
    const unsigned ldsw = (unsigned)wid * 1024u;
    const int aoff = lds_byte(wr * 64 + fr, fq * 8), boff = lds_byte(wc * 32 + fr, fq * 8);
#define PG8_SA(b, h) (((b) * 2 + (h)) * HTB)
#define PG8_SB(b, h) ((4 + (b) * 2 + (h)) * HTB)
#define PG8_STAGE(bufoff, gbase, voff) do { _Pragma("unroll") for (int _i = 0; _i < 2; ++_i) \
        __builtin_amdgcn_global_load_lds((const unsigned*)((const char*)(gbase) + (voff)[_i]), (PG8_LAS unsigned*)(lds + (bufoff) + ldsw + _i * 8192), 16, 0, 0); } while (0)
#define PG8_LDA(dst, b, h) do { _Pragma("unroll") for (int m = 0; m < 4; ++m) _Pragma("unroll") for (int k = 0; k < 2; ++k) dst[m][k] = *(const PG8_LAS bf16x8*)(lds + PG8_SA(b, h) + aoff + m * 2048 + k * 1024); } while (0)
#define PG8_LDB(dst, b, h) do { _Pragma("unroll") for (int n = 0; n < 2; ++n) _Pragma("unroll") for (int k = 0; k < 2; ++k) dst[n][k] = *(const PG8_LAS bf16x8*)(lds + PG8_SB(b, h) + boff + n * 2048 + k * 1024); } while (0)
#define PG8_MMA(ai, bj, At, Bt) do { __builtin_amdgcn_s_setprio(1); _Pragma("unroll") for (int m = 0; m < 4; ++m) _Pragma("unroll") for (int n = 0; n < 2; ++n) _Pragma("unroll") for (int k = 0; k < 2; ++k) \
        acc[ai][bj][m][n] = __builtin_amdgcn_mfma_f32_16x16x32_bf16(Bt[n][k], At[m][k], acc[ai][bj][m][n], 0, 0, 0); __builtin_amdgcn_s_setprio(0); } while (0)
#define PG8_WAIT_V(n) asm volatile("s_waitcnt vmcnt(" #n ")" ::: "memory")
#define PG8_WAIT_L(n) asm volatile("s_waitcnt lgkmcnt(" #n ")" ::: "memory")
#define PG8_BAR __builtin_amdgcn_s_barrier()
#define PG8_SCHED __builtin_amdgcn_sched_barrier(0)
    Unit cur, nxt; int ui = 0;
    if (!S.next(0, cur)) return;
    f32x4 acc[2][2][4][2];
#pragma unroll
    for (int a = 0; a < 2; ++a)
#pragma unroll
        for (int b = 0; b < 2; ++b)
#pragma unroll
            for (int m = 0; m < 4; ++m)
#pragma unroll
                for (int n = 0; n < 2; ++n) acc[a][b][m][n] = (f32x4){0.f, 0.f, 0.f, 0.f};
    bf16x8 At[4][2], B0[2][2], B1[2][2];
    const char* cA = (const char*)g.A + (size_t)cur.pm * tstep; const char* cB = (const char*)g.Bt + (size_t)cur.pn * tstep;
    S.a_ready(cur);
    if constexpr (SP2) {
        PG8_STAGE(PG8_SB(0, 0), cB, voffB); PG8_STAGE(PG8_SB(0, 1), cB + hstep, voffB); PG8_STAGE(PG8_SA(0, 0), cA, voffA); PG8_STAGE(PG8_SA(0, 1), cA + hstep, voffA);
        if (wr == 1) PG8_BAR;
        PG8_WAIT_V(2); PG8_BAR;
        PG8_STAGE(PG8_SB(1, 0), cB + kstep, voffB); PG8_STAGE(PG8_SA(1, 0), cA + kstep, voffA); PG8_STAGE(PG8_SB(1, 1), cB + hstep + kstep, voffB);
        PG8_WAIT_V(6); PG8_BAR;
    } else {
        PG8_STAGE(PG8_SB(0, 0), cB, voffB); PG8_STAGE(PG8_SA(0, 0), cA, voffA); PG8_STAGE(PG8_SB(0, 1), cB + hstep, voffB); PG8_STAGE(PG8_SA(0, 1), cA + hstep, voffA);
        if (wr == 1) PG8_BAR;
        PG8_WAIT_V(4); PG8_BAR;
        PG8_STAGE(PG8_SB(1, 0), cB + kstep, voffB); PG8_STAGE(PG8_SA(1, 0), cA + kstep, voffA); PG8_STAGE(PG8_SB(1, 1), cB + hstep + kstep, voffB);
        PG8_WAIT_V(6); PG8_BAR;
    }
    for (;;) {
        const bool has_next = S.next(ui + 1, nxt);
        const char* nA = has_next ? (const char*)g.A + (size_t)nxt.pm * tstep : cA; const char* nB = has_next ? (const char*)g.Bt + (size_t)nxt.pn * tstep : cB;
        for (int t = 0; t < nt; t += 2) {
            const bool last = (t == nt - 2);
            const char* a1 = cA + (size_t)(t + 1) * kstep;
            const char* a2 = last ? nA : cA + (size_t)(t + 2) * kstep; const char* b2 = last ? nB : cB + (size_t)(t + 2) * kstep;
            const char* a3 = a2 + kstep; const char* b3 = b2 + kstep;
            if (last && has_next) S.a_ready(nxt);
            if constexpr (SP2) {
            PG8_LDB(B0, 0, 0); PG8_LDB(B1, 0, 1); PG8_SCHED; PG8_LDA(At, 0, 0); PG8_STAGE(PG8_SA(1, 1), a1 + hstep, voffA);
            PG8_WAIT_V(8); PG8_WAIT_L(0); PG8_BAR; PG8_MMA(0, 0, At, B0); PG8_MMA(0, 1, At, B1); PG8_BAR; PG8_SCHED;
            PG8_LDA(At, 0, 1); PG8_STAGE(PG8_SB(0, 0), b2, voffB); PG8_STAGE(PG8_SB(0, 1), b2 + hstep, voffB); PG8_STAGE(PG8_SA(0, 0), a2, voffA);
            PG8_WAIT_V(8); PG8_WAIT_L(0); PG8_BAR; PG8_MMA(1, 0, At, B0); PG8_MMA(1, 1, At, B1); PG8_BAR; PG8_SCHED;
            PG8_LDB(B0, 1, 0); PG8_LDB(B1, 1, 1); PG8_SCHED; PG8_LDA(At, 1, 0); PG8_STAGE(PG8_SA(0, 1), a2 + hstep, voffA);
            PG8_WAIT_V(8); PG8_WAIT_L(0); PG8_BAR; PG8_MMA(0, 0, At, B0); PG8_MMA(0, 1, At, B1); PG8_BAR; PG8_SCHED;
            PG8_LDA(At, 1, 1); PG8_STAGE(PG8_SB(1, 0), b3, voffB); PG8_STAGE(PG8_SB(1, 1), b3 + hstep, voffB); PG8_STAGE(PG8_SA(1, 0), a3, voffA);
            PG8_WAIT_V(8); PG8_WAIT_L(0); PG8_BAR; PG8_MMA(1, 0, At, B0); PG8_MMA(1, 1, At, B1); PG8_BAR; PG8_SCHED;
            } else {
            PG8_LDB(B0, 0, 0); PG8_SCHED; PG8_LDA(At, 0, 0); PG8_STAGE(PG8_SA(1, 1), a1 + hstep, voffA);
            PG8_WAIT_L(8); PG8_BAR; PG8_WAIT_L(0); PG8_MMA(0, 0, At, B0); PG8_BAR; PG8_SCHED;
            PG8_LDB(B1, 0, 1); PG8_STAGE(PG8_SB(0, 0), b2, voffB);
            PG8_BAR; PG8_WAIT_L(0); PG8_MMA(0, 1, At, B1); PG8_BAR;
            PG8_LDA(At, 0, 1); PG8_STAGE(PG8_SA(0, 0), a2, voffA);
            PG8_BAR; PG8_WAIT_L(0); PG8_MMA(1, 0, At, B0); PG8_BAR; PG8_SCHED;
            PG8_STAGE(PG8_SB(0, 1), b2 + hstep, voffB);
            PG8_WAIT_V(6); PG8_BAR; PG8_MMA(1, 1, At, B1); PG8_BAR;
            PG8_LDB(B0, 1, 0); PG8_SCHED; PG8_LDA(At, 1, 0); PG8_STAGE(PG8_SA(0, 1), a2 + hstep, voffA);
            PG8_WAIT_L(8); PG8_BAR; PG8_WAIT_L(0); PG8_MMA(0, 0, At, B0); PG8_BAR; PG8_SCHED;
            PG8_LDB(B1, 1, 1); PG8_STAGE(PG8_SB(1, 0), b3, voffB);
            PG8_BAR; PG8_WAIT_L(0); PG8_MMA(0, 1, At, B1); PG8_BAR;
            PG8_LDA(At, 1, 1); PG8_STAGE(PG8_SA(1, 0), a3, voffA);
            PG8_BAR; PG8_WAIT_L(0); PG8_MMA(1, 0, At, B0); PG8_BAR; PG8_SCHED;
            PG8_STAGE(PG8_SB(1, 1), b3 + hstep, voffB);
            PG8_WAIT_V(6); PG8_BAR; PG8_MMA(1, 1, At, B1); PG8_BAR;
            }
        }
        if constexpr (ALIGN_EPI) { if (wr == 0) PG8_BAR; }
        if constexpr (!Epi::AFTER_DRAIN) { E(acc, cur, wr, wc, fr, fq); S.done(cur); }
        if (!has_next) break;
#pragma unroll
        for (int a = 0; a < 2; ++a)
#pragma unroll
            for (int b = 0; b < 2; ++b)
#pragma unroll
                for (int m = 0; m < 4; ++m)
#pragma unroll
                    for (int n = 0; n < 2; ++n) acc[a][b][m][n] = (f32x4){0.f, 0.f, 0.f, 0.f};
        cur = nxt; cA = nA; cB = nB; ++ui;
        if constexpr (ALIGN_EPI) { if (wr == 1) PG8_BAR; }
    }
    PG8_WAIT_V(0);
    if constexpr (!ALIGN_EPI) { if (wr == 0) PG8_BAR; }
    PG8_BAR;
    if constexpr (Epi::AFTER_DRAIN) { E.fused(acc, cur, wr, wc, fr, fq, lds, wid, lane); S.done(cur); }
#undef PG8_SA
#undef PG8_SB
#undef PG8_STAGE
#undef PG8_LDA
#undef PG8_LDB
#undef PG8_MMA
#undef PG8_WAIT_V
#undef PG8_WAIT_L
#undef PG8_BAR
#undef PG8_SCHED
}
}

#ifndef DUP
#define DUP 0
#endif
#define DI __device__ __forceinline__
#define LAS __attribute__((address_space(3)))
typedef unsigned short bf16_t;
typedef short bf16x8 __attribute__((ext_vector_type(8)));
typedef float f32x4 __attribute__((ext_vector_type(4)));
typedef float f32x16 __attribute__((ext_vector_type(16)));
typedef unsigned u32x4 __attribute__((ext_vector_type(4)));
typedef unsigned u32x2 __attribute__((ext_vector_type(2)));
typedef float f32x2_t __attribute__((ext_vector_type(2)));
typedef __bf16 bf16x2_t __attribute__((ext_vector_type(2)));

constexpr int D = 1024, NB = 8, SEQ = 4096, CTX = 256, FF = 4096;
constexpr int ML = NB * SEQ, MC = NB * CTX, MT = ML + MC;
constexpr size_t MiB = 1u << 20;
constexpr size_t WS_MOD = 0, WS_ZF = 1 * MiB, WS_RK = 9 * MiB, WS_LR = 14 * MiB, WS_W = 20 * MiB, WS_H2 = 56 * MiB, WS_BIG = 192 * MiB, WS_G = 430 * MiB;
constexpr size_t W_MIX = WS_W, W_O = WS_W + 14 * MiB, W_G2 = WS_W + 16 * MiB, W_1 = WS_W + 17 * MiB, W_2 = WS_W + 25 * MiB;
constexpr int LDS_BYTES = 147456;
constexpr size_t WS_BAR = 983040;
constexpr int NTHREADS = 512;

struct Args { const float* in[35]; float* out; unsigned char* ws; int lo, hi; };

DI float bf2f(bf16_t v) { return __uint_as_float(((unsigned)v) << 16); }
DI unsigned cvtpk(float lo, float hi) { f32x2_t v = {lo, hi}; bf16x2_t b = __builtin_convertvector(v, bf16x2_t); return __builtin_bit_cast(unsigned, b); }
DI bf16_t f2bf(float x) { return (bf16_t)(cvtpk(x, 0.f) & 0xffffu); }
DI float wave_sum(float v) {
#pragma unroll
    for (int o = 1; o < 64; o <<= 1) v += __shfl_xor(v, o);
    return v;
}
DI float sigmoidf_(float x) { return 1.f / (1.f + __expf(-x)); }
DI float softplusf_(float x) { return fmaxf(x, 0.f) + log1pf(__expf(-fabsf(x))); }
DI int crow(int i, int h) { return (i & 3) + 8 * (i >> 2) + 4 * h; }
#define MFMA32(a, b, c) __builtin_amdgcn_mfma_f32_32x32x16_bf16((a), (b), (c), 0, 0, 0)

DI void mma_tile(f32x16& acc, const bf16_t* A, int lda, const bf16_t* Bt, int ldb, int ksteps, int lane) {
    const int rho = lane & 31, h = lane >> 5;
    const bf16_t* ap = A + rho * lda + 8 * h; const bf16_t* bp = Bt + rho * ldb + 8 * h;
    for (int s = 0; s < ksteps; ++s) {
        bf16x8 av = *(const bf16x8*)(ap + 16 * s); bf16x8 bv = *(const bf16x8*)(bp + 16 * s);
        acc = MFMA32(av, bv, acc);
    }
}

template <class Inner> struct Epi {
    static constexpr bool PERM = true, AFTER_DRAIN = false;
    Inner in;
    DI void operator()(const pg8::f32x4 (&acc)[2][2][4][2], const pg8::Unit& u, int wr, int wc, int fr, int fq) const {
        const int row0 = u.pm * 256 + wr * 64 + fr, col0 = u.pn * 256 + wc * 32 + 8 * fq;
#pragma unroll
        for (int ai = 0; ai < 2; ++ai)
#pragma unroll
            for (int m = 0; m < 4; ++m) {
                const int row = row0 + ai * 128 + m * 16;
#pragma unroll
                for (int bj = 0; bj < 2; ++bj) in.store8(row, col0 + bj * 128, acc[ai][bj][m][0], acc[ai][bj][m][1]);
            }
    }
};
DI u32x4 pack8(f32x4 a, f32x4 b) { u32x4 w; w.x = cvtpk(a[0], a[1]); w.y = cvtpk(a[2], a[3]); w.z = cvtpk(b[0], b[1]); w.w = cvtpk(b[2], b[3]); return w; }

template <int ACT> struct InStore {
    bf16_t* O; int ldc;
    DI void store8(int row, int col, f32x4 a, f32x4 b) const {
        if (ACT == 1) {
#pragma unroll
            for (int j = 0; j < 4; ++j) { float x = fmaxf(a[j], 0.f); a[j] = x * x; float y = fmaxf(b[j], 0.f); b[j] = y * y; }
        }
        *(u32x4*)(O + (size_t)row * ldc + col) = pack8(a, b);
    }
};
struct InNaQkv {
    bf16_t* QK; bf16_t* VTL; bf16_t* VTC;
    DI void store8(int row, int col, f32x4 a, f32x4 b) const {
        if (col < 2048) {
            const float sc = col < 1024 ? 0.18033688011112042f : 1.f;
            *(u32x4*)(QK + (size_t)row * 2048 + col) = pack8(a * sc, b * sc);
        } else {
            const int c = col - 2048, hd = c >> 6, d0 = c & 63;
            bf16_t* p; size_t ld;
            if (row < ML) { const int b_ = row >> 12, t = row & 4095; p = VTL + ((size_t)((b_ * 16 + hd) * 64 + d0)) * 4096 + t; ld = 4096; }
            else { const int r2 = row - ML, b_ = r2 >> 8, t = r2 & 255; p = VTC + ((size_t)((b_ * 16 + hd) * 64 + d0)) * 256 + t; ld = 256; }
#pragma unroll
            for (int j = 0; j < 4; ++j) { p[(size_t)j * ld] = f2bf(a[j]); p[(size_t)(j + 4) * ld] = f2bf(b[j]); }
        }
    }
};
struct InResid {
    const float* sl; const float* sc; float* dl; float* dc; const float* gate;
    DI void store8(int row, int col, f32x4 a, f32x4 b) const {
        const float* s; float* d; int mi;
        if (row < ML) { s = sl + (size_t)row * 1024 + col; d = dl + (size_t)row * 1024 + col; mi = row >> 12; }
        else { s = sc + (size_t)(row - ML) * 1024 + col; d = dc + (size_t)(row - ML) * 1024 + col; mi = 8; }
        const float* g = gate + (size_t)mi * 6144 + col;
        const f32x4 g0 = *(const f32x4*)g, g1 = *(const f32x4*)(g + 4);
        const f32x4 x0 = *(const f32x4*)s, x1 = *(const f32x4*)(s + 4);
        *(f32x4*)d = x0 + g0 * a; *(f32x4*)(d + 4) = x1 + g1 * b;
    }
};
struct InGlaIn {
    bf16_t* P; float* LR;
    DI void store8(int row, int col, f32x4 a, f32x4 b) const {
        if (col < 3072) {
            const float sc = col < 512 ? 0.08838834764831845f : 1.f;
            *(u32x4*)(P + (size_t)row * 3072 + col) = pack8(a * sc, b * sc);
        } else if (col < 3104) {
            float* p = LR + (size_t)row * 32 + (col - 3072);
            *(f32x4*)p = a; *(f32x4*)(p + 4) = b;
        }
    }
};
struct InRwL1 {
    bf16_t* RKV; bf16_t* SG; bf16_t* TWAA;
    DI void store8(int row, int col, f32x4 a, f32x4 b) const {
        if (col < 3072) { *(u32x4*)(RKV + (size_t)row * 3072 + col) = pack8(a, b); }
        else if (col < 3328) {
#pragma unroll
            for (int j = 0; j < 4; ++j) { a[j] = sigmoidf_(a[j]); b[j] = sigmoidf_(b[j]); }
            *(u32x4*)(SG + (size_t)row * 256 + (col - 3072)) = pack8(a, b);
        } else {
            const int c = col - 3328;
            if (c < 128) {
#pragma unroll
                for (int j = 0; j < 4; ++j) { a[j] = tanhf(a[j]); b[j] = tanhf(b[j]); }
            }
            *(u32x4*)(TWAA + (size_t)row * 256 + c) = pack8(a, b);
        }
    }
};

template <class Inner> DI void run_gemm(LAS unsigned char* lds, const bf16_t* A, const bf16_t* Bt, int M, int N, int K, const Inner& in) {
    int Kr = K; asm volatile("" : "+s"(Kr));
    pg8::Gemm g{A, Bt, M, N, Kr}; pg8::StaticOrder S; S.init(M, N, (int)gridDim.x, (int)blockIdx.x);
    Epi<Inner> E{in};
#ifndef NO_GEMM
    pg8::gemm_phase<Epi<Inner>, pg8::StaticOrder, true, true>(lds, g, S, E);
#endif
    __syncthreads();
}

DI void conv_item(const float* W, int ldw, int Kv, int Nv, const float* mix, int mode, bf16_t* WT, int ldt, int row_off, int col_off, float* scr, int kb, int nb, int lane) {
    const int k0 = 64 * kb, n0 = 32 * nb;
#pragma unroll 8
    for (int i = 0; i < 32; ++i) {
        const int kk = 2 * i + (lane >> 5), k = k0 + kk, n = n0 + (lane & 31);
        float v = (k < Kv && n < Nv) ? W[(size_t)k * ldw + n] : 0.f;
        if (mode) { const float m = (k < Kv) ? mix[k] : 0.f; v *= (mode == 1) ? (1.f - m) : m; }
        scr[kk * 33 + (lane & 31)] = v;
    }
    __builtin_amdgcn_s_waitcnt(0xc07f); __builtin_amdgcn_wave_barrier();
    const int c = lane & 7;
#pragma unroll
    for (int j = 0; j < 4; ++j) {
        const int n = (lane >> 3) + 8 * j; const float* s = scr + (8 * c) * 33 + n;
        u32x4 o; o.x = cvtpk(s[0 * 33], s[1 * 33]); o.y = cvtpk(s[2 * 33], s[3 * 33]); o.z = cvtpk(s[4 * 33], s[5 * 33]); o.w = cvtpk(s[6 * 33], s[7 * 33]);
        *(u32x4*)(WT + (size_t)(row_off + n0 + n) * ldt + col_off + k0 + 8 * c) = o;
    }
    __builtin_amdgcn_s_waitcnt(0xc07f); __builtin_amdgcn_wave_barrier();
}
DI void conv_job(const float* W, int ldw, int Kv, int Nv, int Kp, int Np, const float* mix, int mode, bf16_t* WT, int ldt, int row_off, int col_off, float* scr, int gw, int ngw, int lane) {
    const int nkb = Kp / 64, nnb = Np / 32, nit = nkb * nnb;
    for (int it = gw; it < nit; it += ngw) conv_item(W, ldw, Kv, Nv, mix, mode, WT, ldt, row_off, col_off, scr, it / nnb, it % nnb, lane);
}

DI void norm_row(const float* xr, const f32x4 (&gs)[4], const f32x4 (&sh)[4], int lane, f32x4 (&out)[4]) {
    f32x4 v[4]; float s = 0.f;
#pragma unroll
    for (int j = 0; j < 4; ++j) { v[j] = *(const f32x4*)(xr + 4 * lane + 256 * j); s += (v[j].x * v[j].x + v[j].y * v[j].y) + (v[j].z * v[j].z + v[j].w * v[j].w); }
    s = wave_sum(s);
    const float rinv = rsqrtf(s * (1.f / 1024.f) + 1e-6f);
#pragma unroll
    for (int j = 0; j < 4; ++j) out[j] = v[j] * rinv * gs[j] + sh[j];
}
DI void store_row_bf16(bf16_t* o, const f32x4 (&v)[4], int lane) {
#pragma unroll
    for (int j = 0; j < 4; ++j) { u32x2 w; w.x = cvtpk(v[j].x, v[j].y); w.y = cvtpk(v[j].z, v[j].w); *(u32x2*)(o + 4 * lane + 256 * j) = w; }
}
DI void phase_prenorm(const float* xl, const float* xc, const float* g, const float* modl  , int shift_chunk, bf16_t* H, int ldh, bool with_hs, int Mrows, int gw, int ngw, int lane) {
#define XROW(r) ((r) < ML ? xl + (size_t)(r) * 1024 : xc + (size_t)((r) - ML) * 1024)
    if (!with_hs) {
        const int nstrips = Mrows / 4;
        for (int st = gw; st < nstrips; st += ngw) {
            const int row0 = 4 * st;
            const int mi = row0 < ML ? row0 >> 12 : 8;
            const float* mp = modl + (size_t)mi * 6144 + shift_chunk * 1024;
            f32x4 v[4][4]; float ss[4];
#pragma unroll
            for (int r = 0; r < 4; ++r) { const float* xr = XROW(row0 + r);
#pragma unroll
                for (int j = 0; j < 4; ++j) v[r][j] = *(const f32x4*)(xr + 4 * lane + 256 * j); }
            f32x4 gs[4], sh[4];
#pragma unroll
            for (int j = 0; j < 4; ++j) { const int c = 4 * lane + 256 * j; sh[j] = *(const f32x4*)(mp + c); const f32x4 sc = *(const f32x4*)(mp + 1024 + c); gs[j] = *(const f32x4*)(g + c) * (sc + 1.f); }
#pragma unroll
            for (int r = 0; r < 4; ++r) { float s = 0.f;
#pragma unroll
                for (int j = 0; j < 4; ++j) s += (v[r][j].x * v[r][j].x + v[r][j].y * v[r][j].y) + (v[r][j].z * v[r][j].z + v[r][j].w * v[r][j].w);
                ss[r] = s; }
#pragma unroll
            for (int o = 1; o < 64; o <<= 1) {
#pragma unroll
                for (int r = 0; r < 4; ++r) ss[r] += __shfl_xor(ss[r], o);
            }
#pragma unroll
            for (int r = 0; r < 4; ++r) { const float rinv = rsqrtf(ss[r] * (1.f / 1024.f) + 1e-6f); f32x4 o[4];
#pragma unroll
                for (int j = 0; j < 4; ++j) o[j] = v[r][j] * rinv * gs[j] + sh[j];
                store_row_bf16(H + (size_t)(row0 + r) * ldh, o, lane); }
        }
    } else {
        const int nstrips = Mrows / 8;
        for (int st = gw; st < nstrips; st += ngw) {
            const int row0 = 8 * st;
            int mi, seg0, seg1;
            if (row0 < ML) { mi = row0 >> 12; seg0 = row0 & ~4095; seg1 = seg0 + 4096; } else { mi = 8; seg0 = ML + ((row0 - ML) & ~255); seg1 = seg0 + 256; }
            const float* mp = modl + (size_t)mi * 6144 + shift_chunk * 1024;
            f32x4 gs[4], sh[4];
#pragma unroll
            for (int j = 0; j < 4; ++j) { const int c = 4 * lane + 256 * j; sh[j] = *(const f32x4*)(mp + c); const f32x4 sc = *(const f32x4*)(mp + 1024 + c); gs[j] = *(const f32x4*)(g + c) * (sc + 1.f); }
            f32x4 prev[4], cur[4], nxt[4];
            if (row0 > seg0) norm_row(XROW(row0 - 1), gs, sh, lane, prev); else { for (int j = 0; j < 4; ++j) prev[j] = (f32x4){0.f, 0.f, 0.f, 0.f}; }
            norm_row(XROW(row0), gs, sh, lane, cur);
            for (int r = row0; r < row0 + 8; ++r) {
                if (r + 1 < seg1) norm_row(XROW(r + 1), gs, sh, lane, nxt); else { for (int j = 0; j < 4; ++j) nxt[j] = (f32x4){0.f, 0.f, 0.f, 0.f}; }
                store_row_bf16(H + (size_t)r * ldh, cur, lane);
                f32x4 hs[4];
#pragma unroll
                for (int j = 0; j < 4; ++j) hs[j] = (prev[j] + nxt[j]) * 0.5f;
                store_row_bf16(H + (size_t)r * ldh + 1024, hs, lane);
#pragma unroll
                for (int j = 0; j < 4; ++j) { prev[j] = cur[j]; cur[j] = nxt[j]; }
            }
        }
    }
#undef XROW
}

DI void phase_mod(const Args& a, float* lds, int tid) {
    float* sc = lds;
    float* red = lds + 1024 * 12;
    const float* c = a.in[1]; const float* cctx = a.in[3]; const float* ada_w = a.in[4]; const float* ada_b = a.in[5];
    float* mod = (float*)(a.ws + WS_MOD);
    for (int idx = tid; idx < 9 * 1024; idx += NTHREADS) { const int j = idx >> 10, k = idx & 1023; const float v = j < 8 ? c[j * 1024 + k] : cctx[k]; sc[k * 12 + j] = v * sigmoidf_(v); }
    __syncthreads();
    for (int unit = blockIdx.x; unit < 768; unit += gridDim.x) {
        const int l = unit / 192, n0 = (unit % 192) * 32, col = tid & 31, ks = tid >> 5;
        const float* w = ada_w + ((size_t)l * 1024 + ks * 64) * 6144 + n0 + col;
        float acc[9];
#pragma unroll
        for (int j = 0; j < 9; ++j) acc[j] = 0.f;
#pragma unroll 32
        for (int kk = 0; kk < 64; ++kk) {
            const float wv = w[(size_t)kk * 6144]; const float* s = sc + (ks * 64 + kk) * 12;
            const f32x4 s0 = *(const f32x4*)s, s1 = *(const f32x4*)(s + 4); const float s8 = s[8];
            acc[0] += s0.x * wv; acc[1] += s0.y * wv; acc[2] += s0.z * wv; acc[3] += s0.w * wv;
            acc[4] += s1.x * wv; acc[5] += s1.y * wv; acc[6] += s1.z * wv; acc[7] += s1.w * wv; acc[8] += s8 * wv;
        }
#pragma unroll
        for (int j = 0; j < 9; ++j) red[(ks * 9 + j) * 32 + col] = acc[j];
        __syncthreads();
        if (tid < 288) {
            const int j = tid >> 5, cc = tid & 31; float s = ada_b[l * 6144 + n0 + cc];
#pragma unroll
            for (int k2 = 0; k2 < 16; ++k2) s += red[(k2 * 9 + j) * 32 + cc];
            mod[((size_t)(l * 9 + j)) * 6144 + n0 + cc] = s;
        }
        __syncthreads();
    }
}

DI void attn_unit(const bf16_t* QK, const bf16_t* VTL, const bf16_t* VTC, bf16_t* O, const float* tbl, int b, int hd, int r, int cq, int lane) {
    const int n = lane & 31, h = lane >> 5;
    const bool lat = r >= 0;
    const int qrow0 = lat ? b * 4096 + r * 64 : ML + b * 256 + cq * 64;
    const int pin = (n & 0x13) | ((n & 4) << 1) | ((n & 8) >> 1);
    bf16x8 bq[2][4];
#pragma unroll
    for (int qb = 0; qb < 2; ++qb)
#pragma unroll
        for (int s = 0; s < 4; ++s) bq[qb][s] = *(const bf16x8*)(QK + (size_t)(qrow0 + 32 * qb + n) * 2048 + hd * 64 + 32 * h + 8 * s);
    f32x16 o[2][2];
#pragma unroll
    for (int x = 0; x < 2; ++x)
#pragma unroll
        for (int y = 0; y < 2; ++y)
#pragma unroll
            for (int i = 0; i < 16; ++i) o[x][y][i] = 0.f;
    float mrun[2] = {-1e30f, -1e30f}, lrun[2] = {0.f, 0.f};
    const int r0 = lat ? min(max(r - 4, 0), 56) : 0;
    const int nblk = lat ? 24 : 8;
    const bf16_t* vtc = VTC + (size_t)((b * 16 + hd) * 64) * 256;
    const bf16_t* vtl = VTL + (size_t)((b * 16 + hd) * 64) * 4096;
    for (int blk = 0; blk < nblk; ++blk) {
        int krow0, ldv, kc0 = 0, ridx = 0; const bf16_t* vt;
        const bool lb_ = blk >= 8;
        if (!lb_) { krow0 = ML + b * 256 + blk * 32; vt = vtc + blk * 32; ldv = 256; }
        else { const int lb = blk - 8, kr = r0 + (lb >> 1); kc0 = (lb & 1) * 32; krow0 = b * 4096 + kr * 64 + kc0; vt = vtl + kr * 64 + kc0; ldv = 4096; ridx = kr - r + 7; }
        bf16x8 ka[4];
#pragma unroll
        for (int s = 0; s < 4; ++s) ka[s] = *(const bf16x8*)(QK + (size_t)(krow0 + pin) * 2048 + 1024 + hd * 64 + 32 * h + 8 * s);
        bf16x8 va[2][2];
#pragma unroll
        for (int db = 0; db < 2; ++db)
#pragma unroll
            for (int s2 = 0; s2 < 2; ++s2) va[db][s2] = *(const bf16x8*)(vt + (size_t)(32 * db + n) * ldv + 16 * s2 + 8 * h);
        f32x16 sa[2];
#pragma unroll
        for (int qb = 0; qb < 2; ++qb) {
#pragma unroll
            for (int i = 0; i < 16; ++i) sa[qb][i] = 0.f;
#pragma unroll
            for (int s = 0; s < 4; ++s) sa[qb] = MFMA32(ka[s], bq[qb][s], sa[qb]);
        }
        bf16x8 pb[2][2];
#pragma unroll
        for (int qb = 0; qb < 2; ++qb) {
            if (lb_) {
                const int qc = 32 * qb + n, cs = min(max(qc - 8, 0), 48);
                const float* bp = tbl + ridx * 128 + 48 + 15 + kc0 + 8 * h - qc;
                const int okb = kc0 + 8 * h - cs;
#pragma unroll
                for (int i = 0; i < 16; ++i) {
                    const int ko = (i & 7) + 16 * (i >> 3);
                    const bool ok = (unsigned)(okb + ko) < 16u;
                    const float bv = bp[ko];
                    sa[qb][i] = ok ? sa[qb][i] + bv : -1e30f;
                }
            }
            float bm = sa[qb][0];
#pragma unroll
            for (int i = 1; i < 16; ++i) bm = fmaxf(bm, sa[qb][i]);
            bm = fmaxf(bm, __shfl_xor(bm, 32));
            const float mnew = fmaxf(mrun[qb], bm);
            const float alpha = __builtin_amdgcn_exp2f(mrun[qb] - mnew);
            mrun[qb] = mnew;
            float ps = 0.f;
#pragma unroll
            for (int i = 0; i < 16; ++i) { const float p = __builtin_amdgcn_exp2f(sa[qb][i] - mnew); sa[qb][i] = p; ps += p; }
            lrun[qb] = lrun[qb] * alpha + ps;
            if (__builtin_amdgcn_ballot_w64(alpha != 1.f) != 0ull) {
#pragma unroll
                for (int db = 0; db < 2; ++db)
#pragma unroll
                    for (int i = 0; i < 16; ++i) o[db][qb][i] *= alpha;
            }
#pragma unroll
            for (int s2 = 0; s2 < 2; ++s2) {
                u32x4 w; w.x = cvtpk(sa[qb][8 * s2 + 0], sa[qb][8 * s2 + 1]); w.y = cvtpk(sa[qb][8 * s2 + 2], sa[qb][8 * s2 + 3]);
                w.z = cvtpk(sa[qb][8 * s2 + 4], sa[qb][8 * s2 + 5]); w.w = cvtpk(sa[qb][8 * s2 + 6], sa[qb][8 * s2 + 7]);
                pb[qb][s2] = __builtin_bit_cast(bf16x8, w);
            }
        }
#pragma unroll
        for (int db = 0; db < 2; ++db)
#pragma unroll
            for (int qb = 0; qb < 2; ++qb)
#pragma unroll
                for (int s2 = 0; s2 < 2; ++s2) o[db][qb] = MFMA32(va[db][s2], pb[qb][s2], o[db][qb]);
    }
#pragma unroll
    for (int qb = 0; qb < 2; ++qb) {
        const float lt = lrun[qb] + __shfl_xor(lrun[qb], 32);
        const float inv = 1.f / lt;
        bf16_t* op = O + (size_t)(qrow0 + 32 * qb + n) * 1024 + hd * 64;
#pragma unroll
        for (int db = 0; db < 2; ++db)
#pragma unroll
            for (int g = 0; g < 4; ++g) {
                u32x2 w; w.x = cvtpk(o[db][qb][4 * g] * inv, o[db][qb][4 * g + 1] * inv); w.y = cvtpk(o[db][qb][4 * g + 2] * inv, o[db][qb][4 * g + 3] * inv);
                *(u32x2*)(op + 32 * db + 8 * g + 4 * h) = w;
            }
    }
}

DI void gla_gates(const float* LR, const float* wdec, const float* bdec, bf16_t* G, float* lds, int tid) {
    constexpr int RB = 64;
    float* lrs = lds;
    for (int bt = blockIdx.x; bt < MT / RB; bt += gridDim.x) {
        const int row0 = bt * RB;
        __syncthreads();
        for (int e = tid; e < RB * 32 / 4; e += NTHREADS) *(f32x4*)(lrs + 4 * e) = *(const f32x4*)(LR + (size_t)row0 * 32 + 4 * e);
        __syncthreads();
#pragma unroll 1
        for (int dir = 0; dir < 2; ++dir) {
            float wd[16];
#pragma unroll
            for (int r = 0; r < 16; ++r) wd[r] = wdec[(dir * 16 + r) * 512 + tid];
            const float bd = bdec[dir * 512 + tid];
            bf16_t* gp = G + ((size_t)dir * MT + row0) * 512 + tid;
#pragma unroll 4
            for (int rr = 0; rr < RB; ++rr) {
                const float* lp = lrs + rr * 32 + dir * 16;
                const f32x4 l0 = *(const f32x4*)lp, l1 = *(const f32x4*)(lp + 4), l2 = *(const f32x4*)(lp + 8), l3 = *(const f32x4*)(lp + 12);
                float z = bd;
                z += l0.x * wd[0] + l0.y * wd[1] + l0.z * wd[2] + l0.w * wd[3]; z += l1.x * wd[4] + l1.y * wd[5] + l1.z * wd[6] + l1.w * wd[7];
                z += l2.x * wd[8] + l2.y * wd[9] + l2.z * wd[10] + l2.w * wd[11]; z += l3.x * wd[12] + l3.y * wd[13] + l3.z * wd[14] + l3.w * wd[15];
                const float x = -z; const float sp = fmaxf(x, 0.f) + __logf(1.f + __expf(-fabsf(x)));
                gp[(size_t)rr * 512] = f2bf(sp * (-1.f / 16.f));
            }
        }
    }
    __syncthreads();
}
DI void gla_unit(const bf16_t* P, const bf16_t* G  , bf16_t* OUT  , unsigned char* lds, int unit, int tid) {
    const int lane = tid & 63, wid = __builtin_amdgcn_readfirstlane(tid >> 6);
    const int vs = unit & 3, dir = (unit >> 2) & 1, hd = (unit >> 3) & 3, b = unit >> 5;
    bf16_t* QE = (bf16_t*)lds;
    bf16_t* KE = QE + 64 * 136;
    bf16_t* ST = KE + 64 * 136;
    bf16_t* KDT = ST + 64 * 136;
    bf16_t* VT = KDT + 128 * 72;
    bf16_t* AM = VT + 64 * 72;
    float* Bc = (float*)(AM + 64 * 72);
    float* LRs = Bc + 64 * 132;
    float* GRP = LRs + 64 * 16;
    float* DEC = GRP + 4 * 128;
    const int dcol = tid & 127, lg = tid >> 7;
    const int col_q = hd * 128, col_k = 512 + hd * 128, col_v = 1024 + hd * 256 + vs * 64;
    f32x16 st;
#pragma unroll
    for (int i = 0; i < 16; ++i) st[i] = 0.f;
    const int svt = wid >> 2, sdt = wid & 3, rho = lane & 31, hh = lane >> 5;
    bf16_t* outp = OUT + (size_t)dir * MT * 1024;
    const int el = tid >> 3, eg = tid & 7;
    constexpr int NCHT = 68;
#define GROWQ(q, l) ((q) < 4 ? ML + b * 256 + (dir ? 255 - ((q) * 64 + (l)) : (q) * 64 + (l)) : b * 4096 + (dir ? 4095 - (((q) - 4) * 64 + (l)) : ((q) - 4) * 64 + (l)))
    u32x4 rq0, rq1, rk0, rk1, rv; bf16_t rg[16];
    const bf16_t* Gd = G + (size_t)dir * MT * 512;
#define GLA_FETCH(q) do { const size_t ro_ = (size_t)GROWQ(q, el) * 3072; \
        rq0 = *(const u32x4*)(P + ro_ + col_q + 16 * eg); rq1 = *(const u32x4*)(P + ro_ + col_q + 16 * eg + 8); \
        rk0 = *(const u32x4*)(P + ro_ + col_k + 16 * eg); rk1 = *(const u32x4*)(P + ro_ + col_k + 16 * eg + 8); \
        rv = *(const u32x4*)(P + ro_ + col_v + 8 * eg); \
        _Pragma("unroll") for (int li_ = 0; li_ < 16; ++li_) rg[li_] = Gd[(size_t)GROWQ(q, 16 * lg + li_) * 512 + hd * 128 + dcol]; } while (0)
    GLA_FETCH(0);
    for (int q = 0; q < NCHT; ++q) {
        const u32x4 cq0 = rq0, cq1 = rq1, ck0 = rk0, ck1 = rk1, cv = rv;
        { float run = 0.f;
#pragma unroll
          for (int li = 0; li < 16; ++li) { run += bf2f(rg[li]); Bc[(16 * lg + li) * 132 + dcol] = run; }
          GRP[lg * 128 + dcol] = run; }
        __syncthreads();
        if (q + 1 < NCHT) GLA_FETCH(q + 1);
        {
          const int g_ = el >> 4;
          float bv[16], bl[16];
#pragma unroll
          for (int e4 = 0; e4 < 4; ++e4) {
              const f32x4 t = *(const f32x4*)(Bc + el * 132 + 16 * eg + 4 * e4);
              f32x4 off = (f32x4){0.f, 0.f, 0.f, 0.f}, tot = (f32x4){0.f, 0.f, 0.f, 0.f};
#pragma unroll
              for (int g2 = 0; g2 < 4; ++g2) { const f32x4 gq = *(const f32x4*)(GRP + g2 * 128 + 16 * eg + 4 * e4); tot += gq; if (g2 < g_) off += gq; }
#pragma unroll
              for (int j = 0; j < 4; ++j) { bv[4 * e4 + j] = t[j] + off[j]; bl[4 * e4 + j] = tot[j]; }
          }
          if (el == 0) {
#pragma unroll
              for (int e = 0; e < 16; ++e) DEC[16 * eg + e] = __expf(bl[e]);
          }
          unsigned qw[8] = {cq0.x, cq0.y, cq0.z, cq0.w, cq1.x, cq1.y, cq1.z, cq1.w}, kw[8] = {ck0.x, ck0.y, ck0.z, ck0.w, ck1.x, ck1.y, ck1.z, ck1.w};
          unsigned qo[8], ko[8];
#pragma unroll
          for (int e2 = 0; e2 < 8; ++e2) {
              const float q0 = __uint_as_float(qw[e2] << 16), q1 = __uint_as_float(qw[e2] & 0xffff0000u), k0 = __uint_as_float(kw[e2] << 16), k1 = __uint_as_float(kw[e2] & 0xffff0000u);
              const float b0 = bv[2 * e2], b1 = bv[2 * e2 + 1];
              const float e0 = __expf(b0), e1 = __expf(b1);
              qo[e2] = cvtpk(q0 * e0, q1 * e1);
              ko[e2] = cvtpk(k0 * __builtin_amdgcn_rcpf(e0), k1 * __builtin_amdgcn_rcpf(e1));
              KDT[(16 * eg + 2 * e2) * 72 + el] = f2bf(k0 * __expf(bl[2 * e2] - b0)); KDT[(16 * eg + 2 * e2 + 1) * 72 + el] = f2bf(k1 * __expf(bl[2 * e2 + 1] - b1));
          }
          *(u32x4*)(QE + el * 136 + 16 * eg) = (u32x4){qo[0], qo[1], qo[2], qo[3]}; *(u32x4*)(QE + el * 136 + 16 * eg + 8) = (u32x4){qo[4], qo[5], qo[6], qo[7]};
          *(u32x4*)(KE + el * 136 + 16 * eg) = (u32x4){ko[0], ko[1], ko[2], ko[3]}; *(u32x4*)(KE + el * 136 + 16 * eg + 8) = (u32x4){ko[4], ko[5], ko[6], ko[7]};
          { const unsigned vw[4] = {cv.x, cv.y, cv.z, cv.w};
#pragma unroll
            for (int e2 = 0; e2 < 4; ++e2) { VT[(8 * eg + 2 * e2) * 72 + el] = (bf16_t)(vw[e2] & 0xffffu); VT[(8 * eg + 2 * e2 + 1) * 72 + el] = (bf16_t)(vw[e2] >> 16); } }
#pragma unroll
          for (int i = 0; i < 16; ++i) ST[(32 * svt + crow(i, hh)) * 136 + 32 * sdt + rho] = f2bf(st[i]);
        }
        __syncthreads();
        if (wid < 4) { const int lt = wid >> 1, mt = wid & 1; f32x16 acc;
#pragma unroll
            for (int i = 0; i < 16; ++i) acc[i] = 0.f;
            mma_tile(acc, QE + 32 * lt * 136, 136, KE + 32 * mt * 136, 136, 8, lane);
#pragma unroll
            for (int i = 0; i < 16; ++i) { const int l = 32 * lt + crow(i, hh), m = 32 * mt + rho; AM[l * 72 + m] = f2bf(m <= l ? acc[i] : 0.f); } }
        __syncthreads();
        if (wid < 4) { const int lt = wid >> 1, vt2 = wid & 1; f32x16 acc;
#pragma unroll
            for (int i = 0; i < 16; ++i) acc[i] = 0.f;
            mma_tile(acc, AM + 32 * lt * 72, 72, VT + 32 * vt2 * 72, 72, 4, lane);
            mma_tile(acc, QE + 32 * lt * 136, 136, ST + 32 * vt2 * 136, 136, 8, lane);
#pragma unroll
            for (int i = 0; i < 16; ++i) { const int l = 32 * lt + crow(i, hh); outp[(size_t)GROWQ(q, l) * 1024 + hd * 256 + vs * 64 + 32 * vt2 + rho] = f2bf(acc[i]); } }
        { const float dc = DEC[32 * sdt + rho];
#pragma unroll
          for (int i = 0; i < 16; ++i) st[i] *= dc;
          mma_tile(st, VT + 32 * svt * 72, 72, KDT + 32 * sdt * 72, 72, 4, lane); }
        __syncthreads();
    }
#undef GROWQ
#undef GLA_FETCH
}
struct GlaFinRow { bf16x8 a0, a1, b0, b1, g0, g1; };
DI void gla_fin_load(GlaFinRow& R, const bf16_t* OF, const bf16_t* OB, const bf16_t* P, int row, int c0) {
    R.a0 = *(const bf16x8*)(OF + (size_t)row * 1024 + c0); R.a1 = *(const bf16x8*)(OF + (size_t)row * 1024 + c0 + 8);
    R.b0 = *(const bf16x8*)(OB + (size_t)row * 1024 + c0); R.b1 = *(const bf16x8*)(OB + (size_t)row * 1024 + c0 + 8);
    R.g0 = *(const bf16x8*)(P + (size_t)row * 3072 + 2048 + c0); R.g1 = *(const bf16x8*)(P + (size_t)row * 3072 + 2048 + c0 + 8);
}
DI void gla_fin_store(const GlaFinRow& R, bf16_t* OF, const float* ng, int row, int c0) {
    float o[16]; float ss = 0.f;
#pragma unroll
    for (int e = 0; e < 8; ++e) { o[e] = bf2f((bf16_t)R.a0[e]) + bf2f((bf16_t)R.b0[e]); o[8 + e] = bf2f((bf16_t)R.a1[e]) + bf2f((bf16_t)R.b1[e]); }
#pragma unroll
    for (int e = 0; e < 16; ++e) ss += o[e] * o[e];
    ss += __shfl_xor(ss, 1); ss += __shfl_xor(ss, 2); ss += __shfl_xor(ss, 4); ss += __shfl_xor(ss, 8);
    const float rinv = rsqrtf(ss * (1.f / 256.f) + 1e-6f);
    float y[16];
#pragma unroll
    for (int e = 0; e < 16; ++e) { const float gt = bf2f((bf16_t)(e < 8 ? R.g0[e] : R.g1[e - 8])); y[e] = o[e] * rinv * ng[(c0 + e) & 255] * (gt * sigmoidf_(gt)); }
    u32x4 w0, w1; w0.x = cvtpk(y[0], y[1]); w0.y = cvtpk(y[2], y[3]); w0.z = cvtpk(y[4], y[5]); w0.w = cvtpk(y[6], y[7]);
    w1.x = cvtpk(y[8], y[9]); w1.y = cvtpk(y[10], y[11]); w1.z = cvtpk(y[12], y[13]); w1.w = cvtpk(y[14], y[15]);
    *(u32x4*)(OF + (size_t)row * 1024 + c0) = w0; *(u32x4*)(OF + (size_t)row * 1024 + c0 + 8) = w1;
}
DI void gla_finish(bf16_t* OF, const bf16_t* OB, const bf16_t* P, const float* ng, int Mrows, int gw, int ngw, int lane) {
    const int c0 = 16 * lane;
    for (int row = gw; row < Mrows; row += 2 * ngw) {
        const int rowB = row + ngw < Mrows ? row + ngw : row;
        GlaFinRow A, B;
        gla_fin_load(A, OF, OB, P, row, c0); gla_fin_load(B, OF, OB, P, rowB, c0);
        gla_fin_store(A, OF, ng, row, c0);
        if (rowB != row) gla_fin_store(B, OF, ng, rowB, c0);
    }
}

typedef unsigned u32x2_t __attribute__((ext_vector_type(2)));
DI float red_rows(float x) {
    unsigned u = __float_as_uint(x);
    u32x2_t r = __builtin_amdgcn_permlane16_swap(u, u, false, false);
    const float y = __uint_as_float(r.x) + __uint_as_float(r.y);
    unsigned v = __float_as_uint(y);
    u32x2_t q = __builtin_amdgcn_permlane32_swap(v, v, false, false);
    return __uint_as_float(q.x) + __uint_as_float(q.y);
}
DI int rw_row(int q, int l, int dir, int b) {
    int T, base, n;
    if (q < 8) { T = 256; base = ML + b * 256; n = q; } else { T = 4096; base = b * 4096; n = q - 8; }
    const int t = n * 32 + l;
    return base + (dir ? T - 1 - t : t);
}
#define DPPB(n) " row_newbcast:" #n " row_mask:0xf bank_mask:0xf\n\t"
#define RW_UPD(n, sreg) "v_mul_f32_dpp " sreg ", %17, " sreg DPPB(n) "v_fmac_f32_dpp " sreg ", %18, %21" DPPB(n) "v_fmac_f32_dpp " sreg ", %19, %22" DPPB(n)
DI void rwkv_unit(const Args& a, const bf16_t* RKV, const bf16_t* TWAA, bf16_t* Y  , float* RK  , unsigned char* lds, int unit, int tid) {
    const int lane = tid & 63, wid = __builtin_amdgcn_readfirstlane(tid >> 6);
    const int dir = unit & 1, hd = (unit >> 1) & 15, b = unit >> 5;
    float* SA = (float*)lds;
    float* YC = SA + 6 * 4096;
    bf16_t* W2T = (bf16_t*)(YC + 4096);
    bf16_t* A2T = W2T + 64 * 72;
    constexpr int NCH = 136;
    {
        const float* w2 = a.in[23] + (size_t)dir * 64 * 1024; const float* a2 = a.in[26] + (size_t)dir * 64 * 1024;
        for (int e = 0; e < 8; ++e) { const int idx = tid + 512 * e, j = idx >> 6, c = idx & 63; W2T[c * 72 + j] = f2bf(w2[(size_t)j * 1024 + hd * 64 + c]); A2T[c * 72 + j] = f2bf(a2[(size_t)j * 1024 + hd * 64 + c]); }
    }
    __syncthreads();
    bf16_t* yout = Y + (size_t)dir * MT * 1024; float* rkout = RK + (size_t)dir * MT * 16;
    if (wid >= 4) {
        const int pw = wid - 4, rho = lane & 31, h = lane >> 5, ptid = tid - 256;
        float cw0[2], ca0[2], ckk[2], cka[2], crk[2];
#pragma unroll
        for (int ct = 0; ct < 2; ++ct) { const int c = hd * 64 + 32 * ct + rho; cw0[ct] = a.in[21][dir * 1024 + c]; ca0[ct] = a.in[24][dir * 1024 + c]; ckk[ct] = a.in[29][c]; cka[ct] = a.in[30][c]; crk[ct] = a.in[31][c]; }
        for (int p = 0; p <= NCH + 1; ++p) {
            if (p < NCH) {
                const int buf = p & 1;
                const int rowA = rw_row(p, 8 * pw + (rho & 7), dir, b);
                const bf16_t* ta = TWAA + (size_t)rowA * 256 + dir * 64 + 8 * h;
                f32x16 zw0, zw1, za0, za1;
#pragma unroll
                for (int i = 0; i < 16; ++i) { zw0[i] = 0.f; zw1[i] = 0.f; za0[i] = 0.f; za1[i] = 0.f; }
#pragma unroll
                for (int s = 0; s < 4; ++s) {
                    const bf16x8 atw = *(const bf16x8*)(ta + 16 * s), aaa = *(const bf16x8*)(ta + 128 + 16 * s);
                    const bf16x8 bw0 = *(const bf16x8*)(W2T + rho * 72 + 16 * s + 8 * h), bw1 = *(const bf16x8*)(W2T + (32 + rho) * 72 + 16 * s + 8 * h);
                    const bf16x8 ba0 = *(const bf16x8*)(A2T + rho * 72 + 16 * s + 8 * h), ba1 = *(const bf16x8*)(A2T + (32 + rho) * 72 + 16 * s + 8 * h);
                    zw0 = MFMA32(atw, bw0, zw0); zw1 = MFMA32(atw, bw1, zw1); za0 = MFMA32(aaa, ba0, za0); za1 = MFMA32(aaa, ba1, za1);
                }
#pragma unroll
                for (int i = 0; i < 4; ++i) {
                    const int tok = 8 * pw + i + 4 * h; const int row = rw_row(p, tok, dir, b);
                    const bf16_t* pr = RKV + (size_t)row * 3072 + hd * 64 + rho;
                    float rv[2], kv[2], vv[2], av[2], kkv[2], kd[2]; float ss = 0.f, rk = 0.f;
#pragma unroll
                    for (int ct = 0; ct < 2; ++ct) {
                        rv[ct] = bf2f(pr[32 * ct]); kv[ct] = bf2f(pr[1024 + 32 * ct]); vv[ct] = bf2f(pr[2048 + 32 * ct]);
                        const float zav = ct ? za1[i] : za0[i];
                        av[ct] = 1.f / (1.f + __expf(-(ca0[ct] + zav)));
                        kkv[ct] = kv[ct] * ckk[ct]; ss += kkv[ct] * kkv[ct];
                        kd[ct] = kv[ct] * (1.f + (av[ct] - 1.f) * cka[ct]); rk += rv[ct] * kd[ct] * crk[ct];
                    }
#pragma unroll
                    for (int o = 1; o < 32; o <<= 1) { ss += __shfl_xor(ss, o); rk += __shfl_xor(rk, o); }
                    const float kinv = rsqrtf(fmaxf(ss, 1e-24f));
                    if (rho == 0) rkout[(size_t)row * 16 + hd] = rk;
#pragma unroll
                    for (int ct = 0; ct < 2; ++ct) {
                        const float zwv = ct ? zw1[i] : zw0[i];
                        const float x = -(cw0[ct] + zwv);
                        const float sp = fmaxf(x, 0.f) + __logf(1.f + __expf(-fabsf(x)));
                        const float dec = __expf(-__expf(-sp - 0.5f));
                        const float kn = kkv[ct] * kinv;
                        float* o = SA + buf * 2048 + tok * 64 + 32 * ct + rho;
                        o[0 * 4096] = dec; o[1 * 4096] = kd[ct]; o[2 * 4096] = kn * av[ct]; o[3 * 4096] = -kn; o[4 * 4096] = rv[ct]; o[5 * 4096] = vv[ct];
                    }
                }
            }
            if (p >= 2) {
                const int tok = ptid >> 3, i0 = (ptid & 7) * 8; const int row = rw_row(p - 2, tok, dir, b);
                const float* y = YC + (p & 1) * 2048 + tok * 64 + i0;
                const f32x4 y0 = *(const f32x4*)y, y1 = *(const f32x4*)(y + 4);
                *(u32x4*)(yout + (size_t)row * 1024 + hd * 64 + i0) = pack8(y0, y1);
            }
            __syncthreads();
        }
    } else {
        __builtin_amdgcn_s_setprio(3);
        const int rl = lane & 15, cg = lane >> 4, myrow = 16 * wid + rl;
        float s0 = 0.f, s1 = 0.f, s2 = 0.f, s3 = 0.f, s4 = 0.f, s5 = 0.f, s6 = 0.f, s7 = 0.f, s8 = 0.f, s9 = 0.f, s10 = 0.f, s11 = 0.f, s12 = 0.f, s13 = 0.f, s14 = 0.f, s15 = 0.f;
        for (int p = 0; p <= NCH + 1; ++p) {
            if (p >= 1 && p <= NCH) {
                const int buf = (p - 1) & 1;
                const float* base = SA + buf * 2048;
                float* yc = YC + buf * 2048 + myrow;
                float w_c = base[lane], kd_c = base[4096 + lane], bb_c = base[2 * 4096 + lane], nk_c = base[3 * 4096 + lane], r_c = base[4 * 4096 + lane], v_c = base[5 * 4096 + myrow];
                for (int t = 0; t < 32; ++t) {
                    const int tn = (t + 1) & 31;
                    const float w_n = base[tn * 64 + lane], kd_n = base[4096 + tn * 64 + lane], bb_n = base[2 * 4096 + tn * 64 + lane], nk_n = base[3 * 4096 + tn * 64 + lane], r_n = base[4 * 4096 + tn * 64 + lane], v_n = base[5 * 4096 + tn * 64 + myrow];
                    float sap;
                    asm volatile("s_nop 1\n\t"
                        "v_mul_f32_dpp %0, %1, %2" DPPB(0) "v_fmac_f32_dpp %0, %1, %3" DPPB(1) "v_fmac_f32_dpp %0, %1, %4" DPPB(2) "v_fmac_f32_dpp %0, %1, %5" DPPB(3)
                        "v_fmac_f32_dpp %0, %1, %6" DPPB(4) "v_fmac_f32_dpp %0, %1, %7" DPPB(5) "v_fmac_f32_dpp %0, %1, %8" DPPB(6) "v_fmac_f32_dpp %0, %1, %9" DPPB(7)
                        "v_fmac_f32_dpp %0, %1, %10" DPPB(8) "v_fmac_f32_dpp %0, %1, %11" DPPB(9) "v_fmac_f32_dpp %0, %1, %12" DPPB(10) "v_fmac_f32_dpp %0, %1, %13" DPPB(11)
                        "v_fmac_f32_dpp %0, %1, %14" DPPB(12) "v_fmac_f32_dpp %0, %1, %15" DPPB(13) "v_fmac_f32_dpp %0, %1, %16" DPPB(14) "v_fmac_f32_dpp %0, %1, %17" DPPB(15)
                        "s_nop 1"
                        : "=&v"(sap)
                        : "v"(nk_c), "v"(s0), "v"(s1), "v"(s2), "v"(s3), "v"(s4), "v"(s5), "v"(s6), "v"(s7), "v"(s8), "v"(s9), "v"(s10), "v"(s11), "v"(s12), "v"(s13), "v"(s14), "v"(s15));
                    const float sa = red_rows(sap);
                    float yp;
                    asm volatile("s_nop 1\n\t"
                        RW_UPD(0, "%0") RW_UPD(1, "%1") RW_UPD(2, "%2") RW_UPD(3, "%3") RW_UPD(4, "%4") RW_UPD(5, "%5") RW_UPD(6, "%6") RW_UPD(7, "%7")
                        RW_UPD(8, "%8") RW_UPD(9, "%9") RW_UPD(10, "%10") RW_UPD(11, "%11") RW_UPD(12, "%12") RW_UPD(13, "%13") RW_UPD(14, "%14") RW_UPD(15, "%15")
                        "v_mul_f32_dpp %16, %20, %0" DPPB(0) "v_fmac_f32_dpp %16, %20, %1" DPPB(1) "v_fmac_f32_dpp %16, %20, %2" DPPB(2) "v_fmac_f32_dpp %16, %20, %3" DPPB(3)
                        "v_fmac_f32_dpp %16, %20, %4" DPPB(4) "v_fmac_f32_dpp %16, %20, %5" DPPB(5) "v_fmac_f32_dpp %16, %20, %6" DPPB(6) "v_fmac_f32_dpp %16, %20, %7" DPPB(7)
                        "v_fmac_f32_dpp %16, %20, %8" DPPB(8) "v_fmac_f32_dpp %16, %20, %9" DPPB(9) "v_fmac_f32_dpp %16, %20, %10" DPPB(10) "v_fmac_f32_dpp %16, %20, %11" DPPB(11)
                        "v_fmac_f32_dpp %16, %20, %12" DPPB(12) "v_fmac_f32_dpp %16, %20, %13" DPPB(13) "v_fmac_f32_dpp %16, %20, %14" DPPB(14) "v_fmac_f32_dpp %16, %20, %15" DPPB(15)
                        "s_nop 1"
                        : "+v"(s0), "+v"(s1), "+v"(s2), "+v"(s3), "+v"(s4), "+v"(s5), "+v"(s6), "+v"(s7), "+v"(s8), "+v"(s9), "+v"(s10), "+v"(s11), "+v"(s12), "+v"(s13), "+v"(s14), "+v"(s15), "=&v"(yp)
                        : "v"(w_c), "v"(bb_c), "v"(kd_c), "v"(r_c), "v"(sa), "v"(v_c));
                    const float y = red_rows(yp);
                    if (cg == 0) yc[t * 64] = y;
                    w_c = w_n; kd_c = kd_n; bb_c = bb_n; nk_c = nk_n; r_c = r_n; v_c = v_n;
                }
            }
            __syncthreads();
        }
        __builtin_amdgcn_s_setprio(0);
    }
    __syncthreads();
}
struct RwFinRow { bf16x8 a0, a1, b0, b1, v0, v1, g0, g1; float rk; };
DI void rw_fin_load(RwFinRow& R, const bf16_t* YF, const bf16_t* YB, const bf16_t* RKV, const bf16_t* G, const float* RK, int row, int c0, int hd) {
    R.a0 = *(const bf16x8*)(YF + (size_t)row * 1024 + c0); R.a1 = *(const bf16x8*)(YF + (size_t)row * 1024 + c0 + 8);
    R.b0 = *(const bf16x8*)(YB + (size_t)row * 1024 + c0); R.b1 = *(const bf16x8*)(YB + (size_t)row * 1024 + c0 + 8);
    R.v0 = *(const bf16x8*)(RKV + (size_t)row * 3072 + 2048 + c0); R.v1 = *(const bf16x8*)(RKV + (size_t)row * 3072 + 2048 + c0 + 8);
    R.g0 = *(const bf16x8*)(G + (size_t)row * 1024 + c0); R.g1 = *(const bf16x8*)(G + (size_t)row * 1024 + c0 + 8);
    R.rk = RK[(size_t)row * 16 + hd] + RK[(size_t)MT * 16 + (size_t)row * 16 + hd];
}
DI void rw_fin_store(const RwFinRow& R, bf16_t* YF, const float* lng, const float* lnb, int row, int c0) {
    float y[16]; float sm = 0.f;
#pragma unroll
    for (int e = 0; e < 8; ++e) { y[e] = bf2f((bf16_t)R.a0[e]) + bf2f((bf16_t)R.b0[e]); y[8 + e] = bf2f((bf16_t)R.a1[e]) + bf2f((bf16_t)R.b1[e]); }
#pragma unroll
    for (int e = 0; e < 16; ++e) sm += y[e];
    sm += __shfl_xor(sm, 1); sm += __shfl_xor(sm, 2);
    const float mu = sm * (1.f / 64.f);
    float sv = 0.f;
#pragma unroll
    for (int e = 0; e < 16; ++e) { y[e] -= mu; sv += y[e] * y[e]; }
    sv += __shfl_xor(sv, 1); sv += __shfl_xor(sv, 2);
    const float rinv = rsqrtf(sv * (1.f / 64.f) + 64e-5f);
    float o[16];
#pragma unroll
    for (int e = 0; e < 16; ++e) { const float vv = bf2f((bf16_t)(e < 8 ? R.v0[e] : R.v1[e - 8])), gg = bf2f((bf16_t)(e < 8 ? R.g0[e] : R.g1[e - 8]));
        o[e] = (y[e] * rinv * lng[c0 + e] + lnb[c0 + e] + R.rk * vv) * gg; }
    u32x4 w0, w1; w0.x = cvtpk(o[0], o[1]); w0.y = cvtpk(o[2], o[3]); w0.z = cvtpk(o[4], o[5]); w0.w = cvtpk(o[6], o[7]);
    w1.x = cvtpk(o[8], o[9]); w1.y = cvtpk(o[10], o[11]); w1.z = cvtpk(o[12], o[13]); w1.w = cvtpk(o[14], o[15]);
    *(u32x4*)(YF + (size_t)row * 1024 + c0) = w0; *(u32x4*)(YF + (size_t)row * 1024 + c0 + 8) = w1;
}
DI void rwkv_finish(bf16_t* YF, const bf16_t* YB, const bf16_t* RKV, const bf16_t* G, const float* RK, const float* lng, const float* lnb, int Mrows, int gw, int ngw, int lane) {
    const int c0 = 16 * lane, hd = lane >> 2;
    for (int row = gw; row < Mrows; row += 2 * ngw) {
        const int rowB = row + ngw < Mrows ? row + ngw : row;
        RwFinRow A, B;
        rw_fin_load(A, YF, YB, RKV, G, RK, row, c0, hd); rw_fin_load(B, YF, YB, RKV, G, RK, rowB, c0, hd);
        rw_fin_store(A, YF, lng, lnb, row, c0);
        if (rowB != row) rw_fin_store(B, YF, lng, lnb, rowB, c0);
    }
}

#define XB_TMO      128
#define XB_XCNT(j)  (256  + 64 * (j))
#define XB_XSUB(j)  (1280 + 64 * (j))
#define XB_XGEN(j)  (2304 + 64 * (j))
#define XB_TOP      3328
#define XB_TOPGEN   3392
#define XCD_BAR_WORDS 3456
#define XB_SPIN_CAP (1u << 18)

__device__ __forceinline__ unsigned xb_ld(unsigned* p)              { return __hip_atomic_load(p, __ATOMIC_RELAXED, __HIP_MEMORY_SCOPE_AGENT); }
__device__ __forceinline__ unsigned xb_add(unsigned* p, unsigned v) { return __hip_atomic_fetch_add(p, v, __ATOMIC_RELAXED, __HIP_MEMORY_SCOPE_AGENT); }
__device__ __forceinline__ unsigned xb_xcc_id() { return (unsigned)__builtin_amdgcn_s_getreg((3 << 11) | 20) & 0xFu; }
#define XB_SPIN(cond, bar) do { unsigned _sp = 0; while (cond) { __builtin_amdgcn_s_sleep(1); \
    if ((++_sp & 255u) == 0u) { if (xb_ld(&(bar)[XB_TMO])) break; if (_sp > XB_SPIN_CAP) { atomicAdd(&(bar)[XB_TMO], 1u); break; } } } } while (0)

struct XcdBarrier {
    unsigned* bar; unsigned x;
    volatile LAS unsigned* st;
};

__device__ __forceinline__ XcdBarrier xcd_barrier_post(unsigned* bar, volatile LAS unsigned* st) {
    XcdBarrier b; b.bar = bar; b.x = xb_xcc_id(); b.st = st;
    if (threadIdx.x == 0) (void)xb_add(&bar[XB_XCNT(b.x)], 1u);
    return b;
}
__device__ __forceinline__ void xcd_barrier_complete(unsigned* bar, unsigned x, unsigned& nloc, unsigned& nx) {
    const unsigned G = gridDim.x * gridDim.y * gridDim.z;
    unsigned sum, cnt, mine, sp = 0u;
    for (;;) {
        sum = 0u; cnt = 0u; mine = 0u;
#pragma unroll
        for (unsigned j = 0; j < 16; ++j) { const unsigned c = xb_ld(&bar[XB_XCNT(j)]); sum += c; cnt += (c > 0u) ? 1u : 0u; mine = (j == x) ? c : mine; }
        if (sum == G) break;
        __builtin_amdgcn_s_sleep(1);
        if ((++sp & 255u) == 0u) { if (xb_ld(&bar[XB_TMO])) break; if (sp > XB_SPIN_CAP) { atomicAdd(&bar[XB_TMO], 1u); break; } }
    }
    nloc = mine > 0u ? mine : 1u; nx = cnt > 0u ? cnt : 1u;
}

__device__ __forceinline__ void xcd_barrier(const XcdBarrier& b) {
    asm volatile("s_waitcnt vmcnt(0)" ::: "memory");
    __syncthreads();
    if (threadIdx.x == 0) {
        unsigned* bar = b.bar;
        __builtin_amdgcn_s_waitcnt(0);
        unsigned nloc = b.st[0], nx = b.st[1];
        if (nloc == 0u) { xcd_barrier_complete(bar, b.x, nloc, nx); b.st[0] = nloc; b.st[1] = nx; }
        const unsigned old = xb_add(&bar[XB_XSUB(b.x)], 1u);
        const unsigned gen = old / nloc;
        if (old + 1u == (gen + 1u) * nloc) {
            __builtin_amdgcn_fence(__ATOMIC_RELEASE, "agent");
            asm volatile("s_waitcnt vmcnt(0)" ::: "memory");
            const unsigned og = xb_add(&bar[XB_TOP], 1u);
            const unsigned tg = og / nx;
            if (og + 1u == (tg + 1u) * nx) xb_add(&bar[XB_TOPGEN], 1u);
            else XB_SPIN(xb_ld(&bar[XB_TOPGEN]) == tg, bar);
            __builtin_amdgcn_fence(__ATOMIC_ACQUIRE, "agent");
            xb_add(&bar[XB_XGEN(b.x)], 1u);
            asm volatile("s_waitcnt vmcnt(0)" ::: "memory");
        } else {
            XB_SPIN(xb_ld(&bar[XB_XGEN(b.x)]) == gen, bar);
            __builtin_amdgcn_fence(__ATOMIC_ACQUIRE, "agent");
            asm volatile("s_waitcnt vmcnt(0)" ::: "memory");
        }
    }
    __syncthreads();
}

#define WSP(T, off) ((T*)(a.ws + (off)))
#define PHASE(k) if (lo <= (k) && (k) < hi)
#define SEAM(k) do { if ((k) + 1 < hi) xcd_barrier(xbar); } while (0)
template <int L> DI void run_layer(const Args& a, unsigned char* lds, const XcdBarrier& xbar, int lo, int hi) {
    constexpr int kind = L % 3, jj = L / 3, P0 = 1 + 8 * L;
    constexpr bool need_ctx = L < 3;
    constexpr int Mact = need_ctx ? MT : ML;
    const int tid = threadIdx.x, lane = tid & 63, wid = __builtin_amdgcn_readfirstlane(tid >> 6);
    const int gw = blockIdx.x * 8 + wid, ngw = gridDim.x * 8;
    LAS unsigned char* ldsl = (LAS unsigned char*)lds;
    PHASE(P0 + 0) {
        float* scr = (float*)(lds + wid * 8704);
        for (int rep = 0; rep < ((DUP & 16) ? 2 : 1); ++rep) {
        const float* modl = WSP(float, WS_MOD) + (size_t)L * 9 * 6144;
        phase_prenorm(L == 0 ? a.in[0] : a.out, L == 0 ? a.in[2] : WSP(float, WS_ZF), a.in[6] + L * 1024, modl, 0, WSP(bf16_t, WS_H2), kind == 2 ? 2048 : 1024, kind == 2, MT, gw, ngw, lane);
        bf16_t* Wmix = WSP(bf16_t, W_MIX); bf16_t* Wo = WSP(bf16_t, W_O);
        conv_job(a.in[8] + (size_t)L * 1024 * 4096, 4096, 1024, 4096, 1024, 4096, nullptr, 0, WSP(bf16_t, W_1), 1024, 0, 0, scr, gw, ngw, lane);
        conv_job(a.in[9] + (size_t)L * 4096 * 1024, 1024, 4096, 1024, 4096, 1024, nullptr, 0, WSP(bf16_t, W_2), 4096, 0, 0, scr, gw, ngw, lane);
        if (kind == 0) {
            conv_job(a.in[11] + (size_t)jj * 1024 * 3072, 3072, 1024, 3072, 1024, 3072, nullptr, 0, Wmix, 1024, 0, 0, scr, gw, ngw, lane);
            conv_job(a.in[12] + (size_t)jj * 1024 * 1024, 1024, 1024, 1024, 1024, 1024, nullptr, 0, Wo, 1024, 0, 0, scr, gw, ngw, lane);
        } else if (kind == 1) {
            conv_job(a.in[14], 3104, 1024, 3104, 1024, 3328, nullptr, 0, Wmix, 1024, 0, 0, scr, gw, ngw, lane);
            conv_job(a.in[18], 1024, 1024, 1024, 1024, 1024, nullptr, 0, Wo, 1024, 0, 0, scr, gw, ngw, lane);
        } else {
            const float* mix = a.in[19];
            for (int md = 1; md <= 2; ++md) {
                const int co = (md - 1) * 1024;
                for (int q = 0; q < 3; ++q) conv_job(a.in[20] + (size_t)q * 1024 * 1024, 1024, 1024, 1024, 1024, 1024, mix + (q == 0 ? 0 : q + 1) * 1024, md, Wmix, 2048, q * 1024, co, scr, gw, ngw, lane);
                conv_job(a.in[27], 160, 1024, 160, 1024, 256, mix + 5 * 1024, md, Wmix, 2048, 3072, co, scr, gw, ngw, lane);
                for (int q = 0; q < 2; ++q) conv_job(a.in[22] + (size_t)q * 1024 * 64, 64, 1024, 64, 1024, 64, mix + 1 * 1024, md, Wmix, 2048, 3328 + 64 * q, co, scr, gw, ngw, lane);
                for (int q = 0; q < 2; ++q) conv_job(a.in[25] + (size_t)q * 1024 * 64, 64, 1024, 64, 1024, 64, mix + 4 * 1024, md, Wmix, 2048, 3456 + 64 * q, co, scr, gw, ngw, lane);
            }
            conv_job(a.in[28], 1024, 160, 1024, 256, 1024, nullptr, 0, WSP(bf16_t, W_G2), 256, 0, 0, scr, gw, ngw, lane);
            conv_job(a.in[34], 1024, 1024, 1024, 1024, 1024, nullptr, 0, Wo, 1024, 0, 0, scr, gw, ngw, lane);
        }
        }
        SEAM(P0 + 0);
    }
    PHASE(P0 + 1) {
        bf16_t* BIG = WSP(bf16_t, WS_BIG);
        for (int rep = 0; rep < ((DUP & 8) ? 2 : 1); ++rep) {
        if (kind == 0) run_gemm(ldsl, WSP(bf16_t, WS_H2), WSP(bf16_t, W_MIX), MT, 3072, 1024, InNaQkv{BIG, BIG + (size_t)MT * 2048, BIG + (size_t)MT * 2048 + (size_t)ML * 1024});
        else if (kind == 1) run_gemm(ldsl, WSP(bf16_t, WS_H2), WSP(bf16_t, W_MIX), MT, 3328, 1024, InGlaIn{BIG, WSP(float, WS_LR)});
        else run_gemm(ldsl, WSP(bf16_t, WS_H2), WSP(bf16_t, W_MIX), MT, 3584, 2048, InRwL1{BIG, BIG + (size_t)MT * 3072, BIG + (size_t)MT * 3328});
        }
        SEAM(P0 + 1);
    }
    PHASE(P0 + 2) {
        bf16_t* BIG = WSP(bf16_t, WS_BIG); bf16_t* H2 = WSP(bf16_t, WS_H2);
        const int vcu = (gridDim.x % 8 == 0) ? (int)((blockIdx.x % 8) * (gridDim.x / 8) + blockIdx.x / 8) : (int)blockIdx.x;
        const int gwv = vcu * 8 + wid;
        if (kind == 0) {
            const bf16_t* VTL = BIG + (size_t)MT * 2048; const bf16_t* VTC = VTL + (size_t)ML * 1024;
            const float* rpb = a.in[13] + (size_t)jj * 16 * 15 * 31;
            const int nu = 8192 + (need_ctx ? 512 : 0);
#ifndef NO_ATTN
            float* tbl = (float*)(lds + wid * 7680);
            int tbl_hd = -1;
            for (int rep = 0; rep < ((DUP & 1) ? 2 : 1); ++rep)
            for (int u = gwv; u < nu; u += ngw) {
                if (u < 8192) {
                    const int hd_ = (u >> 6) & 15;
                    if (hd_ != tbl_hd) {
                        for (int e = lane; e < 465; e += 64) { const int rr = e / 31, cc = e - rr * 31; tbl[rr * 128 + 48 + cc] = rpb[hd_ * 465 + e] * 1.4426950408889634f; }
                        tbl_hd = hd_;
                    }
                    attn_unit(BIG, VTL, VTC, H2, tbl, u >> 10, hd_, u & 63, 0, lane);
                }
                else { const int v = u - 8192; attn_unit(BIG, VTL, VTC, H2, tbl, v >> 6, (v >> 2) & 15, -1, v & 3, lane); }
            }
#endif
        } else if (kind == 1) {
#ifndef NO_GLA
            for (int rep = 0; rep < ((DUP & 2) ? 2 : 1); ++rep)
            gla_gates(WSP(float, WS_LR), a.in[15], a.in[16], BIG + (size_t)MT * 3072, (float*)lds, tid);
            xcd_barrier(xbar);
            for (int u = vcu; u < 256; u += gridDim.x) gla_unit(BIG, BIG + (size_t)MT * 3072, H2, lds, u, tid);
#endif
        } else {
#ifndef NO_RWKV
            for (int rep = 0; rep < ((DUP & 4) ? 2 : 1); ++rep)
            for (int u = vcu; u < 256; u += gridDim.x) rwkv_unit(a, BIG, BIG + (size_t)MT * 3328, H2, WSP(float, WS_RK), lds, u, tid);
#endif
            run_gemm(ldsl, BIG + (size_t)MT * 3072, WSP(bf16_t, W_G2), MT, 1024, 256, InStore<0>{WSP(bf16_t, WS_G), 1024});
        }
        SEAM(P0 + 2);
    }
    if (kind != 0) {
        PHASE(P0 + 3) {
            bf16_t* H2 = WSP(bf16_t, WS_H2);
            if (kind == 1) gla_finish(H2, H2 + (size_t)MT * 1024, WSP(bf16_t, WS_BIG), a.in[17], Mact, gw, ngw, lane);
            else rwkv_finish(H2, H2 + (size_t)MT * 1024, WSP(bf16_t, WS_BIG), WSP(bf16_t, WS_G), WSP(float, WS_RK), a.in[32], a.in[33], Mact, gw, ngw, lane);
            SEAM(P0 + 3);
        }
    }
    PHASE(P0 + 4) {
        if (DUP & 32) run_gemm(ldsl, WSP(bf16_t, WS_H2), WSP(bf16_t, W_O), Mact, 1024, 1024, InResid{L == 0 ? a.in[0] : a.out, L == 0 ? a.in[2] : WSP(float, WS_ZF), WSP(float, WS_BIG), WSP(float, WS_BIG) + (size_t)ML * 1024, WSP(float, WS_MOD) + (size_t)L * 9 * 6144 + 2 * 1024});
        run_gemm(ldsl, WSP(bf16_t, WS_H2), WSP(bf16_t, W_O), Mact, 1024, 1024, InResid{L == 0 ? a.in[0] : a.out, L == 0 ? a.in[2] : WSP(float, WS_ZF), a.out, WSP(float, WS_ZF), WSP(float, WS_MOD) + (size_t)L * 9 * 6144 + 2 * 1024});
        SEAM(P0 + 4);
    }
    PHASE(P0 + 5) {
        for (int rep = 0; rep < ((DUP & 16) ? 2 : 1); ++rep)
        phase_prenorm(a.out, WSP(float, WS_ZF), a.in[7] + L * 1024, WSP(float, WS_MOD) + (size_t)L * 9 * 6144, 3, WSP(bf16_t, WS_H2), 1024, false, Mact, gw, ngw, lane);
        SEAM(P0 + 5);
    }
    PHASE(P0 + 6) {
        for (int rep = 0; rep < ((DUP & 8) ? 2 : 1); ++rep)
        run_gemm(ldsl, WSP(bf16_t, WS_H2), WSP(bf16_t, W_1), Mact, 4096, 1024, InStore<1>{WSP(bf16_t, WS_BIG), 4096});
        SEAM(P0 + 6);
    }
    PHASE(P0 + 7) {
        if (DUP & 32) run_gemm(ldsl, WSP(bf16_t, WS_BIG), WSP(bf16_t, W_2), Mact, 1024, 4096, InResid{a.out, WSP(float, WS_ZF), WSP(float, WS_H2), WSP(float, WS_H2) + (size_t)ML * 1024, WSP(float, WS_MOD) + (size_t)L * 9 * 6144 + 5 * 1024});
        run_gemm(ldsl, WSP(bf16_t, WS_BIG), WSP(bf16_t, W_2), Mact, 1024, 4096, InResid{a.out, WSP(float, WS_ZF), a.out, WSP(float, WS_ZF), WSP(float, WS_MOD) + (size_t)L * 9 * 6144 + 5 * 1024});
        SEAM(P0 + 7);
    }
}
__global__ void __launch_bounds__(NTHREADS, 2) mega(Args a) {
    extern __shared__ __attribute__((aligned(16))) unsigned char lds[];
    cg::grid_group grid = cg::this_grid();
    const int lo = a.lo, hi = a.hi;
    volatile LAS unsigned* xst = (volatile LAS unsigned*)((LAS unsigned char*)lds + (LDS_BYTES - 64));
    if (threadIdx.x < 2) xst[threadIdx.x] = 0u;
    __syncthreads();
    const XcdBarrier xbar = xcd_barrier_post((unsigned*)(a.ws + WS_BAR), xst);
    PHASE(0) { phase_mod(a, (float*)lds, threadIdx.x); if (1 < hi) grid.sync(); }
    run_layer<0>(a, lds, xbar, lo, hi);
    run_layer<1>(a, lds, xbar, lo, hi);
    run_layer<2>(a, lds, xbar, lo, hi);
    run_layer<3>(a, lds, xbar, lo, hi);
    PHASE(33) {
        const int tid = threadIdx.x, lane = tid & 63, wid = tid >> 6;
        const int gw = blockIdx.x * 8 + wid, ngw = gridDim.x * 8;
        const float* fg = a.in[10];
        for (int st = gw; st < ML / 4; st += ngw) {
            f32x4 v[4][4]; float ss[4];
#pragma unroll
            for (int r = 0; r < 4; ++r) { const float* xr = a.out + (size_t)(4 * st + r) * 1024;
#pragma unroll
                for (int j = 0; j < 4; ++j) v[r][j] = *(const f32x4*)(xr + 4 * lane + 256 * j); }
#pragma unroll
            for (int r = 0; r < 4; ++r) { float s = 0.f;
#pragma unroll
                for (int j = 0; j < 4; ++j) s += (v[r][j].x * v[r][j].x + v[r][j].y * v[r][j].y) + (v[r][j].z * v[r][j].z + v[r][j].w * v[r][j].w);
                ss[r] = s; }
#pragma unroll
            for (int o = 1; o < 64; o <<= 1) {
#pragma unroll
                for (int r = 0; r < 4; ++r) ss[r] += __shfl_xor(ss[r], o);
            }
#pragma unroll
            for (int r = 0; r < 4; ++r) { const float rinv = rsqrtf(ss[r] * (1.f / 1024.f) + 1e-6f); float* xr = a.out + (size_t)(4 * st + r) * 1024;
#pragma unroll
                for (int j = 0; j < 4; ++j) *(f32x4*)(xr + 4 * lane + 256 * j) = v[r][j] * rinv * *(const f32x4*)(fg + 4 * lane + 256 * j); }
        }
    }
}

#ifndef GM
#define GM 0xffff
#endif
#ifndef MULTI_LAUNCH
#define MULTI_LAUNCH 0
#endif
extern "C" void kernel_launch(void* const* d_in, const int* in_sizes, int n_in, void* d_out, int out_size, void* d_ws, size_t ws_size, hipStream_t stream) {
    static int grid_blocks = 0;
    if (!grid_blocks) {
        int dev = 0, cus = 0, per_cu = 0;
        hipGetDevice(&dev);
        hipDeviceGetAttribute(&cus, hipDeviceAttributeMultiprocessorCount, dev);
        hipFuncSetAttribute((const void*)mega, hipFuncAttributeMaxDynamicSharedMemorySize, LDS_BYTES);
        hipOccupancyMaxActiveBlocksPerMultiprocessor(&per_cu, (const void*)mega, NTHREADS, LDS_BYTES);
        if (per_cu < 1) per_cu = 1;
        grid_blocks = cus * per_cu;
    }
    (void)hipMemsetAsync((char*)d_ws + WS_BAR, 0, XCD_BAR_WORDS * 4, stream);
    Args a{};
    for (int i = 0; i < 35; ++i) a.in[i] = (const float*)d_in[i];
    a.out = (float*)d_out; a.ws = (unsigned char*)d_ws;
#if MULTI_LAUNCH
    for (int p = 0; p < 34; ++p) { a.lo = p; a.hi = p + 1; hipLaunchKernelGGL(mega, dim3(grid_blocks), dim3(NTHREADS), LDS_BYTES, stream, a); }
#else
    a.lo = 0; a.hi = 34;
    void* args[] = {&a};
    hipError_t e = hipLaunchCooperativeKernel((const void*)mega, dim3(grid_blocks), dim3(NTHREADS), args, LDS_BYTES, stream);
    if (e != hipSuccess) fprintf(stderr, "cooperative launch failed: %s (grid %d)\n", hipGetErrorString(e), grid_blocks);
#endif
}
```

```cpp
#include <hip/hip_runtime.h>
#include <hip/hip_cooperative_groups.h>
#include <cstdio>
#include <cstdint>
namespace cg = cooperative_groups;

namespace pg8 {
#define PG8_LAS __attribute__((address_space(3)))
typedef unsigned short bf16_t;
typedef short bf16x8 __attribute__((ext_vector_type(8)));
typedef float f32x4 __attribute__((ext_vector_type(4)));
typedef unsigned u32x4 __attribute__((ext_vector_type(4)));
constexpr int BM = 256, BK = 64, HALF = 128, HTB = HALF * BK * 2  , STAGE_BYTES = 8 * HTB, NXCD = 8, WGM = 8;

__host__ __device__ __forceinline__ int lds_byte(int r, int c) { const int st = (r >> 4) * 2 + (c >> 5), rr = r & 15, cc = c & 31, ob = rr * 64 + cc * 2; return st * 1024 + (ob ^ (((ob >> 9) & 1) << 5)); }
__host__ __device__ __forceinline__ void stage_rc(int b, int& R, int& C) { const int st = b / 1024, sb = b % 1024, swz = sb ^ (((sb >> 9) & 1) << 5); R = (st >> 1) * 16 + swz / 64; C = (st & 1) * 32 + (swz % 64) / 2; }
__host__ __device__ __forceinline__ int perm32(int rho) { const int n = rho >> 4, i = rho & 15; return 8 * (i >> 2) + 4 * n + (i & 3); }

struct Unit { int pm, pn; };
struct Gemm { const bf16_t* A; const bf16_t* Bt; int M, N, K; };

struct StaticOrder {
    int nM, nN, nwg, G, c;
    __host__ __device__ void init(int M, int N, int G_, int c_) { nM = M / BM; nN = N / BM; nwg = nM * nN; G = G_; c = c_; }
    __host__ __device__ bool next(int i, Unit& u) const {
        const long L = (long)i * G + c; if (L >= nwg) return false;
        int wgid = (int)L; { const int q = nwg / NXCD, r = nwg % NXCD, xcd = wgid % NXCD, off = wgid / NXCD; wgid = (xcd < r ? xcd * (q + 1) : r * (q + 1) + (xcd - r) * q) + off; }
        const int nig = WGM * nN, gid = wgid / nig, fm = gid * WGM, gsz = (nM - fm) < WGM ? (nM - fm) : WGM;
        u.pm = fm + ((wgid % nig) % gsz); u.pn = (wgid % nig) / gsz; return true;
    }
    __device__ __forceinline__ void a_ready(const Unit&) const {}
    __device__ __forceinline__ void done(const Unit&) const {}
};

__device__ __forceinline__ unsigned cvt_pk_bf16(float lo, float hi) { unsigned r; asm volatile("v_cvt_pk_bf16_f32 %0, %1, %2" : "=v"(r) : "v"(lo), "v"(hi)); return r; }
template <class Epi, class Sched, bool ALIGN_EPI = false, bool SP2 = false>
__device__ __forceinline__ void gemm_phase(PG8_LAS unsigned char* lds, const Gemm g, const Sched& S, const Epi& E) {
    const int tid = threadIdx.x, wid = __builtin_amdgcn_readfirstlane(tid >> 6), lane = tid & 63, wr = wid >> 2, wc = wid & 3, fr = lane & 15, fq = lane >> 4;
    const int K = g.K, nt = K / BK;
    unsigned voffA[2], voffB[2];
#pragma unroll
    for (int i = 0; i < 2; ++i) { int R, C; stage_rc(tid * 16 + i * 8192, R, C); const int Rb = Epi::PERM ? ((R & ~31) + perm32(R & 31)) : R;
        voffA[i] = (unsigned)(R * K + C) * 2u; voffB[i] = (unsigned)(Rb * K + C) * 2u; }
    const size_t kstep = (size_t)(BK * 2);
    const size_t hstep = (size_t)HALF * K * 2;
    const size_t tstep = 2 * hstep;
    const unsigned ldsw = (unsigned)wid * 1024u;
    const int aoff = lds_byte(wr * 64 + fr, fq * 8), boff = lds_byte(wc * 32 + fr, fq * 8);
#define PG8_SA(b, h) (((b) * 2 + (h)) * HTB)
#define PG8_SB(b, h) ((4 + (b) * 2 + (h)) * HTB)
#define PG8_STAGE(bufoff, gbase, voff) do { _Pragma("unroll") for (int _i = 0; _i < 2; ++_i) \
        __builtin_amdgcn_global_load_lds((const unsigned*)((const char*)(gbase) + (voff)[_i]), (PG8_LAS unsigned*)(lds + (bufoff) + ldsw + _i * 8192), 16, 0, 0); } while (0)
#define PG8_LDA(dst, b, h) do { _Pragma("unroll") for (int m = 0; m < 4; ++m) _Pragma("unroll") for (int k = 0; k < 2; ++k) dst[m][k] = *(const PG8_LAS bf16x8*)(lds + PG8_SA(b, h) + aoff + m * 2048 + k * 1024); } while (0)
#define PG8_LDB(dst, b, h) do { _Pragma("unroll") for (int n = 0; n < 2; ++n) _Pragma("unroll") for (int k = 0; k < 2; ++k) dst[n][k] = *(const PG8_LAS bf16x8*)(lds + PG8_SB(b, h) + boff + n * 2048 + k * 1024); } while (0)
#define PG8_MMA(ai, bj, At, Bt) do { __builtin_amdgcn_s_setprio(1); _Pragma("unroll") for (int m = 0; m < 4; ++m) _Pragma("unroll") for (int n = 0; n < 2; ++n) _Pragma("unroll") for (int k = 0; k < 2; ++k) \
        acc[ai][bj][m][n] = __builtin_amdgcn_mfma_f32_16x16x32_bf16(Bt[n][k], At[m][k], acc[ai][bj][m][n], 0, 0, 0); __builtin_amdgcn_s_setprio(0); } while (0)
#define PG8_WAIT_V(n) asm volatile("s_waitcnt vmcnt(" #n ")" ::: "memory")
#define PG8_WAIT_L(n) asm volatile("s_waitcnt lgkmcnt(" #n ")" ::: "memory")
#define PG8_BAR __builtin_amdgcn_s_barrier()
#define PG8_SCHED __builtin_amdgcn_sched_barrier(0)
    Unit cur, nxt; int ui = 0;
    if (!S.next(0, cur)) return;
    f32x4 acc[2][2][4][2];
#pragma unroll
    for (int a = 0; a < 2; ++a)
#pragma unroll
        for (int b = 0; b < 2; ++b)
#pragma unroll
            for (int m = 0; m < 4; ++m)
#pragma unroll
                for (int n = 0; n < 2; ++n) acc[a][b][m][n] = (f32x4){0.f, 0.f, 0.f, 0.f};
    bf16x8 At[4][2], B0[2][2], B1[2][2];
    const char* cA = (const char*)g.A + (size_t)cur.pm * tstep; const char* cB = (const char*)g.Bt + (size_t)cur.pn * tstep;
    S.a_ready(cur);
    if constexpr (SP2) {
        PG8_STAGE(PG8_SB(0, 0), cB, voffB); PG8_STAGE(PG8_SB(0, 1), cB + hstep, voffB); PG8_STAGE(PG8_SA(0, 0), cA, voffA); PG8_STAGE(PG8_SA(0, 1), cA + hstep, voffA);
        if (wr == 1) PG8_BAR;
        PG8_WAIT_V(2); PG8_BAR;
        PG8_STAGE(PG8_SB(1, 0), cB + kstep, voffB); PG8_STAGE(PG8_SA(1, 0), cA + kstep, voffA); PG8_STAGE(PG8_SB(1, 1), cB + hstep + kstep, voffB);
        PG8_WAIT_V(6); PG8_BAR;
    } else {
        PG8_STAGE(PG8_SB(0, 0), cB, voffB); PG8_STAGE(PG8_SA(0, 0), cA, voffA); PG8_STAGE(PG8_SB(0, 1), cB + hstep, voffB); PG8_STAGE(PG8_SA(0, 1), cA + hstep, voffA);
        if (wr == 1) PG8_BAR;
        PG8_WAIT_V(4); PG8_BAR;
        PG8_STAGE(PG8_SB(1, 0), cB + kstep, voffB); PG8_STAGE(PG8_SA(1, 0), cA + kstep, voffA); PG8_STAGE(PG8_SB(1, 1), cB + hstep + kstep, voffB);
        PG8_WAIT_V(6); PG8_BAR;
    }
    for (;;) {
        const bool has_next = S.next(ui + 1, nxt);
        const char* nA = has_next ? (const char*)g.A + (size_t)nxt.pm * tstep : cA; const char* nB = has_next ? (const char*)g.Bt + (size_t)nxt.pn * tstep : cB;
        for (int t = 0; t < nt; t += 2) {
            const bool last = (t == nt - 2);
            const char* a1 = cA + (size_t)(t + 1) * kstep;
            const char* a2 = last ? nA : cA + (size_t)(t + 2) * kstep; const char* b2 = last ? nB : cB + (size_t)(t + 2) * kstep;
            const char* a3 = a2 + kstep; const char* b3 = b2 + kstep;
            if (last && has_next) S.a_ready(nxt);
            if constexpr (SP2) {
            PG8_LDB(B0, 0, 0); PG8_LDB(B1, 0, 1); PG8_SCHED; PG8_LDA(At, 0, 0); PG8_STAGE(PG8_SA(1, 1), a1 + hstep, voffA);
            PG8_WAIT_V(8); PG8_WAIT_L(0); PG8_BAR; PG8_MMA(0, 0, At, B0); PG8_MMA(0, 1, At, B1); PG8_BAR; PG8_SCHED;
            PG8_LDA(At, 0, 1); PG8_STAGE(PG8_SB(0, 0), b2, voffB); PG8_STAGE(PG8_SB(0, 1), b2 + hstep, voffB); PG8_STAGE(PG8_SA(0, 0), a2, voffA);
            PG8_WAIT_V(8); PG8_WAIT_L(0); PG8_BAR; PG8_MMA(1, 0, At, B0); PG8_MMA(1, 1, At, B1); PG8_BAR; PG8_SCHED;
            PG8_LDB(B0, 1, 0); PG8_LDB(B1, 1, 1); PG8_SCHED; PG8_LDA(At, 1, 0); PG8_STAGE(PG8_SA(0, 1), a2 + hstep, voffA);
            PG8_WAIT_V(8); PG8_WAIT_L(0); PG8_BAR; PG8_MMA(0, 0, At, B0); PG8_MMA(0, 1, At, B1); PG8_BAR; PG8_SCHED;
            PG8_LDA(At, 1, 1); PG8_STAGE(PG8_SB(1, 0), b3, voffB); PG8_STAGE(PG8_SB(1, 1), b3 + hstep, voffB); PG8_STAGE(PG8_SA(1, 0), a3, voffA);
            PG8_WAIT_V(8); PG8_WAIT_L(0); PG8_BAR; PG8_MMA(1, 0, At, B0); PG8_MMA(1, 1, At, B1); PG8_BAR; PG8_SCHED;
            } else {
            PG8_LDB(B0, 0, 0); PG8_SCHED; PG8_LDA(At, 0, 0); PG8_STAGE(PG8_SA(1, 1), a1 + hstep, voffA);
            PG8_WAIT_L(8); PG8_BAR; PG8_WAIT_L(0); PG8_MMA(0, 0, At, B0); PG8_BAR; PG8_SCHED;
            PG8_LDB(B1, 0, 1); PG8_STAGE(PG8_SB(0, 0), b2, voffB);
            PG8_BAR; PG8_WAIT_L(0); PG8_MMA(0, 1, At, B1); PG8_BAR;
            PG8_LDA(At, 0, 1); PG8_STAGE(PG8_SA(0, 0), a2, voffA);
            PG8_BAR; PG8_WAIT_L(0); PG8_MMA(1, 0, At, B0); PG8_BAR; PG8_SCHED;
            PG8_STAGE(PG8_SB(0, 1), b2 + hstep, voffB);
            PG8_WAIT_V(6); PG8_BAR; PG8_MMA(1, 1, At, B1); PG8_BAR;
            PG8_LDB(B0, 1, 0); PG8_SCHED; PG8_LDA(At, 1, 0); PG8_STAGE(PG8_SA(0, 1), a2 + hstep, voffA);
            PG8_WAIT_L(8); PG8_BAR; PG8_WAIT_L(0); PG8_MMA(0, 0, At, B0); PG8_BAR; PG8_SCHED;
            PG8_LDB(B1, 1, 1); PG8_STAGE(PG8_SB(1, 0), b3, voffB);
            PG8_BAR; PG8_WAIT_L(0); PG8_MMA(0, 1, At, B1); PG8_BAR;
            PG8_LDA(At, 1, 1); PG8_STAGE(PG8_SA(1, 0), a3, voffA);
            PG8_BAR; PG8_WAIT_L(0); PG8_MMA(1, 0, At, B0); PG8_BAR; PG8_SCHED;
            PG8_STAGE(PG8_SB(1, 1), b3 + hstep, voffB);
            PG8_WAIT_V(6); PG8_BAR; PG8_MMA(1, 1, At, B1); PG8_BAR;
            }
        }
        if constexpr (ALIGN_EPI) { if (wr == 0) PG8_BAR; }
        if constexpr (!Epi::AFTER_DRAIN) { E(acc, cur, wr, wc, fr, fq); S.done(cur); }
        if (!has_next) break;
#pragma unroll
        for (int a = 0; a < 2; ++a)
#pragma unroll
            for (int b = 0; b < 2; ++b)
#pragma unroll
                for (int m = 0; m < 4; ++m)
#pragma unroll
                    for (int n = 0; n < 2; ++n) acc[a][b][m][n] = (f32x4){0.f, 0.f, 0.f, 0.f};
        cur = nxt; cA = nA; cB = nB; ++ui;
        if constexpr (ALIGN_EPI) { if (wr == 1) PG8_BAR; }
    }
    PG8_WAIT_V(0);
    if constexpr (!ALIGN_EPI) { if (wr == 0) PG8_BAR; }
    PG8_BAR;
    if constexpr (Epi::AFTER_DRAIN) { E.fused(acc, cur, wr, wc, fr, fq, lds, wid, lane); S.done(cur); }
#undef PG8_SA
#undef PG8_SB
#undef PG8_STAGE
#undef PG8_LDA
#undef PG8_LDB
#undef PG8_MMA
#undef PG8_WAIT_V
#undef PG8_WAIT_L
#undef PG8_BAR
#undef PG8_SCHED
}
}

#ifndef DUP
#define DUP 0
#endif
#define DI __device__ __forceinline__
#define LAS __attribute__((address_space(3)))
typedef unsigned short bf16_t;
typedef short bf16x8 __attribute__((ext_vector_type(8)));
typedef float f32x4 __attribute__((ext_vector_type(4)));
typedef float f32x16 __attribute__((ext_vector_type(16)));
typedef unsigned u32x4 __attribute__((ext_vector_type(4)));
typedef unsigned u32x2 __attribute__((ext_vector_type(2)));
typedef float f32x2_t __attribute__((ext_vector_type(2)));
typedef __bf16 bf16x2_t __attribute__((ext_vector_type(2)));

constexpr int D = 1024, NB = 8, SEQ = 4096, CTX = 256, FF = 4096;
constexpr int ML = NB * SEQ, MC = NB * CTX, MT = ML + MC;
constexpr size_t MiB = 1u << 20;
constexpr size_t WS_MOD = 0, WS_ZF = 1 * MiB, WS_RK = 9 * MiB, WS_LR = 14 * MiB, WS_W = 20 * MiB, WS_H2 = 56 * MiB, WS_BIG = 192 * MiB, WS_G = 430 * MiB;
constexpr size_t W_MIX = WS_W, W_O = WS_W + 14 * MiB, W_G2 = WS_W + 16 * MiB, W_1 = WS_W + 17 * MiB, W_2 = WS_W + 25 * MiB;
constexpr int LDS_BYTES = 147456;
constexpr size_t WS_BAR = 983040;
constexpr int NTHREADS = 512;

struct Args { const float* in[35]; float* out; unsigned char* ws; int lo, hi; };

DI float bf2f(bf16_t v) { return __uint_as_float(((unsigned)v) << 16); }
DI unsigned cvtpk(float lo, float hi) { f32x2_t v = {lo, hi}; bf16x2_t b = __builtin_convertvector(v, bf16x2_t); return __builtin_bit_cast(unsigned, b); }
DI bf16_t f2bf(float x) { return (bf16_t)(cvtpk(x, 0.f) & 0xffffu); }
DI float wave_sum(float v) {
#pragma unroll
    for (int o = 1; o < 64; o <<= 1) v += __shfl_xor(v, o);
    return v;
}
DI float sigmoidf_(float x) { return 1.f / (1.f + __expf(-x)); }
DI float softplusf_(float x) { return fmaxf(x, 0.f) + log1pf(__expf(-fabsf(x))); }
DI int crow(int i, int h) { return (i & 3) + 8 * (i >> 2) + 4 * h; }
#define LDS_BARRIER() do { asm volatile("s_waitcnt lgkmcnt(0)" ::: "memory"); __builtin_amdgcn_s_barrier(); asm volatile("" ::: "memory"); } while (0)
#define MFMA32(a, b, c) __builtin_amdgcn_mfma_f32_32x32x16_bf16((a), (b), (c), 0, 0, 0)

DI void mma_tile(f32x16& acc, const bf16_t* A, int lda, const bf16_t* Bt, int ldb, int ksteps, int lane) {
    const int rho = lane & 31, h = lane >> 5;
    const bf16_t* ap = A + rho * lda + 8 * h; const bf16_t* bp = Bt + rho * ldb + 8 * h;
    for (int s = 0; s < ksteps; ++s) {
        bf16x8 av = *(const bf16x8*)(ap + 16 * s); bf16x8 bv = *(const bf16x8*)(bp + 16 * s);
        acc = MFMA32(av, bv, acc);
    }
}

template <class Inner> struct Epi {
    static constexpr bool PERM = true, AFTER_DRAIN = false;
    Inner in;
    DI void operator()(const pg8::f32x4 (&acc)[2][2][4][2], const pg8::Unit& u, int wr, int wc, int fr, int fq) const {
        const int row0 = u.pm * 256 + wr * 64 + fr, col0 = u.pn * 256 + wc * 32 + 8 * fq;
#pragma unroll
        for (int ai = 0; ai < 2; ++ai)
#pragma unroll
            for (int m = 0; m < 4; ++m) {
                const int row = row0 + ai * 128 + m * 16;
#pragma unroll
                for (int bj = 0; bj < 2; ++bj) in.store8(row, col0 + bj * 128, acc[ai][bj][m][0], acc[ai][bj][m][1]);
            }
    }
};
DI u32x4 pack8(f32x4 a, f32x4 b) { u32x4 w; w.x = cvtpk(a[0], a[1]); w.y = cvtpk(a[2], a[3]); w.z = cvtpk(b[0], b[1]); w.w = cvtpk(b[2], b[3]); return w; }

template <int ACT> struct InStore {
    bf16_t* O; int ldc;
    DI void store8(int row, int col, f32x4 a, f32x4 b) const {
        if (ACT == 1) {
#pragma unroll
            for (int j = 0; j < 4; ++j) { float x = fmaxf(a[j], 0.f); a[j] = x * x; float y = fmaxf(b[j], 0.f); b[j] = y * y; }
        }
        *(u32x4*)(O + (size_t)row * ldc + col) = pack8(a, b);
    }
};
struct InNaQkv {
    bf16_t* QK; bf16_t* VTL; bf16_t* VTC;
    DI void store8(int row, int col, f32x4 a, f32x4 b) const {
        if (col < 2048) {
            const float sc = col < 1024 ? 0.18033688011112042f : 1.f;
            *(u32x4*)(QK + (size_t)row * 2048 + col) = pack8(a * sc, b * sc);
        } else {
            const int c = col - 2048, hd = c >> 6, d0 = c & 63;
            bf16_t* p; size_t ld;
            if (row < ML) { const int b_ = row >> 12, t = row & 4095; p = VTL + ((size_t)((b_ * 16 + hd) * 64 + d0)) * 4096 + t; ld = 4096; }
            else { const int r2 = row - ML, b_ = r2 >> 8, t = r2 & 255; p = VTC + ((size_t)((b_ * 16 + hd) * 64 + d0)) * 256 + t; ld = 256; }
#pragma unroll
            for (int j = 0; j < 4; ++j) { p[(size_t)j * ld] = f2bf(a[j]); p[(size_t)(j + 4) * ld] = f2bf(b[j]); }
        }
    }
};
struct InResid {
    const float* sl; const float* sc; float* dl; float* dc; const float* gate;
    DI void store8(int row, int col, f32x4 a, f32x4 b) const {
        const float* s; float* d; int mi;
        if (row < ML) { s = sl + (size_t)row * 1024 + col; d = dl + (size_t)row * 1024 + col; mi = row >> 12; }
        else { s = sc + (size_t)(row - ML) * 1024 + col; d = dc + (size_t)(row - ML) * 1024 + col; mi = 8; }
        const float* g = gate + (size_t)mi * 6144 + col;
        const f32x4 g0 = *(const f32x4*)g, g1 = *(const f32x4*)(g + 4);
        const f32x4 x0 = *(const f32x4*)s, x1 = *(const f32x4*)(s + 4);
        *(f32x4*)d = x0 + g0 * a; *(f32x4*)(d + 4) = x1 + g1 * b;
    }
};
struct InGlaIn {
    bf16_t* P; float* LR;
    DI void store8(int row, int col, f32x4 a, f32x4 b) const {
        if (col < 3072) {
            const float sc = col < 512 ? 0.08838834764831845f : 1.f;
            *(u32x4*)(P + (size_t)row * 3072 + col) = pack8(a * sc, b * sc);
        } else if (col < 3104) {
            float* p = LR + (size_t)row * 32 + (col - 3072);
            *(f32x4*)p = a; *(f32x4*)(p + 4) = b;
        }
    }
};
struct InRwL1 {
    bf16_t* RKV; bf16_t* SG; bf16_t* TWAA;
    DI void store8(int row, int col, f32x4 a, f32x4 b) const {
        if (col < 3072) { *(u32x4*)(RKV + (size_t)row * 3072 + col) = pack8(a, b); }
        else if (col < 3328) {
#pragma unroll
            for (int j = 0; j < 4; ++j) { a[j] = sigmoidf_(a[j]); b[j] = sigmoidf_(b[j]); }
            *(u32x4*)(SG + (size_t)row * 256 + (col - 3072)) = pack8(a, b);
        } else {
            const int c = col - 3328;
            if (c < 128) {
#pragma unroll
                for (int j = 0; j < 4; ++j) { a[j] = tanhf(a[j]); b[j] = tanhf(b[j]); }
            }
            *(u32x4*)(TWAA + (size_t)row * 256 + c) = pack8(a, b);
        }
    }
};

template <class Inner> DI void run_gemm(LAS unsigned char* lds, const bf16_t* A, const bf16_t* Bt, int M, int N, int K, const Inner& in) {
    int Kr = K; asm volatile("" : "+s"(Kr));
    pg8::Gemm g{A, Bt, M, N, Kr}; pg8::StaticOrder S; S.init(M, N, (int)gridDim.x, (int)blockIdx.x);
    Epi<Inner> E{in};
#ifndef NO_GEMM
    pg8::gemm_phase<Epi<Inner>, pg8::StaticOrder, true, true>(lds, g, S, E);
#endif
    __syncthreads();
}

#define GT_FETCH(S, kt_) do { const size_t ko_ = (size_t)(kt_) * 128; \
        _Pragma("unroll") for (int e = 0; e < 2; ++e) ra[S][e] = *(const u32x4*)(pa[e] + ko_); \
        _Pragma("unroll") for (int e = 0; e < 4; ++e) rb[S][e] = *(const u32x4*)(pb[e] + ko_); } while (0)
#define GT_STASH(S, buf_) do { \
        _Pragma("unroll") for (int e = 0; e < 2; ++e) *(u32x4*)(As + (buf_) * 64 * 136 + la[e]) = ra[S][e]; \
        _Pragma("unroll") for (int e = 0; e < 4; ++e) *(u32x4*)(Bs + (buf_) * 128 * 136 + lb[e]) = rb[S][e]; } while (0)
#define GT_STEP(k_, S) do { if ((k_) < nk) { \
        mma_tile(acc, As + ((k_) & 1) * 64 * 136 + wm * 32 * 136, 136, Bs + ((k_) & 1) * 128 * 136 + wn * 32 * 136, 136, 8, lane); \
        if ((k_) + 1 < nk) GT_STASH(S, ((k_) + 1) & 1); \
        LDS_BARRIER(); } } while (0)
#define GT_STEPU(k_, S) do { \
        mma_tile(acc, As + ((k_) & 1) * 64 * 136 + wm * 32 * 136, 136, Bs + ((k_) & 1) * 128 * 136 + wn * 32 * 136, 136, 8, lane); \
        GT_STASH(S, ((k_) + 1) & 1); \
        GT_FETCH(S, min((k_) + 4, nk - 1)); \
        LDS_BARRIER(); } while (0)
DI void gemm_tail(const bf16_t* A  , const bf16_t* Bt  , int K, const float* src  , float* dst, const float* gate8  , unsigned char* lds, int tid) {
    const int lane = tid & 63, wid = __builtin_amdgcn_readfirstlane(tid >> 6);
    bf16_t* As = (bf16_t*)lds;
    bf16_t* Bs = As + 2 * 64 * 136;
    const int wm = wid >> 2, wn = wid & 3, nk = K / 128;
    for (int tile = blockIdx.x; tile < 256; tile += gridDim.x) {
        const int tm = tile >> 3, tn = tile & 7, row0 = ML + tm * 64, col0 = tn * 128;
        const bf16_t* pa[2]; const bf16_t* pb[4]; int la[2], lb[4];
#pragma unroll
        for (int e = 0; e < 2; ++e) { const int idx = tid + 512 * e, r = idx >> 4, kc = (idx & 15) * 8; pa[e] = A + (size_t)(row0 + r) * K + kc; la[e] = r * 136 + kc; }
#pragma unroll
        for (int e = 0; e < 4; ++e) { const int idx = tid + 512 * e, r = idx >> 4, kc = (idx & 15) * 8; pb[e] = Bt + (size_t)(col0 + r) * K + kc; lb[e] = r * 136 + kc; }
        u32x4 ra[3][2], rb[3][4];
        f32x16 acc;
#pragma unroll
        for (int i = 0; i < 16; ++i) acc[i] = 0.f;
        GT_FETCH(0, 0); GT_STASH(0, 0);
        GT_FETCH(1, 1); GT_FETCH(2, 2); GT_FETCH(0, 3);
        LDS_BARRIER();
        const int nfull = (nk / 3) * 3;
        for (int kt = 0; kt < nfull; kt += 3) { GT_STEPU(kt, 1); GT_STEPU(kt + 1, 2); GT_STEPU(kt + 2, 0); }
        GT_STEP(nfull, 1); GT_STEP(nfull + 1, 2);
        __syncthreads();
        const int rho = lane & 31, hh = lane >> 5, col = col0 + wn * 32 + rho;
        const float g = gate8[col];
#pragma unroll
        for (int i = 0; i < 16; ++i) { const size_t o = (size_t)(row0 - ML + wm * 32 + crow(i, hh)) * 1024 + col; dst[o] = src[o] + g * acc[i]; }
    }
}

DI void conv_item(const float* W, int ldw, int Kv, int Nv, const float* mix, int mode, bf16_t* WT, int ldt, int row_off, int col_off, float* scr, int kb, int nb, int lane) {
    const int k0 = 64 * kb, n0 = 32 * nb;
#pragma unroll 8
    for (int i = 0; i < 32; ++i) {
        const int kk = 2 * i + (lane >> 5), k = k0 + kk, n = n0 + (lane & 31);
        float v = (k < Kv && n < Nv) ? W[(size_t)k * ldw + n] : 0.f;
        if (mode) { const float m = (k < Kv) ? mix[k] : 0.f; v *= (mode == 1) ? (1.f - m) : m; }
        scr[kk * 33 + (lane & 31)] = v;
    }
    __builtin_amdgcn_s_waitcnt(0xc07f); __builtin_amdgcn_wave_barrier();
    const int c = lane & 7;
#pragma unroll
    for (int j = 0; j < 4; ++j) {
        const int n = (lane >> 3) + 8 * j; const float* s = scr + (8 * c) * 33 + n;
        u32x4 o; o.x = cvtpk(s[0 * 33], s[1 * 33]); o.y = cvtpk(s[2 * 33], s[3 * 33]); o.z = cvtpk(s[4 * 33], s[5 * 33]); o.w = cvtpk(s[6 * 33], s[7 * 33]);
        *(u32x4*)(WT + (size_t)(row_off + n0 + n) * ldt + col_off + k0 + 8 * c) = o;
    }
    __builtin_amdgcn_s_waitcnt(0xc07f); __builtin_amdgcn_wave_barrier();
}
DI void conv_job(const float* W, int ldw, int Kv, int Nv, int Kp, int Np, const float* mix, int mode, bf16_t* WT, int ldt, int row_off, int col_off, float* scr, int gw, int ngw, int lane) {
    const int nkb = Kp / 64, nnb = Np / 32, nit = nkb * nnb;
    for (int it = gw; it < nit; it += ngw) conv_item(W, ldw, Kv, Nv, mix, mode, WT, ldt, row_off, col_off, scr, it / nnb, it % nnb, lane);
}

DI void norm_row(const float* xr, const f32x4 (&gs)[4], const f32x4 (&sh)[4], int lane, f32x4 (&out)[4]) {
    f32x4 v[4]; float s = 0.f;
#pragma unroll
    for (int j = 0; j < 4; ++j) { v[j] = *(const f32x4*)(xr + 4 * lane + 256 * j); s += (v[j].x * v[j].x + v[j].y * v[j].y) + (v[j].z * v[j].z + v[j].w * v[j].w); }
    s = wave_sum(s);
    const float rinv = rsqrtf(s * (1.f / 1024.f) + 1e-6f);
#pragma unroll
    for (int j = 0; j < 4; ++j) out[j] = v[j] * rinv * gs[j] + sh[j];
}
DI void store_row_bf16(bf16_t* o, const f32x4 (&v)[4], int lane) {
#pragma unroll
    for (int j = 0; j < 4; ++j) { u32x2 w; w.x = cvtpk(v[j].x, v[j].y); w.y = cvtpk(v[j].z, v[j].w); *(u32x2*)(o + 4 * lane + 256 * j) = w; }
}
DI void phase_prenorm(const float* xl, const float* xc, const float* g, const float* modl  , int shift_chunk, bf16_t* H, int ldh, bool with_hs, int Mrows, int gw, int ngw, int lane) {
#define XROW(r) ((r) < ML ? xl + (size_t)(r) * 1024 : xc + (size_t)((r) - ML) * 1024)
    if (!with_hs) {
        const int nstrips = Mrows / 4;
        for (int st = gw; st < nstrips; st += ngw) {
            const int row0 = 4 * st;
            const int mi = row0 < ML ? row0 >> 12 : 8;
            const float* mp = modl + (size_t)mi * 6144 + shift_chunk * 1024;
            f32x4 v[4][4]; float ss[4];
#pragma unroll
            for (int r = 0; r < 4; ++r) { const float* xr = XROW(row0 + r);
#pragma unroll
                for (int j = 0; j < 4; ++j) v[r][j] = *(const f32x4*)(xr + 4 * lane + 256 * j); }
            f32x4 gs[4], sh[4];
#pragma unroll
            for (int j = 0; j < 4; ++j) { const int c = 4 * lane + 256 * j; sh[j] = *(const f32x4*)(mp + c); const f32x4 sc = *(const f32x4*)(mp + 1024 + c); gs[j] = *(const f32x4*)(g + c) * (sc + 1.f); }
#pragma unroll
            for (int r = 0; r < 4; ++r) { float s = 0.f;
#pragma unroll
                for (int j = 0; j < 4; ++j) s += (v[r][j].x * v[r][j].x + v[r][j].y * v[r][j].y) + (v[r][j].z * v[r][j].z + v[r][j].w * v[r][j].w);
                ss[r] = s; }
#pragma unroll
            for (int o = 1; o < 64; o <<= 1) {
#pragma unroll
                for (int r = 0; r < 4; ++r) ss[r] += __shfl_xor(ss[r], o);
            }
#pragma unroll
            for (int r = 0; r < 4; ++r) { const float rinv = rsqrtf(ss[r] * (1.f / 1024.f) + 1e-6f); f32x4 o[4];
#pragma unroll
                for (int j = 0; j < 4; ++j) o[j] = v[r][j] * rinv * gs[j] + sh[j];
                store_row_bf16(H + (size_t)(row0 + r) * ldh, o, lane); }
        }
    } else {
        const int nstrips = Mrows / 8;
        for (int st = gw; st < nstrips; st += ngw) {
            const int row0 = 8 * st;
            int mi, seg0, seg1;
            if (row0 < ML) { mi = row0 >> 12; seg0 = row0 & ~4095; seg1 = seg0 + 4096; } else { mi = 8; seg0 = ML + ((row0 - ML) & ~255); seg1 = seg0 + 256; }
            const float* mp = modl + (size_t)mi * 6144 + shift_chunk * 1024;
            f32x4 gs[4], sh[4];
#pragma unroll
            for (int j = 0; j < 4; ++j) { const int c = 4 * lane + 256 * j; sh[j] = *(const f32x4*)(mp + c); const f32x4 sc = *(const f32x4*)(mp + 1024 + c); gs[j] = *(const f32x4*)(g + c) * (sc + 1.f); }
            f32x4 prev[4], cur[4], nxt[4];
            if (row0 > seg0) norm_row(XROW(row0 - 1), gs, sh, lane, prev); else { for (int j = 0; j < 4; ++j) prev[j] = (f32x4){0.f, 0.f, 0.f, 0.f}; }
            norm_row(XROW(row0), gs, sh, lane, cur);
            for (int r = row0; r < row0 + 8; ++r) {
                if (r + 1 < seg1) norm_row(XROW(r + 1), gs, sh, lane, nxt); else { for (int j = 0; j < 4; ++j) nxt[j] = (f32x4){0.f, 0.f, 0.f, 0.f}; }
                store_row_bf16(H + (size_t)r * ldh, cur, lane);
                f32x4 hs[4];
#pragma unroll
                for (int j = 0; j < 4; ++j) hs[j] = (prev[j] + nxt[j]) * 0.5f;
                store_row_bf16(H + (size_t)r * ldh + 1024, hs, lane);
#pragma unroll
                for (int j = 0; j < 4; ++j) { prev[j] = cur[j]; cur[j] = nxt[j]; }
            }
        }
    }
#undef XROW
}

DI void phase_mod(const Args& a, float* lds, int tid) {
    float* sc = lds;
    float* red = lds + 1024 * 12;
    const float* c = a.in[1]; const float* cctx = a.in[3]; const float* ada_w = a.in[4]; const float* ada_b = a.in[5];
    float* mod = (float*)(a.ws + WS_MOD);
    for (int idx = tid; idx < 9 * 1024; idx += NTHREADS) { const int j = idx >> 10, k = idx & 1023; const float v = j < 8 ? c[j * 1024 + k] : cctx[k]; sc[k * 12 + j] = v * sigmoidf_(v); }
    __syncthreads();
    for (int unit = blockIdx.x; unit < 768; unit += gridDim.x) {
        const int l = unit / 192, n0 = (unit % 192) * 32, col = tid & 31, ks = tid >> 5;
        const float* w = ada_w + ((size_t)l * 1024 + ks * 64) * 6144 + n0 + col;
        float acc[9];
#pragma unroll
        for (int j = 0; j < 9; ++j) acc[j] = 0.f;
#pragma unroll 32
        for (int kk = 0; kk < 64; ++kk) {
            const float wv = w[(size_t)kk * 6144]; const float* s = sc + (ks * 64 + kk) * 12;
            const f32x4 s0 = *(const f32x4*)s, s1 = *(const f32x4*)(s + 4); const float s8 = s[8];
            acc[0] += s0.x * wv; acc[1] += s0.y * wv; acc[2] += s0.z * wv; acc[3] += s0.w * wv;
            acc[4] += s1.x * wv; acc[5] += s1.y * wv; acc[6] += s1.z * wv; acc[7] += s1.w * wv; acc[8] += s8 * wv;
        }
#pragma unroll
        for (int j = 0; j < 9; ++j) red[(ks * 9 + j) * 32 + col] = acc[j];
        __syncthreads();
        if (tid < 288) {
            const int j = tid >> 5, cc = tid & 31; float s = ada_b[l * 6144 + n0 + cc];
#pragma unroll
            for (int k2 = 0; k2 < 16; ++k2) s += red[(k2 * 9 + j) * 32 + cc];
            mod[((size_t)(l * 9 + j)) * 6144 + n0 + cc] = s;
        }
        __syncthreads();
    }
}

DI void attn_unit(const bf16_t* QK, const bf16_t* VTL, const bf16_t* VTC, bf16_t* O, const float* tbl, int b, int hd, int r, int cq, int lane) {
    const int n = lane & 31, h = lane >> 5;
    const bool lat = r >= 0;
    const int qrow0 = lat ? b * 4096 + r * 64 : ML + b * 256 + cq * 64;
    const int pin = (n & 0x13) | ((n & 4) << 1) | ((n & 8) >> 1);
    bf16x8 bq[2][4];
#pragma unroll
    for (int qb = 0; qb < 2; ++qb)
#pragma unroll
        for (int s = 0; s < 4; ++s) bq[qb][s] = *(const bf16x8*)(QK + (size_t)(qrow0 + 32 * qb + n) * 2048 + hd * 64 + 32 * h + 8 * s);
    f32x16 o[2][2];
#pragma unroll
    for (int x = 0; x < 2; ++x)
#pragma unroll
        for (int y = 0; y < 2; ++y)
#pragma unroll
            for (int i = 0; i < 16; ++i) o[x][y][i] = 0.f;
    float mrun[2] = {-1e30f, -1e30f}, lrun[2] = {0.f, 0.f};
    const int r0 = lat ? min(max(r - 4, 0), 56) : 0;
    const int nblk = lat ? 24 : 8;
    const bf16_t* vtc = VTC + (size_t)((b * 16 + hd) * 64) * 256;
    const bf16_t* vtl = VTL + (size_t)((b * 16 + hd) * 64) * 4096;
    for (int blk = 0; blk < nblk; ++blk) {
        int krow0, ldv, kc0 = 0, ridx = 0; const bf16_t* vt;
        const bool lb_ = blk >= 8;
        if (!lb_) { krow0 = ML + b * 256 + blk * 32; vt = vtc + blk * 32; ldv = 256; }
        else { const int lb = blk - 8, kr = r0 + (lb >> 1); kc0 = (lb & 1) * 32; krow0 = b * 4096 + kr * 64 + kc0; vt = vtl + kr * 64 + kc0; ldv = 4096; ridx = kr - r + 7; }
        bf16x8 ka[4];
#pragma unroll
        for (int s = 0; s < 4; ++s) ka[s] = *(const bf16x8*)(QK + (size_t)(krow0 + pin) * 2048 + 1024 + hd * 64 + 32 * h + 8 * s);
        bf16x8 va[2][2];
#pragma unroll
        for (int db = 0; db < 2; ++db)
#pragma unroll
            for (int s2 = 0; s2 < 2; ++s2) va[db][s2] = *(const bf16x8*)(vt + (size_t)(32 * db + n) * ldv + 16 * s2 + 8 * h);
        f32x16 sa[2];
#pragma unroll
        for (int qb = 0; qb < 2; ++qb) {
#pragma unroll
            for (int i = 0; i < 16; ++i) sa[qb][i] = 0.f;
#pragma unroll
            for (int s = 0; s < 4; ++s) sa[qb] = MFMA32(ka[s], bq[qb][s], sa[qb]);
        }
        bf16x8 pb[2][2];
#pragma unroll
        for (int qb = 0; qb < 2; ++qb) {
            if (lb_) {
                const int qc = 32 * qb + n, cs = min(max(qc - 8, 0), 48);
                const float* bp = tbl + ridx * 128 + 48 + 15 + kc0 + 8 * h - qc;
                const int okb = kc0 + 8 * h - cs;
#pragma unroll
                for (int i = 0; i < 16; ++i) {
                    const int ko = (i & 7) + 16 * (i >> 3);
                    const bool ok = (unsigned)(okb + ko) < 16u;
                    const float bv = bp[ko];
                    sa[qb][i] = ok ? sa[qb][i] + bv : -1e30f;
                }
            }
            float bm = sa[qb][0];
#pragma unroll
            for (int i = 1; i < 16; ++i) bm = fmaxf(bm, sa[qb][i]);
            bm = fmaxf(bm, __shfl_xor(bm, 32));
            const float mnew = fmaxf(mrun[qb], bm);
            const float alpha = __builtin_amdgcn_exp2f(mrun[qb] - mnew);
            mrun[qb] = mnew;
            float ps = 0.f;
#pragma unroll
            for (int i = 0; i < 16; ++i) { const float p = __builtin_amdgcn_exp2f(sa[qb][i] - mnew); sa[qb][i] = p; ps += p; }
            lrun[qb] = lrun[qb] * alpha + ps;
            if (__builtin_amdgcn_ballot_w64(alpha != 1.f) != 0ull) {
#pragma unroll
                for (int db = 0; db < 2; ++db)
#pragma unroll
                    for (int i = 0; i < 16; ++i) o[db][qb][i] *= alpha;
            }
#pragma unroll
            for (int s2 = 0; s2 < 2; ++s2) {
                u32x4 w; w.x = cvtpk(sa[qb][8 * s2 + 0], sa[qb][8 * s2 + 1]); w.y = cvtpk(sa[qb][8 * s2 + 2], sa[qb][8 * s2 + 3]);
                w.z = cvtpk(sa[qb][8 * s2 + 4], sa[qb][8 * s2 + 5]); w.w = cvtpk(sa[qb][8 * s2 + 6], sa[qb][8 * s2 + 7]);
                pb[qb][s2] = __builtin_bit_cast(bf16x8, w);
            }
        }
#pragma unroll
        for (int db = 0; db < 2; ++db)
#pragma unroll
            for (int qb = 0; qb < 2; ++qb)
#pragma unroll
                for (int s2 = 0; s2 < 2; ++s2) o[db][qb] = MFMA32(va[db][s2], pb[qb][s2], o[db][qb]);
    }
#pragma unroll
    for (int qb = 0; qb < 2; ++qb) {
        const float lt = lrun[qb] + __shfl_xor(lrun[qb], 32);
        const float inv = 1.f / lt;
        bf16_t* op = O + (size_t)(qrow0 + 32 * qb + n) * 1024 + hd * 64;
#pragma unroll
        for (int db = 0; db < 2; ++db)
#pragma unroll
            for (int g = 0; g < 4; ++g) {
                u32x2 w; w.x = cvtpk(o[db][qb][4 * g] * inv, o[db][qb][4 * g + 1] * inv); w.y = cvtpk(o[db][qb][4 * g + 2] * inv, o[db][qb][4 * g + 3] * inv);
                *(u32x2*)(op + 32 * db + 8 * g + 4 * h) = w;
            }
    }
}

DI void gla_gates(const float* LR, const float* wdec, const float* bdec, bf16_t* G, float* lds, int tid) {
    constexpr int RB = 64;
    float* lrs = lds;
    for (int bt = blockIdx.x; bt < MT / RB; bt += gridDim.x) {
        const int row0 = bt * RB;
        __syncthreads();
        for (int e = tid; e < RB * 32 / 4; e += NTHREADS) *(f32x4*)(lrs + 4 * e) = *(const f32x4*)(LR + (size_t)row0 * 32 + 4 * e);
        __syncthreads();
#pragma unroll 1
        for (int dir = 0; dir < 2; ++dir) {
            float wd[16];
#pragma unroll
            for (int r = 0; r < 16; ++r) wd[r] = wdec[(dir * 16 + r) * 512 + tid];
            const float bd = bdec[dir * 512 + tid];
            bf16_t* gp = G + ((size_t)dir * MT + row0) * 512 + tid;
#pragma unroll 4
            for (int rr = 0; rr < RB; ++rr) {
                const float* lp = lrs + rr * 32 + dir * 16;
                const f32x4 l0 = *(const f32x4*)lp, l1 = *(const f32x4*)(lp + 4), l2 = *(const f32x4*)(lp + 8), l3 = *(const f32x4*)(lp + 12);
                float z = bd;
                z += l0.x * wd[0] + l0.y * wd[1] + l0.z * wd[2] + l0.w * wd[3]; z += l1.x * wd[4] + l1.y * wd[5] + l1.z * wd[6] + l1.w * wd[7];
                z += l2.x * wd[8] + l2.y * wd[9] + l2.z * wd[10] + l2.w * wd[11]; z += l3.x * wd[12] + l3.y * wd[13] + l3.z * wd[14] + l3.w * wd[15];
                const float x = -z; const float sp = fmaxf(x, 0.f) + __logf(1.f + __expf(-fabsf(x)));
                gp[(size_t)rr * 512] = f2bf(sp * (-1.f / 16.f));
            }
        }
    }
    __syncthreads();
}
DI void gla_unit(const bf16_t* P, const bf16_t* G  , bf16_t* OUT  , unsigned char* lds, int unit, int tid) {
    const int lane = tid & 63, wid = __builtin_amdgcn_readfirstlane(tid >> 6);
    const int vs = unit & 3, dir = (unit >> 2) & 1, hd = (unit >> 3) & 3, b = unit >> 5;
    bf16_t* QE = (bf16_t*)lds;
    bf16_t* KE = QE + 64 * 136;
    bf16_t* ST = KE + 64 * 136;
    bf16_t* KDT = ST + 64 * 136;
    bf16_t* VT = KDT + 128 * 72;
    bf16_t* AM = VT + 64 * 72;
    float* Bc = (float*)(AM + 64 * 72);
    float* LRs = Bc + 64 * 132;
    float* GRP = LRs + 64 * 16;
    float* DEC = GRP + 4 * 128;
    const int dcol = tid & 127, lg = tid >> 7;
    const int col_q = hd * 128, col_k = 512 + hd * 128, col_v = 1024 + hd * 256 + vs * 64;
    f32x16 st;
#pragma unroll
    for (int i = 0; i < 16; ++i) st[i] = 0.f;
    const int svt = wid >> 2, sdt = wid & 3, rho = lane & 31, hh = lane >> 5;
    bf16_t* outp = OUT + (size_t)dir * MT * 1024;
    const int el = tid >> 3, eg = tid & 7;
    constexpr int NCHT = 68;
#define GROWQ(q, l) ((q) < 4 ? ML + b * 256 + (dir ? 255 - ((q) * 64 + (l)) : (q) * 64 + (l)) : b * 4096 + (dir ? 4095 - (((q) - 4) * 64 + (l)) : ((q) - 4) * 64 + (l)))
    u32x4 rq0, rq1, rk0, rk1, rv; bf16_t rg[16];
    const bf16_t* Gd = G + (size_t)dir * MT * 512;
#define GLA_FETCH(q) do { const size_t ro_ = (size_t)GROWQ(q, el) * 3072; \
        rq0 = *(const u32x4*)(P + ro_ + col_q + 16 * eg); rq1 = *(const u32x4*)(P + ro_ + col_q + 16 * eg + 8); \
        rk0 = *(const u32x4*)(P + ro_ + col_k + 16 * eg); rk1 = *(const u32x4*)(P + ro_ + col_k + 16 * eg + 8); \
        rv = *(const u32x4*)(P + ro_ + col_v + 8 * eg); \
        _Pragma("unroll") for (int li_ = 0; li_ < 16; ++li_) rg[li_] = Gd[(size_t)GROWQ(q, 16 * lg + li_) * 512 + hd * 128 + dcol]; } while (0)
    GLA_FETCH(0);
    for (int q = 0; q < NCHT; ++q) {
        const u32x4 cq0 = rq0, cq1 = rq1, ck0 = rk0, ck1 = rk1, cv = rv;
        { float run = 0.f;
#pragma unroll
          for (int li = 0; li < 16; ++li) { run += bf2f(rg[li]); Bc[(16 * lg + li) * 132 + dcol] = run; }
          GRP[lg * 128 + dcol] = run; }
        LDS_BARRIER();
        if (q + 1 < NCHT) GLA_FETCH(q + 1);
        {
          const int g_ = el >> 4;
          float bv[16], bl[16];
#pragma unroll
          for (int e4 = 0; e4 < 4; ++e4) {
              const f32x4 t = *(const f32x4*)(Bc + el * 132 + 16 * eg + 4 * e4);
              f32x4 off = (f32x4){0.f, 0.f, 0.f, 0.f}, tot = (f32x4){0.f, 0.f, 0.f, 0.f};
#pragma unroll
              for (int g2 = 0; g2 < 4; ++g2) { const f32x4 gq = *(const f32x4*)(GRP + g2 * 128 + 16 * eg + 4 * e4); tot += gq; if (g2 < g_) off += gq; }
#pragma unroll
              for (int j = 0; j < 4; ++j) { bv[4 * e4 + j] = t[j] + off[j]; bl[4 * e4 + j] = tot[j]; }
          }
          if (el == 0) {
#pragma unroll
              for (int e = 0; e < 16; ++e) DEC[16 * eg + e] = __expf(bl[e]);
          }
          unsigned qw[8] = {cq0.x, cq0.y, cq0.z, cq0.w, cq1.x, cq1.y, cq1.z, cq1.w}, kw[8] = {ck0.x, ck0.y, ck0.z, ck0.w, ck1.x, ck1.y, ck1.z, ck1.w};
          unsigned qo[8], ko[8];
#pragma unroll
          for (int e2 = 0; e2 < 8; ++e2) {
              const float q0 = __uint_as_float(qw[e2] << 16), q1 = __uint_as_float(qw[e2] & 0xffff0000u), k0 = __uint_as_float(kw[e2] << 16), k1 = __uint_as_float(kw[e2] & 0xffff0000u);
              const float b0 = bv[2 * e2], b1 = bv[2 * e2 + 1];
              const float e0 = __expf(b0), e1 = __expf(b1);
              qo[e2] = cvtpk(q0 * e0, q1 * e1);
              ko[e2] = cvtpk(k0 * __builtin_amdgcn_rcpf(e0), k1 * __builtin_amdgcn_rcpf(e1));
              KDT[(16 * eg + 2 * e2) * 72 + el] = f2bf(k0 * __expf(bl[2 * e2] - b0)); KDT[(16 * eg + 2 * e2 + 1) * 72 + el] = f2bf(k1 * __expf(bl[2 * e2 + 1] - b1));
          }
          *(u32x4*)(QE + el * 136 + 16 * eg) = (u32x4){qo[0], qo[1], qo[2], qo[3]}; *(u32x4*)(QE + el * 136 + 16 * eg + 8) = (u32x4){qo[4], qo[5], qo[6], qo[7]};
          *(u32x4*)(KE + el * 136 + 16 * eg) = (u32x4){ko[0], ko[1], ko[2], ko[3]}; *(u32x4*)(KE + el * 136 + 16 * eg + 8) = (u32x4){ko[4], ko[5], ko[6], ko[7]};
          { const unsigned vw[4] = {cv.x, cv.y, cv.z, cv.w};
#pragma unroll
            for (int e2 = 0; e2 < 4; ++e2) { VT[(8 * eg + 2 * e2) * 72 + el] = (bf16_t)(vw[e2] & 0xffffu); VT[(8 * eg + 2 * e2 + 1) * 72 + el] = (bf16_t)(vw[e2] >> 16); } }
#pragma unroll
          for (int i = 0; i < 16; ++i) ST[(32 * svt + crow(i, hh)) * 136 + 32 * sdt + rho] = f2bf(st[i]);
        }
        LDS_BARRIER();
        if (wid < 4) { const int lt = wid >> 1, mt = wid & 1; f32x16 acc;
#pragma unroll
            for (int i = 0; i < 16; ++i) acc[i] = 0.f;
            mma_tile(acc, QE + 32 * lt * 136, 136, KE + 32 * mt * 136, 136, 8, lane);
#pragma unroll
            for (int i = 0; i < 16; ++i) { const int l = 32 * lt + crow(i, hh), m = 32 * mt + rho; AM[l * 72 + m] = f2bf(m <= l ? acc[i] : 0.f); } }
        LDS_BARRIER();
        if (wid < 4) { const int lt = wid >> 1, vt2 = wid & 1; f32x16 acc;
#pragma unroll
            for (int i = 0; i < 16; ++i) acc[i] = 0.f;
            mma_tile(acc, AM + 32 * lt * 72, 72, VT + 32 * vt2 * 72, 72, 4, lane);
            mma_tile(acc, QE + 32 * lt * 136, 136, ST + 32 * vt2 * 136, 136, 8, lane);
#pragma unroll
            for (int i = 0; i < 16; ++i) { const int l = 32 * lt + crow(i, hh); outp[(size_t)GROWQ(q, l) * 1024 + hd * 256 + vs * 64 + 32 * vt2 + rho] = f2bf(acc[i]); } }
        { const float dc = DEC[32 * sdt + rho];
#pragma unroll
          for (int i = 0; i < 16; ++i) st[i] *= dc;
          mma_tile(st, VT + 32 * svt * 72, 72, KDT + 32 * sdt * 72, 72, 4, lane); }
        LDS_BARRIER();
    }
#undef GROWQ
#undef GLA_FETCH
}
struct GlaFinRow { bf16x8 a0, a1, b0, b1, g0, g1; };
DI void gla_fin_load(GlaFinRow& R, const bf16_t* OF, const bf16_t* OB, const bf16_t* P, int row, int c0) {
    R.a0 = *(const bf16x8*)(OF + (size_t)row * 1024 + c0); R.a1 = *(const bf16x8*)(OF + (size_t)row * 1024 + c0 + 8);
    R.b0 = *(const bf16x8*)(OB + (size_t)row * 1024 + c0); R.b1 = *(const bf16x8*)(OB + (size_t)row * 1024 + c0 + 8);
    R.g0 = *(const bf16x8*)(P + (size_t)row * 3072 + 2048 + c0); R.g1 = *(const bf16x8*)(P + (size_t)row * 3072 + 2048 + c0 + 8);
}
DI void gla_fin_store(const GlaFinRow& R, bf16_t* OF, const float* ng, int row, int c0) {
    float o[16]; float ss = 0.f;
#pragma unroll
    for (int e = 0; e < 8; ++e) { o[e] = bf2f((bf16_t)R.a0[e]) + bf2f((bf16_t)R.b0[e]); o[8 + e] = bf2f((bf16_t)R.a1[e]) + bf2f((bf16_t)R.b1[e]); }
#pragma unroll
    for (int e = 0; e < 16; ++e) ss += o[e] * o[e];
    ss += __shfl_xor(ss, 1); ss += __shfl_xor(ss, 2); ss += __shfl_xor(ss, 4); ss += __shfl_xor(ss, 8);
    const float rinv = rsqrtf(ss * (1.f / 256.f) + 1e-6f);
    float y[16];
#pragma unroll
    for (int e = 0; e < 16; ++e) { const float gt = bf2f((bf16_t)(e < 8 ? R.g0[e] : R.g1[e - 8])); y[e] = o[e] * rinv * ng[(c0 + e) & 255] * (gt * sigmoidf_(gt)); }
    u32x4 w0, w1; w0.x = cvtpk(y[0], y[1]); w0.y = cvtpk(y[2], y[3]); w0.z = cvtpk(y[4], y[5]); w0.w = cvtpk(y[6], y[7]);
    w1.x = cvtpk(y[8], y[9]); w1.y = cvtpk(y[10], y[11]); w1.z = cvtpk(y[12], y[13]); w1.w = cvtpk(y[14], y[15]);
    *(u32x4*)(OF + (size_t)row * 1024 + c0) = w0; *(u32x4*)(OF + (size_t)row * 1024 + c0 + 8) = w1;
}
DI void gla_finish(bf16_t* OF, const bf16_t* OB, const bf16_t* P, const float* ng, int Mrows, int gw, int ngw, int lane) {
    const int c0 = 16 * lane;
    for (int row = gw; row < Mrows; row += 2 * ngw) {
        const int rowB = row + ngw < Mrows ? row + ngw : row;
        GlaFinRow A, B;
        gla_fin_load(A, OF, OB, P, row, c0); gla_fin_load(B, OF, OB, P, rowB, c0);
        gla_fin_store(A, OF, ng, row, c0);
        if (rowB != row) gla_fin_store(B, OF, ng, rowB, c0);
    }
}

typedef unsigned u32x2_t __attribute__((ext_vector_type(2)));
DI float red_rows(float x) {
    unsigned u = __float_as_uint(x);
    u32x2_t r = __builtin_amdgcn_permlane16_swap(u, u, false, false);
    const float y = __uint_as_float(r.x) + __uint_as_float(r.y);
    unsigned v = __float_as_uint(y);
    u32x2_t q = __builtin_amdgcn_permlane32_swap(v, v, false, false);
    return __uint_as_float(q.x) + __uint_as_float(q.y);
}
DI int rw_row(int q, int l, int dir, int b) {
    int T, base, n;
    if (q < 8) { T = 256; base = ML + b * 256; n = q; } else { T = 4096; base = b * 4096; n = q - 8; }
    const int t = n * 32 + l;
    return base + (dir ? T - 1 - t : t);
}
#define DPPB(n) " row_newbcast:" #n " row_mask:0xf bank_mask:0xf\n\t"
#define RW_UPD(n, sreg) "v_mul_f32_dpp " sreg ", %17, " sreg DPPB(n) "v_fmac_f32_dpp " sreg ", %18, %21" DPPB(n) "v_fmac_f32_dpp " sreg ", %19, %22" DPPB(n)
DI void rwkv_unit(const Args& a, const bf16_t* RKV, const bf16_t* TWAA, bf16_t* Y  , float* RK  , unsigned char* lds, int unit, int tid) {
    const int lane = tid & 63, wid = __builtin_amdgcn_readfirstlane(tid >> 6);
    const int dir = unit & 1, hd = (unit >> 1) & 15, b = unit >> 5;
    float* SA = (float*)lds;
    float* YC = SA + 6 * 4096;
    bf16_t* W2T = (bf16_t*)(YC + 4096);
    bf16_t* A2T = W2T + 64 * 72;
    constexpr int NCH = 136;
    {
        const float* w2 = a.in[23] + (size_t)dir * 64 * 1024; const float* a2 = a.in[26] + (size_t)dir * 64 * 1024;
        for (int e = 0; e < 8; ++e) { const int idx = tid + 512 * e, j = idx >> 6, c = idx & 63; W2T[c * 72 + j] = f2bf(w2[(size_t)j * 1024 + hd * 64 + c]); A2T[c * 72 + j] = f2bf(a2[(size_t)j * 1024 + hd * 64 + c]); }
    }
    __syncthreads();
    bf16_t* yout = Y + (size_t)dir * MT * 1024; float* rkout = RK + (size_t)dir * MT * 16;
    if (wid >= 4) {
        const int pw = wid - 4, rho = lane & 31, h = lane >> 5, ptid = tid - 256;
        float cw0[2], ca0[2], ckk[2], cka[2], crk[2];
#pragma unroll
        for (int ct = 0; ct < 2; ++ct) { const int c = hd * 64 + 32 * ct + rho; cw0[ct] = a.in[21][dir * 1024 + c]; ca0[ct] = a.in[24][dir * 1024 + c]; ckk[ct] = a.in[29][c]; cka[ct] = a.in[30][c]; crk[ct] = a.in[31][c]; }
        for (int p = 0; p <= NCH + 1; ++p) {
            if (p < NCH) {
                const int buf = p & 1;
                const int rowA = rw_row(p, 8 * pw + (rho & 7), dir, b);
                const bf16_t* ta = TWAA + (size_t)rowA * 256 + dir * 64 + 8 * h;
                f32x16 zw0, zw1, za0, za1;
#pragma unroll
                for (int i = 0; i < 16; ++i) { zw0[i] = 0.f; zw1[i] = 0.f; za0[i] = 0.f; za1[i] = 0.f; }
#pragma unroll
                for (int s = 0; s < 4; ++s) {
                    const bf16x8 atw = *(const bf16x8*)(ta + 16 * s), aaa = *(const bf16x8*)(ta + 128 + 16 * s);
                    const bf16x8 bw0 = *(const bf16x8*)(W2T + rho * 72 + 16 * s + 8 * h), bw1 = *(const bf16x8*)(W2T + (32 + rho) * 72 + 16 * s + 8 * h);
                    const bf16x8 ba0 = *(const bf16x8*)(A2T + rho * 72 + 16 * s + 8 * h), ba1 = *(const bf16x8*)(A2T + (32 + rho) * 72 + 16 * s + 8 * h);
                    zw0 = MFMA32(atw, bw0, zw0); zw1 = MFMA32(atw, bw1, zw1); za0 = MFMA32(aaa, ba0, za0); za1 = MFMA32(aaa, ba1, za1);
                }
#pragma unroll
                for (int i = 0; i < 4; ++i) {
                    const int tok = 8 * pw + i + 4 * h; const int row = rw_row(p, tok, dir, b);
                    const bf16_t* pr = RKV + (size_t)row * 3072 + hd * 64 + rho;
                    float rv[2], kv[2], vv[2], av[2], kkv[2], kd[2]; float ss = 0.f, rk = 0.f;
#pragma unroll
                    for (int ct = 0; ct < 2; ++ct) {
                        rv[ct] = bf2f(pr[32 * ct]); kv[ct] = bf2f(pr[1024 + 32 * ct]); vv[ct] = bf2f(pr[2048 + 32 * ct]);
                        const float zav = ct ? za1[i] : za0[i];
                        av[ct] = 1.f / (1.f + __expf(-(ca0[ct] + zav)));
                        kkv[ct] = kv[ct] * ckk[ct]; ss += kkv[ct] * kkv[ct];
                        kd[ct] = kv[ct] * (1.f + (av[ct] - 1.f) * cka[ct]); rk += rv[ct] * kd[ct] * crk[ct];
                    }
#pragma unroll
                    for (int o = 1; o < 32; o <<= 1) { ss += __shfl_xor(ss, o); rk += __shfl_xor(rk, o); }
                    const float kinv = rsqrtf(fmaxf(ss, 1e-24f));
                    if (rho == 0) rkout[(size_t)row * 16 + hd] = rk;
#pragma unroll
                    for (int ct = 0; ct < 2; ++ct) {
                        const float zwv = ct ? zw1[i] : zw0[i];
                        const float x = -(cw0[ct] + zwv);
                        const float sp = fmaxf(x, 0.f) + __logf(1.f + __expf(-fabsf(x)));
                        const float dec = __expf(-__expf(-sp - 0.5f));
                        const float kn = kkv[ct] * kinv;
                        float* o = SA + buf * 2048 + tok * 64 + 32 * ct + rho;
                        o[0 * 4096] = dec; o[1 * 4096] = kd[ct]; o[2 * 4096] = kn * av[ct]; o[3 * 4096] = -kn; o[4 * 4096] = rv[ct]; o[5 * 4096] = vv[ct];
                    }
                }
            }
            if (p >= 2) {
                const int tok = ptid >> 3, i0 = (ptid & 7) * 8; const int row = rw_row(p - 2, tok, dir, b);
                const float* y = YC + (p & 1) * 2048 + tok * 64 + i0;
                const f32x4 y0 = *(const f32x4*)y, y1 = *(const f32x4*)(y + 4);
                *(u32x4*)(yout + (size_t)row * 1024 + hd * 64 + i0) = pack8(y0, y1);
            }
            __syncthreads();
        }
    } else {
        __builtin_amdgcn_s_setprio(3);
        const int rl = lane & 15, cg = lane >> 4, myrow = 16 * wid + rl;
        float s0 = 0.f, s1 = 0.f, s2 = 0.f, s3 = 0.f, s4 = 0.f, s5 = 0.f, s6 = 0.f, s7 = 0.f, s8 = 0.f, s9 = 0.f, s10 = 0.f, s11 = 0.f, s12 = 0.f, s13 = 0.f, s14 = 0.f, s15 = 0.f;
        for (int p = 0; p <= NCH + 1; ++p) {
            if (p >= 1 && p <= NCH) {
                const int buf = (p - 1) & 1;
                const float* base = SA + buf * 2048;
                float* yc = YC + buf * 2048 + myrow;
                float w_c = base[lane], kd_c = base[4096 + lane], bb_c = base[2 * 4096 + lane], nk_c = base[3 * 4096 + lane], r_c = base[4 * 4096 + lane], v_c = base[5 * 4096 + myrow];
                for (int t = 0; t < 32; ++t) {
                    const int tn = (t + 1) & 31;
                    const float w_n = base[tn * 64 + lane], kd_n = base[4096 + tn * 64 + lane], bb_n = base[2 * 4096 + tn * 64 + lane], nk_n = base[3 * 4096 + tn * 64 + lane], r_n = base[4 * 4096 + tn * 64 + lane], v_n = base[5 * 4096 + tn * 64 + myrow];
                    float sap;
                    asm volatile("s_nop 1\n\t"
                        "v_mul_f32_dpp %0, %1, %2" DPPB(0) "v_fmac_f32_dpp %0, %1, %3" DPPB(1) "v_fmac_f32_dpp %0, %1, %4" DPPB(2) "v_fmac_f32_dpp %0, %1, %5" DPPB(3)
                        "v_fmac_f32_dpp %0, %1, %6" DPPB(4) "v_fmac_f32_dpp %0, %1, %7" DPPB(5) "v_fmac_f32_dpp %0, %1, %8" DPPB(6) "v_fmac_f32_dpp %0, %1, %9" DPPB(7)
                        "v_fmac_f32_dpp %0, %1, %10" DPPB(8) "v_fmac_f32_dpp %0, %1, %11" DPPB(9) "v_fmac_f32_dpp %0, %1, %12" DPPB(10) "v_fmac_f32_dpp %0, %1, %13" DPPB(11)
                        "v_fmac_f32_dpp %0, %1, %14" DPPB(12) "v_fmac_f32_dpp %0, %1, %15" DPPB(13) "v_fmac_f32_dpp %0, %1, %16" DPPB(14) "v_fmac_f32_dpp %0, %1, %17" DPPB(15)
                        "s_nop 1"
                        : "=&v"(sap)
                        : "v"(nk_c), "v"(s0), "v"(s1), "v"(s2), "v"(s3), "v"(s4), "v"(s5), "v"(s6), "v"(s7), "v"(s8), "v"(s9), "v"(s10), "v"(s11), "v"(s12), "v"(s13), "v"(s14), "v"(s15));
                    const float sa = red_rows(sap);
                    float yp;
                    asm volatile("s_nop 1\n\t"
                        RW_UPD(0, "%0") RW_UPD(1, "%1") RW_UPD(2, "%2") RW_UPD(3, "%3") RW_UPD(4, "%4") RW_UPD(5, "%5") RW_UPD(6, "%6") RW_UPD(7, "%7")
                        RW_UPD(8, "%8") RW_UPD(9, "%9") RW_UPD(10, "%10") RW_UPD(11, "%11") RW_UPD(12, "%12") RW_UPD(13, "%13") RW_UPD(14, "%14") RW_UPD(15, "%15")
                        "v_mul_f32_dpp %16, %20, %0" DPPB(0) "v_fmac_f32_dpp %16, %20, %1" DPPB(1) "v_fmac_f32_dpp %16, %20, %2" DPPB(2) "v_fmac_f32_dpp %16, %20, %3" DPPB(3)
                        "v_fmac_f32_dpp %16, %20, %4" DPPB(4) "v_fmac_f32_dpp %16, %20, %5" DPPB(5) "v_fmac_f32_dpp %16, %20, %6" DPPB(6) "v_fmac_f32_dpp %16, %20, %7" DPPB(7)
                        "v_fmac_f32_dpp %16, %20, %8" DPPB(8) "v_fmac_f32_dpp %16, %20, %9" DPPB(9) "v_fmac_f32_dpp %16, %20, %10" DPPB(10) "v_fmac_f32_dpp %16, %20, %11" DPPB(11)
                        "v_fmac_f32_dpp %16, %20, %12" DPPB(12) "v_fmac_f32_dpp %16, %20, %13" DPPB(13) "v_fmac_f32_dpp %16, %20, %14" DPPB(14) "v_fmac_f32_dpp %16, %20, %15" DPPB(15)
                        "s_nop 1"
                        : "+v"(s0), "+v"(s1), "+v"(s2), "+v"(s3), "+v"(s4), "+v"(s5), "+v"(s6), "+v"(s7), "+v"(s8), "+v"(s9), "+v"(s10), "+v"(s11), "+v"(s12), "+v"(s13), "+v"(s14), "+v"(s15), "=&v"(yp)
                        : "v"(w_c), "v"(bb_c), "v"(kd_c), "v"(r_c), "v"(sa), "v"(v_c));
                    const float y = red_rows(yp);
                    if (cg == 0) yc[t * 64] = y;
                    w_c = w_n; kd_c = kd_n; bb_c = bb_n; nk_c = nk_n; r_c = r_n; v_c = v_n;
                }
            }
            __syncthreads();
        }
        __builtin_amdgcn_s_setprio(0);
    }
    __syncthreads();
}
struct RwFinRow { bf16x8 a0, a1, b0, b1, v0, v1, g0, g1; float rk; };
DI void rw_fin_load(RwFinRow& R, const bf16_t* YF, const bf16_t* YB, const bf16_t* RKV, const bf16_t* G, const float* RK, int row, int c0, int hd) {
    R.a0 = *(const bf16x8*)(YF + (size_t)row * 1024 + c0); R.a1 = *(const bf16x8*)(YF + (size_t)row * 1024 + c0 + 8);
    R.b0 = *(const bf16x8*)(YB + (size_t)row * 1024 + c0); R.b1 = *(const bf16x8*)(YB + (size_t)row * 1024 + c0 + 8);
    R.v0 = *(const bf16x8*)(RKV + (size_t)row * 3072 + 2048 + c0); R.v1 = *(const bf16x8*)(RKV + (size_t)row * 3072 + 2048 + c0 + 8);
    R.g0 = *(const bf16x8*)(G + (size_t)row * 1024 + c0); R.g1 = *(const bf16x8*)(G + (size_t)row * 1024 + c0 + 8);
    R.rk = RK[(size_t)row * 16 + hd] + RK[(size_t)MT * 16 + (size_t)row * 16 + hd];
}
DI void rw_fin_store(const RwFinRow& R, bf16_t* YF, const float* lng, const float* lnb, int row, int c0) {
    float y[16]; float sm = 0.f;
#pragma unroll
    for (int e = 0; e < 8; ++e) { y[e] = bf2f((bf16_t)R.a0[e]) + bf2f((bf16_t)R.b0[e]); y[8 + e] = bf2f((bf16_t)R.a1[e]) + bf2f((bf16_t)R.b1[e]); }
#pragma unroll
    for (int e = 0; e < 16; ++e) sm += y[e];
    sm += __shfl_xor(sm, 1); sm += __shfl_xor(sm, 2);
    const float mu = sm * (1.f / 64.f);
    float sv = 0.f;
#pragma unroll
    for (int e = 0; e < 16; ++e) { y[e] -= mu; sv += y[e] * y[e]; }
    sv += __shfl_xor(sv, 1); sv += __shfl_xor(sv, 2);
    const float rinv = rsqrtf(sv * (1.f / 64.f) + 64e-5f);
    float o[16];
#pragma unroll
    for (int e = 0; e < 16; ++e) { const float vv = bf2f((bf16_t)(e < 8 ? R.v0[e] : R.v1[e - 8])), gg = bf2f((bf16_t)(e < 8 ? R.g0[e] : R.g1[e - 8]));
        o[e] = (y[e] * rinv * lng[c0 + e] + lnb[c0 + e] + R.rk * vv) * gg; }
    u32x4 w0, w1; w0.x = cvtpk(o[0], o[1]); w0.y = cvtpk(o[2], o[3]); w0.z = cvtpk(o[4], o[5]); w0.w = cvtpk(o[6], o[7]);
    w1.x = cvtpk(o[8], o[9]); w1.y = cvtpk(o[10], o[11]); w1.z = cvtpk(o[12], o[13]); w1.w = cvtpk(o[14], o[15]);
    *(u32x4*)(YF + (size_t)row * 1024 + c0) = w0; *(u32x4*)(YF + (size_t)row * 1024 + c0 + 8) = w1;
}
DI void rwkv_finish(bf16_t* YF, const bf16_t* YB, const bf16_t* RKV, const bf16_t* G, const float* RK, const float* lng, const float* lnb, int Mrows, int gw, int ngw, int lane) {
    const int c0 = 16 * lane, hd = lane >> 2;
    for (int row = gw; row < Mrows; row += 2 * ngw) {
        const int rowB = row + ngw < Mrows ? row + ngw : row;
        RwFinRow A, B;
        rw_fin_load(A, YF, YB, RKV, G, RK, row, c0, hd); rw_fin_load(B, YF, YB, RKV, G, RK, rowB, c0, hd);
        rw_fin_store(A, YF, lng, lnb, row, c0);
        if (rowB != row) rw_fin_store(B, YF, lng, lnb, rowB, c0);
    }
}

#define XB_TMO      128
#define XB_XCNT(j)  (256  + 64 * (j))
#define XB_XSUB(j)  (1280 + 64 * (j))
#define XB_XGEN(j)  (2304 + 64 * (j))
#define XB_TOP      3328
#define XB_TOPGEN   3392
#define XCD_BAR_WORDS 3456
#define XB_SPIN_CAP (1u << 18)

__device__ __forceinline__ unsigned xb_ld(unsigned* p)              { return __hip_atomic_load(p, __ATOMIC_RELAXED, __HIP_MEMORY_SCOPE_AGENT); }
__device__ __forceinline__ unsigned xb_add(unsigned* p, unsigned v) { return __hip_atomic_fetch_add(p, v, __ATOMIC_RELAXED, __HIP_MEMORY_SCOPE_AGENT); }
__device__ __forceinline__ unsigned xb_xcc_id() { return (unsigned)__builtin_amdgcn_s_getreg((3 << 11) | 20) & 0xFu; }
#define XB_SPIN(cond, bar) do { unsigned _sp = 0; while (cond) { __builtin_amdgcn_s_sleep(1); \
    if ((++_sp & 255u) == 0u) { if (xb_ld(&(bar)[XB_TMO])) break; if (_sp > XB_SPIN_CAP) { atomicAdd(&(bar)[XB_TMO], 1u); break; } } } } while (0)

struct XcdBarrier {
    unsigned* bar; unsigned x;
    volatile LAS unsigned* st;
};

__device__ __forceinline__ XcdBarrier xcd_barrier_post(unsigned* bar, volatile LAS unsigned* st) {
    XcdBarrier b; b.bar = bar; b.x = xb_xcc_id(); b.st = st;
    if (threadIdx.x == 0) (void)xb_add(&bar[XB_XCNT(b.x)], 1u);
    return b;
}
__device__ __forceinline__ void xcd_barrier_complete(unsigned* bar, unsigned x, unsigned& nloc, unsigned& nx) {
    const unsigned G = gridDim.x * gridDim.y * gridDim.z;
    unsigned sum, cnt, mine, sp = 0u;
    for (;;) {
        sum = 0u; cnt = 0u; mine = 0u;
#pragma unroll
        for (unsigned j = 0; j < 16; ++j) { const unsigned c = xb_ld(&bar[XB_XCNT(j)]); sum += c; cnt += (c > 0u) ? 1u : 0u; mine = (j == x) ? c : mine; }
        if (sum == G) break;
        __builtin_amdgcn_s_sleep(1);
        if ((++sp & 255u) == 0u) { if (xb_ld(&bar[XB_TMO])) break; if (sp > XB_SPIN_CAP) { atomicAdd(&bar[XB_TMO], 1u); break; } }
    }
    nloc = mine > 0u ? mine : 1u; nx = cnt > 0u ? cnt : 1u;
}

__device__ __forceinline__ void xcd_barrier(const XcdBarrier& b) {
    asm volatile("s_waitcnt vmcnt(0)" ::: "memory");
    __syncthreads();
    if (threadIdx.x == 0) {
        unsigned* bar = b.bar;
        __builtin_amdgcn_s_waitcnt(0);
        unsigned nloc = b.st[0], nx = b.st[1];
        if (nloc == 0u) { xcd_barrier_complete(bar, b.x, nloc, nx); b.st[0] = nloc; b.st[1] = nx; }
        const unsigned old = xb_add(&bar[XB_XSUB(b.x)], 1u);
        const unsigned gen = old / nloc;
        if (old + 1u == (gen + 1u) * nloc) {
            __builtin_amdgcn_fence(__ATOMIC_RELEASE, "agent");
            asm volatile("s_waitcnt vmcnt(0)" ::: "memory");
            const unsigned og = xb_add(&bar[XB_TOP], 1u);
            const unsigned tg = og / nx;
            if (og + 1u == (tg + 1u) * nx) xb_add(&bar[XB_TOPGEN], 1u);
            else XB_SPIN(xb_ld(&bar[XB_TOPGEN]) == tg, bar);
            __builtin_amdgcn_fence(__ATOMIC_ACQUIRE, "agent");
            xb_add(&bar[XB_XGEN(b.x)], 1u);
            asm volatile("s_waitcnt vmcnt(0)" ::: "memory");
        } else {
            XB_SPIN(xb_ld(&bar[XB_XGEN(b.x)]) == gen, bar);
            __builtin_amdgcn_fence(__ATOMIC_ACQUIRE, "agent");
            asm volatile("s_waitcnt vmcnt(0)" ::: "memory");
        }
    }
    __syncthreads();
}

#define WSP(T, off) ((T*)(a.ws + (off)))
#define PHASE(k) if (lo <= (k) && (k) < hi)
#define SEAM(k) do { if ((k) + 1 < hi) xcd_barrier(xbar); } while (0)
template <int L> DI void run_layer(const Args& a, unsigned char* lds, const XcdBarrier& xbar, int lo, int hi) {
    constexpr int kind = L % 3, jj = L / 3, P0 = 1 + 8 * L;
    constexpr bool need_ctx = L < 3;
    constexpr int Mact = need_ctx ? MT : ML;
    const int tid = threadIdx.x, lane = tid & 63, wid = __builtin_amdgcn_readfirstlane(tid >> 6);
    const int gw = blockIdx.x * 8 + wid, ngw = gridDim.x * 8;
    LAS unsigned char* ldsl = (LAS unsigned char*)lds;
    PHASE(P0 + 0) {
        float* scr = (float*)(lds + wid * 8704);
        for (int rep = 0; rep < ((DUP & 16) ? 2 : 1); ++rep) {
        const float* modl = WSP(float, WS_MOD) + (size_t)L * 9 * 6144;
        phase_prenorm(L == 0 ? a.in[0] : a.out, L == 0 ? a.in[2] : WSP(float, WS_ZF), a.in[6] + L * 1024, modl, 0, WSP(bf16_t, WS_H2), kind == 2 ? 2048 : 1024, kind == 2, MT, gw, ngw, lane);
        bf16_t* Wmix = WSP(bf16_t, W_MIX); bf16_t* Wo = WSP(bf16_t, W_O);
        conv_job(a.in[8] + (size_t)L * 1024 * 4096, 4096, 1024, 4096, 1024, 4096, nullptr, 0, WSP(bf16_t, W_1), 1024, 0, 0, scr, gw, ngw, lane);
        conv_job(a.in[9] + (size_t)L * 4096 * 1024, 1024, 4096, 1024, 4096, 1024, nullptr, 0, WSP(bf16_t, W_2), 4096, 0, 0, scr, gw, ngw, lane);
        if (kind == 0) {
            conv_job(a.in[11] + (size_t)jj * 1024 * 3072, 3072, 1024, 3072, 1024, 3072, nullptr, 0, Wmix, 1024, 0, 0, scr, gw, ngw, lane);
            conv_job(a.in[12] + (size_t)jj * 1024 * 1024, 1024, 1024, 1024, 1024, 1024, nullptr, 0, Wo, 1024, 0, 0, scr, gw, ngw, lane);
        } else if (kind == 1) {
            conv_job(a.in[14], 3104, 1024, 3104, 1024, 3328, nullptr, 0, Wmix, 1024, 0, 0, scr, gw, ngw, lane);
            conv_job(a.in[18], 1024, 1024, 1024, 1024, 1024, nullptr, 0, Wo, 1024, 0, 0, scr, gw, ngw, lane);
        } else {
            const float* mix = a.in[19];
            for (int md = 1; md <= 2; ++md) {
                const int co = (md - 1) * 1024;
                for (int q = 0; q < 3; ++q) conv_job(a.in[20] + (size_t)q * 1024 * 1024, 1024, 1024, 1024, 1024, 1024, mix + (q == 0 ? 0 : q + 1) * 1024, md, Wmix, 2048, q * 1024, co, scr, gw, ngw, lane);
                conv_job(a.in[27], 160, 1024, 160, 1024, 256, mix + 5 * 1024, md, Wmix, 2048, 3072, co, scr, gw, ngw, lane);
                for (int q = 0; q < 2; ++q) conv_job(a.in[22] + (size_t)q * 1024 * 64, 64, 1024, 64, 1024, 64, mix + 1 * 1024, md, Wmix, 2048, 3328 + 64 * q, co, scr, gw, ngw, lane);
                for (int q = 0; q < 2; ++q) conv_job(a.in[25] + (size_t)q * 1024 * 64, 64, 1024, 64, 1024, 64, mix + 4 * 1024, md, Wmix, 2048, 3456 + 64 * q, co, scr, gw, ngw, lane);
            }
            conv_job(a.in[28], 1024, 160, 1024, 256, 1024, nullptr, 0, WSP(bf16_t, W_G2), 256, 0, 0, scr, gw, ngw, lane);
            conv_job(a.in[34], 1024, 1024, 1024, 1024, 1024, nullptr, 0, Wo, 1024, 0, 0, scr, gw, ngw, lane);
        }
        }
        SEAM(P0 + 0);
    }
    PHASE(P0 + 1) {
        bf16_t* BIG = WSP(bf16_t, WS_BIG);
        for (int rep = 0; rep < ((DUP & 8) ? 2 : 1); ++rep) {
        if (kind == 0) run_gemm(ldsl, WSP(bf16_t, WS_H2), WSP(bf16_t, W_MIX), MT, 3072, 1024, InNaQkv{BIG, BIG + (size_t)MT * 2048, BIG + (size_t)MT * 2048 + (size_t)ML * 1024});
        else if (kind == 1) run_gemm(ldsl, WSP(bf16_t, WS_H2), WSP(bf16_t, W_MIX), MT, 3328, 1024, InGlaIn{BIG, WSP(float, WS_LR)});
        else run_gemm(ldsl, WSP(bf16_t, WS_H2), WSP(bf16_t, W_MIX), MT, 3584, 2048, InRwL1{BIG, BIG + (size_t)MT * 3072, BIG + (size_t)MT * 3328});
        }
        SEAM(P0 + 1);
    }
    PHASE(P0 + 2) {
        bf16_t* BIG = WSP(bf16_t, WS_BIG); bf16_t* H2 = WSP(bf16_t, WS_H2);
        const int vcu = (gridDim.x % 8 == 0) ? (int)((blockIdx.x % 8) * (gridDim.x / 8) + blockIdx.x / 8) : (int)blockIdx.x;
        const int gwv = vcu * 8 + wid;
        if (kind == 0) {
            const bf16_t* VTL = BIG + (size_t)MT * 2048; const bf16_t* VTC = VTL + (size_t)ML * 1024;
            const float* rpb = a.in[13] + (size_t)jj * 16 * 15 * 31;
            const int nu = 8192 + (need_ctx ? 512 : 0);
#ifndef NO_ATTN
            float* tbl = (float*)(lds + wid * 7680);
            int tbl_hd = -1;
            for (int rep = 0; rep < ((DUP & 1) ? 2 : 1); ++rep)
            for (int u = gwv; u < nu; u += ngw) {
                if (u < 8192) {
                    const int hd_ = (u >> 6) & 15;
                    if (hd_ != tbl_hd) {
                        for (int e = lane; e < 465; e += 64) { const int rr = e / 31, cc = e - rr * 31; tbl[rr * 128 + 48 + cc] = rpb[hd_ * 465 + e] * 1.4426950408889634f; }
                        tbl_hd = hd_;
                    }
                    attn_unit(BIG, VTL, VTC, H2, tbl, u >> 10, hd_, u & 63, 0, lane);
                }
                else { const int v = u - 8192; attn_unit(BIG, VTL, VTC, H2, tbl, v >> 6, (v >> 2) & 15, -1, v & 3, lane); }
            }
#endif
        } else if (kind == 1) {
#ifndef NO_GLA
            for (int rep = 0; rep < ((DUP & 2) ? 2 : 1); ++rep)
            gla_gates(WSP(float, WS_LR), a.in[15], a.in[16], BIG + (size_t)MT * 3072, (float*)lds, tid);
            xcd_barrier(xbar);
            for (int u = vcu; u < 256; u += gridDim.x) gla_unit(BIG, BIG + (size_t)MT * 3072, H2, lds, u, tid);
#endif
        } else {
#ifndef NO_RWKV
            for (int rep = 0; rep < ((DUP & 4) ? 2 : 1); ++rep)
            for (int u = vcu; u < 256; u += gridDim.x) rwkv_unit(a, BIG, BIG + (size_t)MT * 3328, H2, WSP(float, WS_RK), lds, u, tid);
#endif
            run_gemm(ldsl, BIG + (size_t)MT * 3072, WSP(bf16_t, W_G2), MT, 1024, 256, InStore<0>{WSP(bf16_t, WS_G), 1024});
        }
        SEAM(P0 + 2);
    }
    if (kind != 0) {
        PHASE(P0 + 3) {
            bf16_t* H2 = WSP(bf16_t, WS_H2);
            if (kind == 1) gla_finish(H2, H2 + (size_t)MT * 1024, WSP(bf16_t, WS_BIG), a.in[17], Mact, gw, ngw, lane);
            else rwkv_finish(H2, H2 + (size_t)MT * 1024, WSP(bf16_t, WS_BIG), WSP(bf16_t, WS_G), WSP(float, WS_RK), a.in[32], a.in[33], Mact, gw, ngw, lane);
            SEAM(P0 + 3);
        }
    }
    PHASE(P0 + 4) {
        run_gemm(ldsl, WSP(bf16_t, WS_H2), WSP(bf16_t, W_O), ML, 1024, 1024, InResid{L == 0 ? a.in[0] : a.out, L == 0 ? a.in[2] : WSP(float, WS_ZF), a.out, WSP(float, WS_ZF), WSP(float, WS_MOD) + (size_t)L * 9 * 6144 + 2 * 1024});
        if (need_ctx) gemm_tail(WSP(bf16_t, WS_H2), WSP(bf16_t, W_O), 1024, L == 0 ? a.in[2] : WSP(float, WS_ZF), WSP(float, WS_ZF), WSP(float, WS_MOD) + (size_t)L * 9 * 6144 + 2 * 1024 + (size_t)8 * 6144, lds, tid);
        SEAM(P0 + 4);
    }
    PHASE(P0 + 5) {
        for (int rep = 0; rep < ((DUP & 16) ? 2 : 1); ++rep)
        phase_prenorm(a.out, WSP(float, WS_ZF), a.in[7] + L * 1024, WSP(float, WS_MOD) + (size_t)L * 9 * 6144, 3, WSP(bf16_t, WS_H2), 1024, false, Mact, gw, ngw, lane);
        SEAM(P0 + 5);
    }
    PHASE(P0 + 6) {
        for (int rep = 0; rep < ((DUP & 8) ? 2 : 1); ++rep)
        run_gemm(ldsl, WSP(bf16_t, WS_H2), WSP(bf16_t, W_1), Mact, 4096, 1024, InStore<1>{WSP(bf16_t, WS_BIG), 4096});
        SEAM(P0 + 6);
    }
    PHASE(P0 + 7) {
        run_gemm(ldsl, WSP(bf16_t, WS_BIG), WSP(bf16_t, W_2), ML, 1024, 4096, InResid{a.out, WSP(float, WS_ZF), a.out, WSP(float, WS_ZF), WSP(float, WS_MOD) + (size_t)L * 9 * 6144 + 5 * 1024});
        if (need_ctx) gemm_tail(WSP(bf16_t, WS_BIG), WSP(bf16_t, W_2), 4096, WSP(float, WS_ZF), WSP(float, WS_ZF), WSP(float, WS_MOD) + (size_t)L * 9 * 6144 + 5 * 1024 + (size_t)8 * 6144, lds, tid);
        SEAM(P0 + 7);
    }
}
__global__ void __launch_bounds__(NTHREADS, 2) mega(Args a) {
    extern __shared__ __attribute__((aligned(16))) unsigned char lds[];
    cg::grid_group grid = cg::this_grid();
    const int lo = a.lo, hi = a.hi;
    volatile LAS unsigned* xst = (volatile LAS unsigned*)((LAS unsigned char*)lds + (LDS_BYTES - 64));
    if (threadIdx.x < 2) xst[threadIdx.x] = 0u;
    __syncthreads();
    const XcdBarrier xbar = xcd_barrier_post((unsigned*)(a.ws + WS_BAR), xst);
    PHASE(0) { phase_mod(a, (float*)lds, threadIdx.x); if (1 < hi) grid.sync(); }
    run_layer<0>(a, lds, xbar, lo, hi);
    run_layer<1>(a, lds, xbar, lo, hi);
    run_layer<2>(a, lds, xbar, lo, hi);
    run_layer<3>(a, lds, xbar, lo, hi);
    PHASE(33) {
        const int tid = threadIdx.x, lane = tid & 63, wid = tid >> 6;
        const int gw = blockIdx.x * 8 + wid, ngw = gridDim.x * 8;
        const float* fg = a.in[10];
        for (int st = gw; st < ML / 4; st += ngw) {
            f32x4 v[4][4]; float ss[4];
#pragma unroll
            for (int r = 0; r < 4; ++r) { const float* xr = a.out + (size_t)(4 * st + r) * 1024;
#pragma unroll
                for (int j = 0; j < 4; ++j) v[r][j] = *(const f32x4*)(xr + 4 * lane + 256 * j); }
#pragma unroll
            for (int r = 0; r < 4; ++r) { float s = 0.f;
#pragma unroll
                for (int j = 0; j < 4; ++j) s += (v[r][j].x * v[r][j].x + v[r][j].y * v[r][j].y) + (v[r][j].z * v[r][j].z + v[r][j].w * v[r][j].w);
                ss[r] = s; }
#pragma unroll
            for (int o = 1; o < 64; o <<= 1) {
#pragma unroll
                for (int r = 0; r < 4; ++r) ss[r] += __shfl_xor(ss[r], o);
            }
#pragma unroll
            for (int r = 0; r < 4; ++r) { const float rinv = rsqrtf(ss[r] * (1.f / 1024.f) + 1e-6f); float* xr = a.out + (size_t)(4 * st + r) * 1024;
#pragma unroll
                for (int j = 0; j < 4; ++j) *(f32x4*)(xr + 4 * lane + 256 * j) = v[r][j] * rinv * *(const f32x4*)(fg + 4 * lane + 256 * j); }
        }
    }
}

#ifndef GM
#define GM 0xffff
#endif
#ifndef MULTI_LAUNCH
#define MULTI_LAUNCH 0
#endif
extern "C" void kernel_launch(void* const* d_in, const int* in_sizes, int n_in, void* d_out, int out_size, void* d_ws, size_t ws_size, hipStream_t stream) {
    static int grid_blocks = 0;
    if (!grid_blocks) {
        int dev = 0, cus = 0, per_cu = 0;
        hipGetDevice(&dev);
        hipDeviceGetAttribute(&cus, hipDeviceAttributeMultiprocessorCount, dev);
        hipFuncSetAttribute((const void*)mega, hipFuncAttributeMaxDynamicSharedMemorySize, LDS_BYTES);
        hipOccupancyMaxActiveBlocksPerMultiprocessor(&per_cu, (const void*)mega, NTHREADS, LDS_BYTES);
        if (per_cu < 1) per_cu = 1;
        grid_blocks = cus * per_cu;
    }
    (void)hipMemsetAsync((char*)d_ws + WS_BAR, 0, XCD_BAR_WORDS * 4, stream);
    Args a{};
    for (int i = 0; i < 35; ++i) a.in[i] = (const float*)d_in[i];
    a.out = (float*)d_out; a.ws = (unsigned char*)d_ws;
#if MULTI_LAUNCH
    for (int p = 0; p < 34; ++p) { a.lo = p; a.hi = p + 1; hipLaunchKernelGGL(mega, dim3(grid_blocks), dim3(NTHREADS), LDS_BYTES, stream, a); }
#else
    a.lo = 0; a.hi = 34;
    void* args[] = {&a};
    hipError_t e = hipLaunchCooperativeKernel((const void*)mega, dim3(grid_blocks), dim3(NTHREADS), args, LDS_BYTES, stream);
    if (e != hipSuccess) fprintf(stderr, "cooperative launch failed: %s (grid %d)\n", hipGetErrorString(e), grid_blocks);
#endif
}
```
